# Optimizing an MI355X kernel written in HIP

```python
import math
import jax, jax.numpy as jnp
from jax import lax
import numpy as np

D_MODEL = 1024
BATCH = 8
SEQ = 2048
DEPTH = 4

MEM_LEN = 256
EXPAND = 2
MIX_WIDTH = EXPAND * D_MODEL
A_WIDTH = MIX_WIDTH // 2
A_HEAD_DIM = 64
A_HEADS = A_WIDTH // A_HEAD_DIM
A_PATTERNS = ((128, 1), (512, 4), (2048, 16))
A_BLOCK = 128
B_WIDTH = MIX_WIDTH - A_WIDTH
POOL_WINDOWS = (2, 4, 8, 16)
B_GROUP = B_WIDTH // len(POOL_WINDOWS)
C_WIDTH = D_MODEL
C_CHUNK = 128
C_GROUPS = 4
C_GROUP_DIM = C_WIDTH // C_GROUPS
D_WIDTH = D_MODEL // 2
S5_GROUP_DIM = 16
S5_GROUPS = D_WIDTH // S5_GROUP_DIM
S5_STATE = 64
X_HEADS = 4
X_HEAD_DIM = D_MODEL // X_HEADS
N_EVEN = (DEPTH + 1) // 2
N_ODD = DEPTH // 2
EPS = 1e-6
NEG = -1e30

kernel_name = 'hybrid_dilated_pool_sgu_s5_trunk'


def rms_norm(x, g):
    xf = x.astype(jnp.float32)
    y = xf * lax.rsqrt(jnp.mean(xf * xf, axis=-1, keepdims=True) + EPS)
    return (y * g.astype(jnp.float32)).astype(x.dtype)


def _dilated_pattern(q, k, v, window, dilation):
    b, s, h, dh = q.shape
    d = dilation
    L = s // d
    w = window // d
    nb = -(-L // A_BLOCK)
    lp = nb * A_BLOCK
    n = b * d

    def to_dilated(t):
        t = t.reshape(b, L, d, h, dh).transpose(0, 2, 1, 3, 4).reshape(n, L, h, dh)
        return jnp.pad(t, ((0, 0), (0, lp - L), (0, 0), (0, 0)))

    def band(t):
        tp = jnp.pad(t, ((0, 0), (A_BLOCK, 0), (0, 0), (0, 0))).reshape(n, nb + 1, A_BLOCK, h, dh)
        return jnp.concatenate([tp[:, :-1], tp[:, 1:]], axis=2)

    qb = to_dilated(q).reshape(n, nb, A_BLOCK, h, dh)
    kb = band(to_dilated(k))
    vb = band(to_dilated(v))
    i = jnp.arange(A_BLOCK)[:, None]
    j = jnp.arange(2 * A_BLOCK)[None, :]
    dist = i + A_BLOCK - j
    blk = jnp.arange(nb)[:, None, None]
    valid = (dist >= 0) & (dist <= w) & ((j >= A_BLOCK) | (blk > 0))
    sc = jnp.einsum('nbihd,nbjhd->nbhij', qb, kb, preferred_element_type=jnp.float32)
    sc = jnp.where(valid[None, :, None], sc, NEG)
    m = jnp.max(sc, axis=-1, keepdims=True)
    p = jnp.exp(sc - m)
    den = jnp.sum(p, axis=-1, keepdims=True)
    o = jnp.einsum('nbhij,nbjhd->nbihd', (p / den).astype(v.dtype), vb)
    lse = (m + jnp.log(den))[..., 0].transpose(0, 1, 3, 2)

    def from_dilated(t):
        rest = t.shape[3:]
        t = t.reshape((n, lp) + rest)[:, :L]
        return t.reshape((b, d, L) + rest).swapaxes(1, 2).reshape((b, s) + rest)

    return from_dilated(o), from_dilated(lse)


def dilated_attention(q, k, v):
    outs, lses = zip(*[_dilated_pattern(q, k, v, w, d) for (w, d) in A_PATTERNS])
    wts = jax.nn.softmax(jnp.stack(lses, axis=0), axis=0)
    o = jnp.sum(jnp.stack(outs, axis=0).astype(jnp.float32) * wts[..., None], axis=0)
    return o.astype(q.dtype)


def multiscale_pool(v, pool_w, pool_scale):
    b, s, _ = v.shape
    vf = v.astype(jnp.float32)
    c0 = jnp.pad(jnp.cumsum(vf, axis=1), ((0, 0), (1, 0), (0, 0)))
    pos = jnp.arange(1, s + 1, dtype=jnp.float32)[None, :, None]
    groups = []
    for g, w in enumerate(POOL_WINDOWS):
        sl = slice(g * B_GROUP, (g + 1) * B_GROUP)
        cg = c0[..., sl]
        lower = jnp.pad(cg, ((0, 0), (w - 1, 0), (0, 0)))[:, :s]
        mean = (cg[:, 1:] - lower) / jnp.minimum(pos, float(w))
        groups.append(mean - vf[..., sl])
    pooled = jnp.stack(groups, axis=2).astype(v.dtype)
    mixed = jnp.einsum('bsgc,gcd->bsgd', pooled, pool_w).reshape(b, s, B_WIDTH)
    return mixed * pool_scale


def spatial_gating(u, v, ln_g, ln_b, w_s, b_s):
    b, s, _ = u.shape
    vf = v.astype(jnp.float32)
    mu = jnp.mean(vf, axis=-1, keepdims=True)
    var = jnp.mean(jnp.square(vf - mu), axis=-1, keepdims=True)
    vn = ((vf - mu) * lax.rsqrt(var + EPS) * ln_g.astype(jnp.float32) + ln_b.astype(jnp.float32)).astype(v.dtype)
    nc = s // C_CHUNK
    vc = vn.reshape(b, nc, C_CHUNK, C_GROUPS, C_GROUP_DIM)
    mask = jnp.tril(jnp.ones((C_CHUNK, C_CHUNK), dtype=bool))
    w = jnp.where(mask[None], w_s, jnp.zeros_like(w_s))
    mixed = jnp.einsum('gij,bnjgc->bnigc', w, vc) + b_s.T[None, None, :, :, None]
    return u * mixed.reshape(b, s, C_WIDTH)


def _ssm_combine(e1, e2):
    a1r, a1i, b1r, b1i = e1
    a2r, a2i, b2r, b2i = e2
    return (a2r * a1r - a2i * a1i,
            a2r * a1i + a2i * a1r,
            a2r * b1r - a2i * b1i + b2r,
            a2r * b1i + a2i * b1r + b2i)


def s5_ssm(u, a_re, a_im, log_dt, b_re, b_im, c_re, c_im, d_skip, w1, w2):
    bsz, s, _ = u.shape
    f32 = jnp.float32
    uf = u.astype(f32).reshape(bsz, s, S5_GROUPS, S5_GROUP_DIM)
    ar, ai = a_re.astype(f32), a_im.astype(f32)
    dt = jnp.exp(log_dt.astype(f32))[:, None]
    mag = jnp.exp(dt * ar)
    abar_re = mag * jnp.cos(dt * ai)
    abar_im = mag * jnp.sin(dt * ai)
    nr, ni = abar_re - 1.0, abar_im
    inv = 1.0 / (ar * ar + ai * ai)
    coef_re = (nr * ar + ni * ai) * inv
    coef_im = (ni * ar - nr * ai) * inv
    br, bi = b_re.astype(f32), b_im.astype(f32)
    bbar_re = coef_re[..., None] * br - coef_im[..., None] * bi
    bbar_im = coef_re[..., None] * bi + coef_im[..., None] * br
    bu_re = jnp.einsum('bsgh,gph->bsgp', uf, bbar_re)
    bu_im = jnp.einsum('bsgh,gph->bsgp', uf, bbar_im)
    shape_a = (1, s, S5_GROUPS, S5_STATE)
    a_seq_re = jnp.broadcast_to(abar_re[None, None], shape_a)
    a_seq_im = jnp.broadcast_to(abar_im[None, None], shape_a)
    _, _, h_re, h_im = lax.associative_scan(_ssm_combine, (a_seq_re, a_seq_im, bu_re, bu_im), axis=1)
    y = (jnp.einsum('bsgp,ghp->bsgh', h_re, c_re.astype(f32))
         - jnp.einsum('bsgp,ghp->bsgh', h_im, c_im.astype(f32))
         + d_skip.astype(f32).reshape(S5_GROUPS, S5_GROUP_DIM) * uf)
    y = jax.nn.gelu(y.reshape(bsz, s, D_WIDTH)).astype(u.dtype)
    return (y @ w1) * jax.nn.sigmoid(y @ w2)


def memory_cross_attention(h, mem_n, w_q, w_kv, w_o):
    b, s, _ = h.shape
    m = mem_n.shape[1]
    q = (h @ w_q).reshape(b, s, X_HEADS, X_HEAD_DIM)
    kv = (mem_n @ w_kv).reshape(b, m, 2, X_HEADS, X_HEAD_DIM)
    k, v = kv[:, :, 0], kv[:, :, 1]
    sc = jnp.einsum('bshd,bmhd->bhsm', q, k, preferred_element_type=jnp.float32) * (X_HEAD_DIM ** -0.5)
    p = jax.nn.softmax(sc, axis=-1).astype(v.dtype)
    o = jnp.einsum('bhsm,bmhd->bshd', p, v).reshape(b, s, D_MODEL)
    return o @ w_o


def setup_inputs(seed: int = 0) -> dict:
    key = jax.random.key(seed)
    ks = iter(jax.random.split(key, 40))

    def nrm(shape, scale):
        return scale * jax.random.normal(next(ks), shape, jnp.float32)

    def gain(shape):
        return 1.0 + nrm(shape, 0.05)

    return {
        'x': nrm((BATCH, SEQ, D_MODEL), 1.0),
        'mem': nrm((BATCH, MEM_LEN, D_MODEL), 1.0),
        'norm_ab': gain((N_EVEN, D_MODEL)),
        'w_in_ab': nrm((N_EVEN, D_MODEL, 4 * A_WIDTH + 2 * B_WIDTH), D_MODEL ** -0.5),
        'pool_w': nrm((N_EVEN, len(POOL_WINDOWS), B_GROUP, B_GROUP), B_GROUP ** -0.5),
        'pool_scale': gain((N_EVEN, B_WIDTH)),
        'w_out_ab': nrm((N_EVEN, A_WIDTH + B_WIDTH, D_MODEL), (A_WIDTH + B_WIDTH) ** -0.5),
        'norm_cd': gain((N_ODD, D_MODEL)),
        'w_in_cd': nrm((N_ODD, D_MODEL, 3 * C_WIDTH + 2 * D_WIDTH), D_MODEL ** -0.5),
        'sgu_ln_g': gain((N_ODD, C_WIDTH)),
        'sgu_ln_b': nrm((N_ODD, C_WIDTH), 0.02),
        'sgu_w': nrm((N_ODD, C_GROUPS, C_CHUNK, C_CHUNK), C_CHUNK ** -0.5),
        'sgu_b': gain((N_ODD, C_GROUPS, C_CHUNK)),
        's5_a_re': -0.5 + nrm((N_ODD, S5_GROUPS, S5_STATE), 0.01),
        's5_a_im': jnp.pi * jnp.arange(S5_STATE, dtype=jnp.float32)[None, None, :] + nrm((N_ODD, S5_GROUPS, S5_STATE), 0.01),
        's5_log_dt': jax.random.uniform(next(ks), (N_ODD, S5_GROUPS), jnp.float32, math.log(1e-3), math.log(1e-1)),
        's5_b_re': nrm((N_ODD, S5_GROUPS, S5_STATE, S5_GROUP_DIM), (2 * S5_GROUP_DIM) ** -0.5),
        's5_b_im': nrm((N_ODD, S5_GROUPS, S5_STATE, S5_GROUP_DIM), (2 * S5_GROUP_DIM) ** -0.5),
        's5_c_re': nrm((N_ODD, S5_GROUPS, S5_GROUP_DIM, S5_STATE), S5_STATE ** -0.5),
        's5_c_im': nrm((N_ODD, S5_GROUPS, S5_GROUP_DIM, S5_STATE), S5_STATE ** -0.5),
        's5_d': nrm((N_ODD, D_WIDTH), 1.0),
        'glu_w1': nrm((N_ODD, D_WIDTH, D_WIDTH), D_WIDTH ** -0.5),
        'glu_w2': nrm((N_ODD, D_WIDTH, D_WIDTH), D_WIDTH ** -0.5),
        'w_out_cd': nrm((N_ODD, C_WIDTH + D_WIDTH, D_MODEL), (C_WIDTH + D_WIDTH) ** -0.5),
        'norm_x': gain((DEPTH, D_MODEL)),
        'w_xq': nrm((DEPTH, D_MODEL, D_MODEL), D_MODEL ** -0.5),
        'w_xkv': nrm((DEPTH, D_MODEL, 2 * D_MODEL), D_MODEL ** -0.5),
        'w_xo': nrm((DEPTH, D_MODEL, D_MODEL), D_MODEL ** -0.5),
        'mem_norm': gain((D_MODEL,)),
        'final_norm': gain((D_MODEL,)),
    }


def reference(x, mem, norm_ab, w_in_ab, pool_w, pool_scale, w_out_ab,
              norm_cd, w_in_cd, sgu_ln_g, sgu_ln_b, sgu_w, sgu_b,
              s5_a_re, s5_a_im, s5_log_dt, s5_b_re, s5_b_im, s5_c_re, s5_c_im, s5_d,
              glu_w1, glu_w2, w_out_cd, norm_x, w_xq, w_xkv, w_xo, mem_norm, final_norm):
    b, s, _ = x.shape
    mem_n = rms_norm(mem, mem_norm)
    for layer in range(DEPTH):
        i = layer // 2
        if layer % 2 == 0:
            hn = rms_norm(x, norm_ab[i])
            z = hn @ w_in_ab[i]
            q, k, v, g_a, v_b, g_b = jnp.split(
                z, [A_WIDTH, 2 * A_WIDTH, 3 * A_WIDTH, 4 * A_WIDTH, 4 * A_WIDTH + B_WIDTH], axis=-1)
            q = q.reshape(b, s, A_HEADS, A_HEAD_DIM) * (A_HEAD_DIM ** -0.5)
            k = k.reshape(b, s, A_HEADS, A_HEAD_DIM)
            v = v.reshape(b, s, A_HEADS, A_HEAD_DIM)
            a_out = dilated_attention(q, k, v).reshape(b, s, A_WIDTH) * jax.nn.silu(g_a)
            b_out = multiscale_pool(v_b, pool_w[i], pool_scale[i]) * jax.nn.silu(g_b)
            y = jnp.concatenate([a_out, b_out], axis=-1) @ w_out_ab[i]
        else:
            hn = rms_norm(x, norm_cd[i])
            z = hn @ w_in_cd[i]
            u_c, v_c, g_c, x_d, g_d = jnp.split(
                z, [C_WIDTH, 2 * C_WIDTH, 3 * C_WIDTH, 3 * C_WIDTH + D_WIDTH], axis=-1)
            c_out = spatial_gating(u_c, v_c, sgu_ln_g[i], sgu_ln_b[i], sgu_w[i], sgu_b[i]) * jax.nn.silu(g_c)
            d_out = s5_ssm(x_d, s5_a_re[i], s5_a_im[i], s5_log_dt[i], s5_b_re[i], s5_b_im[i],
                           s5_c_re[i], s5_c_im[i], s5_d[i], glu_w1[i], glu_w2[i]) * jax.nn.silu(g_d)
            y = jnp.concatenate([c_out, d_out], axis=-1) @ w_out_cd[i]
        x = x + y
        x = x + memory_cross_attention(rms_norm(x, norm_x[layer]), mem_n, w_xq[layer], w_xkv[layer], w_xo[layer])
    return rms_norm(x, final_norm)
```

```cpp
#include <hip/hip_runtime.h>
#include <hip/hip_cooperative_groups.h>
#include <cstdio>
#include <cstdint>
namespace cg = cooperative_groups;

typedef unsigned short bf16_t;
typedef float f32x4 __attribute__((ext_vector_type(4)));
typedef unsigned u32x4 __attribute__((ext_vector_type(4)));
typedef unsigned u32x2 __attribute__((ext_vector_type(2)));

constexpr int BATCH = 8, SEQ = 2048, DM = 1024, M = BATCH * SEQ, MEML = 256, MM = BATCH * MEML;
constexpr float EPS = 1e-6f;
constexpr int NT = 512;
constexpr int LDS_BYTES = 147456;

constexpr size_t MiB = 1u << 20;
constexpr size_t WS_RS = 1 * MiB;
constexpr size_t WS_LNS = 2 * MiB;
constexpr size_t WS_SGUW = 3 * MiB;
constexpr size_t WS_XB = 8 * MiB;
constexpr size_t WS_B0 = 40 * MiB, WS_B1 = 72 * MiB, WS_B2 = 104 * MiB, WS_B3 = 136 * MiB;
constexpr size_t WS_KVX = 168 * MiB;
constexpr size_t WS_VTX = 184 * MiB;
constexpr int WIN_LD = 1088;
constexpr size_t WS_WIN = 200 * MiB;
constexpr size_t WS_WUT = 248 * MiB;
constexpr size_t WS_WOAB = 216 * MiB;
constexpr size_t WS_WOCD = 224 * MiB;
constexpr size_t WS_WXQ = 230 * MiB;
constexpr size_t WS_WXO = 238 * MiB;
constexpr size_t WS_GLU = 246 * MiB;
constexpr size_t WS_END = 253 * MiB;
constexpr size_t WS_WKVT = WS_B0;
constexpr size_t WS_MEMNB = WS_B1;
constexpr size_t WS_PWT = WS_B2;
constexpr size_t WS_WVB = WS_B2 + 2 * MiB;

struct Params { const float* in[30]; float* out; unsigned char* ws; };

#define GAS __attribute__((address_space(1)))
template <class T> __device__ __forceinline__ T gld(const void* p) { return *(const GAS T*)p; }
template <class T> __device__ __forceinline__ void gst(void* p, T v) { *(GAS T*)p = v; }
#ifndef WT_STORES
#define WT_STORES 1
#endif
__device__ __forceinline__ void wst8(void* base, size_t off, u32x2 v) {
#if WT_STORES
    const __amdgpu_buffer_rsrc_t r = __builtin_amdgcn_make_buffer_rsrc(base, (short)0, 0x7fffffff, 0x00020000);
    __builtin_amdgcn_raw_buffer_store_b64(v, r, (unsigned)off, 0, 16);
#else
    *(GAS u32x2*)((unsigned char*)base + off) = v;
#endif
}
__device__ __forceinline__ void wst16(void* base, size_t off, u32x4 v) {
#if WT_STORES
    const __amdgpu_buffer_rsrc_t r = __builtin_amdgcn_make_buffer_rsrc(base, (short)0, 0x7fffffff, 0x00020000);
    __builtin_amdgcn_raw_buffer_store_b128(v, r, (unsigned)off, 0, 16);
#else
    *(GAS u32x4*)((unsigned char*)base + off) = v;
#endif
}
__device__ __forceinline__ void st16(void* base, size_t off, u32x4 v, const bool wt) { if (wt) wst16(base, off, v); else *(GAS u32x4*)((unsigned char*)base + off) = v; }
__device__ __forceinline__ int tid_l() { int t = threadIdx.x; asm volatile("" : "+v"(t)); return t; }
__device__ __forceinline__ int bid_l() { int b = blockIdx.x; asm volatile("" : "+s"(b)); return b; }
__device__ __forceinline__ float quad_rows_sum(float v) {
    { const auto r = __builtin_amdgcn_permlane16_swap(__float_as_uint(v), __float_as_uint(v), false, false); v = __uint_as_float(r[0]) + __uint_as_float(r[1]); }
    { const auto r = __builtin_amdgcn_permlane32_swap(__float_as_uint(v), __float_as_uint(v), false, false); v = __uint_as_float(r[0]) + __uint_as_float(r[1]); }
    return v;
}
__device__ __forceinline__ float quad_rows_max(float v) {
    { const auto r = __builtin_amdgcn_permlane16_swap(__float_as_uint(v), __float_as_uint(v), false, false); v = fmaxf(__uint_as_float(r[0]), __uint_as_float(r[1])); }
    { const auto r = __builtin_amdgcn_permlane32_swap(__float_as_uint(v), __float_as_uint(v), false, false); v = fmaxf(__uint_as_float(r[0]), __uint_as_float(r[1])); }
    return v;
}
__device__ __forceinline__ float bf2f(bf16_t v) { return __uint_as_float(((unsigned)v) << 16); }
__device__ __forceinline__ bf16_t f2bf(float f) { unsigned u = __float_as_uint(f); u += 0x7fffu + ((u >> 16) & 1u); return (bf16_t)(u >> 16); }
__device__ __forceinline__ float wave_sum(float v) {
#pragma unroll
    for (int o = 1; o < 64; o <<= 1) v += __shfl_xor(v, o);
    return v;
}
__device__ __forceinline__ float wave_max(float v) {
#pragma unroll
    for (int o = 1; o < 64; o <<= 1) v = fmaxf(v, __shfl_xor(v, o));
    return v;
}
__device__ __forceinline__ float half_sum32(float v) {
#pragma unroll
    for (int o = 1; o < 32; o <<= 1) v += __shfl_xor(v, o);
    return v;
}
__device__ __forceinline__ float silu_f(float x) { return x / (1.0f + expf(-x)); }
__device__ __forceinline__ float sigmoid_f(float x) { return 1.0f / (1.0f + expf(-x)); }
__device__ __forceinline__ float gelu_tanh_f(float x) { return 0.5f * x * (1.0f + tanhf(0.7978845608028654f * (x + 0.044715f * x * x * x))); }
__device__ __forceinline__ float rstd_of(const float* RS, int row) { return rsqrtf(((gld<float>(RS + row) + gld<float>(RS + M + row)) + (gld<float>(RS + 2 * M + row) + gld<float>(RS + 3 * M + row))) * (1.0f / DM) + EPS); }
__device__ __forceinline__ float fsilu(float x) { return x * __builtin_amdgcn_rcpf(1.0f + __builtin_amdgcn_exp2f(-1.4426950408889634f * x)); }
__device__ __forceinline__ float fsigmoid(float x) { return __builtin_amdgcn_rcpf(1.0f + __builtin_amdgcn_exp2f(-1.4426950408889634f * x)); }
typedef float cvt_f32x2 __attribute__((ext_vector_type(2)));
typedef __bf16 cvt_bf16x2 __attribute__((ext_vector_type(2)));
__device__ __forceinline__ unsigned cvt_pk_bf16(float lo, float hi) { const cvt_f32x2 v = {lo, hi}; return __builtin_bit_cast(unsigned, __builtin_convertvector(v, cvt_bf16x2)); }
__device__ __forceinline__ float bflo(unsigned w) { return __uint_as_float(w << 16); }
__device__ __forceinline__ float bfhi(unsigned w) { return __uint_as_float(w & 0xffff0000u); }

__device__ __forceinline__ void conv_job(unsigned char* lds, const float* src, int ldn, int n0, int Nrows, int K, bf16_t* dst, const float* rs, float scale, int& tc, int ldd = 0, const bool wt = true) {
    if (ldd == 0) ldd = K;
    const int tid = tid_l(), lane = tid & 63, wid = tid >> 6;
    float* T = (float*)lds + wid * (64 * 65);
    int gdim = gridDim.x; asm volatile("" : "+s"(gdim));
    const int nnt = Nrows / 64, ntile = (K / 64) * nnt, gw = blockIdx.x * (NT / 64) + wid, ngw = gdim * (NT / 64);
    const int r4 = lane >> 4, c16 = lane & 15;
    for (int t = ((gw - tc) % ngw + ngw) % ngw; t < ntile; t += ngw) {
        const int kt = t / nnt, nt = t % nnt, k0 = kt * 64, nn0 = nt * 64;
        f32x4 v[16];
#pragma unroll
        for (int i = 0; i < 16; ++i) v[i] = gld<f32x4>(src + (size_t)(k0 + r4 + 4 * i) * ldn + n0 + nn0 + 4 * c16);
#pragma unroll
        for (int i = 0; i < 16; ++i) { const int kk = r4 + 4 * i; const float sc = rs ? scale * gld<float>(rs + k0 + kk) : scale; float* tp = T + kk * 65 + 4 * c16;
            tp[0] = v[i].x * sc; tp[1] = v[i].y * sc; tp[2] = v[i].z * sc; tp[3] = v[i].w * sc; }
        __builtin_amdgcn_wave_barrier();
#pragma unroll
        for (int j = 0; j < 8; ++j) { const int nn = (lane >> 3) + 8 * j, kc = (lane & 7) * 8; const float* tp = T + kc * 65 + nn; u32x4 o;
            o.x = cvt_pk_bf16(tp[0], tp[65]); o.y = cvt_pk_bf16(tp[2 * 65], tp[3 * 65]); o.z = cvt_pk_bf16(tp[4 * 65], tp[5 * 65]); o.w = cvt_pk_bf16(tp[6 * 65], tp[7 * 65]);
            st16(dst, ((size_t)(nn0 + nn) * ldd + k0 + kc) * 2, o, wt); }
        __builtin_amdgcn_wave_barrier();
    }
    tc += ntile;
}

__device__ __forceinline__ void conv_inproj(unsigned char* lds, const Params& p, int l, int& tc, const bool wt = true) {
    unsigned char* wsl = p.ws; asm volatile("" : "+s"(wsl));
    bf16_t* W = (bf16_t*)(wsl + WS_WIN);
    const int i = l >> 1;
    if ((l & 1) == 0) {
        const float* src = p.in[3] + (size_t)i * 1024 * 6144; const float* g = p.in[2] + i * 1024;
        conv_job(lds, src, 6144, 0, 1024, 1024, W, g, 0.125f * 1.4426950408889634f, tc, WIN_LD, wt);
        conv_job(lds, src, 6144, 1024, 3072, 1024, W + (size_t)1024 * WIN_LD, g, 1.0f, tc, WIN_LD, wt);
        conv_job(lds, src, 6144, 5120, 1024, 1024, W + (size_t)4096 * WIN_LD, g, 1.0f, tc, WIN_LD, wt);
    } else {
        const float* src = p.in[8] + (size_t)i * 1024 * 4096; const float* g = p.in[7] + i * 1024;
        conv_job(lds, src, 4096, 0, 4096, 1024, W, g, 1.0f, tc, WIN_LD, wt);
    }
}

template <class Epi>
__device__ __forceinline__ void ngemm(unsigned char* lds, const bf16_t* A1, const bf16_t* A2, int K1, int lda, const bf16_t* Bt, int Mrows, int N, int K, const Epi& E) {
    float* As = (float*)lds;
    float* Bs = As + 32 * 68;
    const int tid = tid_l(), tx = tid & 31, ty = tid >> 5;
    const int ntm = Mrows / 64, ntn = N / 256;
    for (int tile = blockIdx.x; tile < ntm * ntn; tile += gridDim.x) {
        const int tm = tile % ntm, tn = tile / ntm;
        float acc[4][8];
#pragma unroll
        for (int r = 0; r < 4; ++r)
#pragma unroll
            for (int j = 0; j < 8; ++j) acc[r][j] = 0.f;
        for (int k0 = 0; k0 < K; k0 += 32) {
            { const int r = tid >> 3, kc = (tid & 7) * 4;
              const bf16_t* ap = (k0 < K1) ? (A1 + (size_t)(tm * 64 + r) * lda + k0 + kc) : (A2 + (size_t)(tm * 64 + r) * lda + (k0 - K1) + kc);
              const u32x2 w = *(const u32x2*)ap;
              As[(kc + 0) * 68 + r] = __uint_as_float(w.x << 16); As[(kc + 1) * 68 + r] = __uint_as_float(w.x & 0xffff0000u);
              As[(kc + 2) * 68 + r] = __uint_as_float(w.y << 16); As[(kc + 3) * 68 + r] = __uint_as_float(w.y & 0xffff0000u); }
            { const int n = tid >> 1, kc = (tid & 1) * 16;
              const bf16_t* bp = Bt + (size_t)(tn * 256 + n) * K + k0 + kc;
#pragma unroll
              for (int h = 0; h < 2; ++h) { const u32x4 w = *(const u32x4*)(bp + 8 * h); const int kk = kc + 8 * h;
                  Bs[(kk + 0) * 260 + n] = __uint_as_float(w.x << 16); Bs[(kk + 1) * 260 + n] = __uint_as_float(w.x & 0xffff0000u);
                  Bs[(kk + 2) * 260 + n] = __uint_as_float(w.y << 16); Bs[(kk + 3) * 260 + n] = __uint_as_float(w.y & 0xffff0000u);
                  Bs[(kk + 4) * 260 + n] = __uint_as_float(w.z << 16); Bs[(kk + 5) * 260 + n] = __uint_as_float(w.z & 0xffff0000u);
                  Bs[(kk + 6) * 260 + n] = __uint_as_float(w.w << 16); Bs[(kk + 7) * 260 + n] = __uint_as_float(w.w & 0xffff0000u); } }
            __syncthreads();
#pragma unroll 8
            for (int k = 0; k < 32; ++k) {
                const f32x4 a = *(const f32x4*)(As + k * 68 + ty * 4);
                float b[8];
#pragma unroll
                for (int j = 0; j < 8; ++j) b[j] = Bs[k * 260 + tx + 32 * j];
#pragma unroll
                for (int j = 0; j < 8; ++j) { acc[0][j] += a.x * b[j]; acc[1][j] += a.y * b[j]; acc[2][j] += a.z * b[j]; acc[3][j] += a.w * b[j]; }
            }
            __syncthreads();
        }
#pragma unroll
        for (int r = 0; r < 4; ++r) E.row(tm * 64 + ty * 4 + r, tn * 256 + tx, acc[r]);
    }
}

namespace pg8 {
#define PG8_LAS __attribute__((address_space(3)))
typedef short bf16x8 __attribute__((ext_vector_type(8)));
constexpr int BM = 256, BK = 64, HALF = 128, HTB = HALF * BK * 2, STAGE_BYTES = 8 * HTB, NXCD = 8, WGM = 8;
__host__ __device__ __forceinline__ int lds_byte(int r, int c) { const int st = (r >> 4) * 2 + (c >> 5), rr = r & 15, cc = c & 31, ob = rr * 64 + cc * 2; return st * 1024 + (ob ^ (((ob >> 9) & 1) << 5)); }
__host__ __device__ __forceinline__ void stage_rc(int b, int& R, int& C) { const int st = b / 1024, sb = b % 1024, swz = sb ^ (((sb >> 9) & 1) << 5); R = (st >> 1) * 16 + swz / 64; C = (st & 1) * 32 + (swz % 64) / 2; }
__host__ __device__ __forceinline__ int perm32(int rho) { const int n = rho >> 4, i = rho & 15; return 8 * (i >> 2) + 4 * n + (i & 3); }
struct Unit { int pm, pn; };
struct Gemm { const bf16_t* A1; const bf16_t* A2; int nt1; int lda; const bf16_t* Bt; int M, N, K; int a_grp, a_skip, b_grp, b_skip; int vG, vc; int ldb; const bf16_t* Bt2; int nsplit; };
struct StaticOrder {
    int nM, nN, nwg, G, c;
    __device__ void init(int M_, int N_, int G_, int c_) { nM = M_ / BM; nN = N_ / BM; nwg = nM * nN; G = G_; c = c_; }
    __device__ bool next(int i, Unit& u) const {
        const long L = (long)i * G + c; if (L >= nwg) return false;
        int wgid = (int)L; { const int q = nwg / NXCD, r = nwg % NXCD, xcd = wgid % NXCD, off = wgid / NXCD; wgid = (xcd < r ? xcd * (q + 1) : r * (q + 1) + (xcd - r) * q) + off; }
        const int nig = WGM * nN, gid = wgid / nig, fm = gid * WGM, gsz = (nM - fm) < WGM ? (nM - fm) : WGM;
        u.pm = fm + ((wgid % nig) % gsz); u.pn = (wgid % nig) / gsz; return true;
    }
};
__device__ __forceinline__ int static_unit(int M_, int N_, int G, int c, int i) {
    const int nM = M_ / BM, nN = N_ / BM, nwg = nM * nN; const long L = (long)i * G + c; if (L >= nwg) return -1;
    int wgid = (int)L; { const int q = nwg / NXCD, r = nwg % NXCD, xcd = wgid % NXCD, off = wgid / NXCD; wgid = (xcd < r ? xcd * (q + 1) : r * (q + 1) + (xcd - r) * q) + off; }
    const int nig = WGM * nN, gid = wgid / nig, fm = gid * WGM, gsz = (nM - fm) < WGM ? (nM - fm) : WGM;
    return (fm + ((wgid % nig) % gsz)) * 65536 + (wgid % nig) / gsz;
}
struct NoEpi {};
struct Trail { const bf16_t* A; const bf16_t* Bt; int nt; int ldb; };
template <class T> struct is_noepi { static constexpr bool v = false; };
template <> struct is_noepi<NoEpi> { static constexpr bool v = true; };
template <class Epi, bool TAIL = true, class Epi2 = NoEpi>
__device__ __forceinline__ void gemm_phase(PG8_LAS unsigned char* lds, const Gemm g, const Epi& E, const Trail tr = Trail{nullptr, nullptr, 0, 0}, const Epi2& E2 = Epi2{}) {
    constexpr bool HT = !is_noepi<Epi2>::v;
    const int tid = tid_l(), wid = __builtin_amdgcn_readfirstlane(tid >> 6), lane = tid & 63, wr = wid >> 2, wc = wid & 3, fr = lane & 15, fq = lane >> 4;
    if (g.vG > 0 && g.vc < 0) return;
    StaticOrder S; S.init(g.M, g.N, g.vG > 0 ? g.vG : (int)gridDim.x, g.vG > 0 ? g.vc : bid_l());
    const int K = g.K, nt = K / BK, nt1 = g.nt1;
    unsigned voffA[2], voffB[2], voffB2[2];
#pragma unroll
    for (int i = 0; i < 2; ++i) { int R, C; stage_rc(tid * 16 + i * 8192, R, C); const int Rb = (R & ~31) + perm32(R & 31);
        voffA[i] = (unsigned)(R * g.lda + C) * 2u; voffB[i] = (unsigned)(Rb * g.ldb + C) * 2u; voffB2[i] = HT ? (unsigned)(Rb * tr.ldb + C) * 2u : 0u; }
    const size_t kstep = (size_t)(BK * 2);
    const size_t hstepA = (size_t)HALF * g.lda * 2, tstepA = 2 * hstepA;
    const size_t hstepB = (size_t)HALF * g.ldb * 2, tstepB = 2 * hstepB;
    const size_t hstepB2 = HT ? (size_t)HALF * tr.ldb * 2 : hstepB;
    const unsigned ldsw = (unsigned)wid * 1024u;
    const int aoff = lds_byte(wr * 64 + fr, fq * 8), boff = lds_byte(wc * 32 + fr, fq * 8);
#define PG8_SA(b, h) (((b) * 2 + (h)) * HTB)
#define PG8_SB(b, h) ((4 + (b) * 2 + (h)) * HTB)
#define PG8_STAGE(bufoff, gbase, voff) do { _Pragma("unroll") for (int _i = 0; _i < 2; ++_i) \
        __builtin_amdgcn_global_load_lds((const unsigned*)((const char*)(gbase) + (voff)[_i]), (PG8_LAS unsigned*)(lds + (bufoff) + ldsw + _i * 8192), 16, 0, 0); } while (0)
#define PG8_STAGEB(bufoff, gbase, istr) do { _Pragma("unroll") for (int _i = 0; _i < 2; ++_i) \
        __builtin_amdgcn_global_load_lds((const unsigned*)((const char*)(gbase) + ((HT && (istr)) ? voffB2[_i] : voffB[_i])), (PG8_LAS unsigned*)(lds + (bufoff) + ldsw + _i * 8192), 16, 0, 0); } while (0)
#define PG8_LDA(dst, b, h) do { _Pragma("unroll") for (int m = 0; m < 4; ++m) _Pragma("unroll") for (int k = 0; k < 2; ++k) dst[m][k] = *(const PG8_LAS bf16x8*)(lds + PG8_SA(b, h) + aoff + m * 2048 + k * 1024); } while (0)
#define PG8_LDB(dst, b, h) do { _Pragma("unroll") for (int n = 0; n < 2; ++n) _Pragma("unroll") for (int k = 0; k < 2; ++k) dst[n][k] = *(const PG8_LAS bf16x8*)(lds + PG8_SB(b, h) + boff + n * 2048 + k * 1024); } while (0)
#define PG8_MMA(ai, bj, At, Bt) do { __builtin_amdgcn_s_setprio(1); _Pragma("unroll") for (int m = 0; m < 4; ++m) _Pragma("unroll") for (int n = 0; n < 2; ++n) _Pragma("unroll") for (int k = 0; k < 2; ++k) \
        acc[ai][bj][m][n] = __builtin_amdgcn_mfma_f32_16x16x32_bf16(Bt[n][k], At[m][k], acc[ai][bj][m][n], 0, 0, 0); __builtin_amdgcn_s_setprio(0); } while (0)
#define PG8_WAIT_V(n) asm volatile("s_waitcnt vmcnt(" #n ")" ::: "memory")
#define PG8_WAIT_L(n) asm volatile("s_waitcnt lgkmcnt(" #n ")" ::: "memory")
#define PG8_BAR __builtin_amdgcn_s_barrier()
#define PG8_SCHED __builtin_amdgcn_sched_barrier(0)
    Unit cur, nxt; int ui = 0;
    if (!S.next(0, cur)) return;
    PG8_LAS float* rtab = (PG8_LAS float*)(lds + 139264);
    if constexpr (Epi::HAS_ROWSCALE) {
        Unit tu;
        for (int i = 0; i < 4 && S.next(i, tu); ++i) if (tid < 256) rtab[i * 256 + tid] = E.row_scale(tu.pm * 256 + tid);
        asm volatile("s_waitcnt vmcnt(0) lgkmcnt(0)" ::: "memory"); __builtin_amdgcn_s_barrier();
    }
    f32x4 acc[2][2][4][2];
#pragma unroll
    for (int a = 0; a < 2; ++a)
#pragma unroll
        for (int b = 0; b < 2; ++b)
#pragma unroll
            for (int m = 0; m < 4; ++m)
#pragma unroll
                for (int n = 0; n < 2; ++n) acc[a][b][m][n] = (f32x4){0.f, 0.f, 0.f, 0.f};
    bf16x8 At[4][2], B0[2][2], B1[2][2];
#define PG8_TA(pm_) ((size_t)((pm_) + ((pm_) / g.a_grp) * g.a_skip) * tstepA)
#define PG8_TB(pn_) ((size_t)((pn_) + ((pn_) / g.b_grp) * g.b_skip) * tstepB)
#define PG8_BP(pn_) ((pn_) < g.nsplit ? (const char*)g.Bt + PG8_TB(pn_) : (const char*)g.Bt2 + PG8_TB((pn_) - g.nsplit))
    const char* cA1 = (const char*)g.A1 + PG8_TA(cur.pm); const char* cA2 = (const char*)g.A2 + PG8_TA(cur.pm) - (size_t)nt1 * kstep; const char* cB = PG8_BP(cur.pn);
    PG8_STAGE(PG8_SB(0, 0), cB, voffB); PG8_STAGE(PG8_SB(0, 1), cB + hstepB, voffB); PG8_STAGE(PG8_SA(0, 0), cA1, voffA); PG8_STAGE(PG8_SA(0, 1), cA1 + hstepA, voffA);
    if (wr == 1) PG8_BAR;
    PG8_WAIT_V(2); PG8_BAR;
    PG8_STAGE(PG8_SB(1, 0), cB + kstep, voffB); PG8_STAGE(PG8_SA(1, 0), cA1 + kstep, voffA); PG8_STAGE(PG8_SB(1, 1), cB + hstepB + kstep, voffB);
    PG8_WAIT_V(6); PG8_BAR;
    bool cur_tr = false; int cnt = nt, cnt1 = nt1;
    for (;;) {
        bool has_next = S.next(ui + 1, nxt); bool nxt_tr = false;
        if constexpr (HT) { if (cur_tr) has_next = false; else if (!has_next) { has_next = true; nxt_tr = true; } }
        const char* nA1 = has_next ? (nxt_tr ? (const char*)tr.A : (const char*)g.A1 + PG8_TA(nxt.pm)) : cA1;
        const char* nA2 = has_next ? (nxt_tr ? (const char*)tr.A : (const char*)g.A2 + PG8_TA(nxt.pm) - (size_t)nt1 * kstep) : cA2;
        const char* nB = has_next ? (nxt_tr ? (const char*)tr.Bt : PG8_BP(nxt.pn)) : cB;
        for (int t = 0; t < cnt; t += 2) {
            const bool last = (t == cnt - 2);
            const bool btr = last ? (has_next ? nxt_tr : cur_tr) : cur_tr;
            const char* a1 = ((t + 1 < cnt1) ? cA1 : cA2) + (size_t)(t + 1) * kstep;
            const char* a2 = last ? nA1 : ((t + 2 < cnt1) ? cA1 : cA2) + (size_t)(t + 2) * kstep; const char* b2 = last ? nB : cB + (size_t)(t + 2) * kstep;
            const char* a3 = a2 + kstep; const char* b3 = b2 + kstep;
            const bool tail = TAIL && last && !has_next;
            PG8_LDB(B0, 0, 0); PG8_LDB(B1, 0, 1); PG8_SCHED; PG8_LDA(At, 0, 0); PG8_STAGE(PG8_SA(1, 1), a1 + hstepA, voffA);
            PG8_WAIT_V(8); PG8_WAIT_L(0); PG8_BAR; PG8_MMA(0, 0, At, B0); PG8_MMA(0, 1, At, B1); PG8_BAR; PG8_SCHED;
            PG8_LDA(At, 0, 1);
            if (!tail) { PG8_STAGEB(PG8_SB(0, 0), b2, btr); PG8_STAGEB(PG8_SB(0, 1), b2 + (btr ? hstepB2 : hstepB), btr); PG8_STAGE(PG8_SA(0, 0), a2, voffA); PG8_WAIT_V(8); } else { PG8_WAIT_V(2); }
            PG8_WAIT_L(0); PG8_BAR; PG8_MMA(1, 0, At, B0); PG8_MMA(1, 1, At, B1); PG8_BAR; PG8_SCHED;
            PG8_LDB(B0, 1, 0); PG8_LDB(B1, 1, 1); PG8_SCHED; PG8_LDA(At, 1, 0);
            if (!tail) { PG8_STAGE(PG8_SA(0, 1), a2 + hstepA, voffA); PG8_WAIT_V(8); } else { PG8_WAIT_V(0); }
            PG8_WAIT_L(0); PG8_BAR; PG8_MMA(0, 0, At, B0); PG8_MMA(0, 1, At, B1); PG8_BAR; PG8_SCHED;
            PG8_LDA(At, 1, 1);
            if (!tail) { PG8_STAGEB(PG8_SB(1, 0), b3, btr); PG8_STAGEB(PG8_SB(1, 1), b3 + (btr ? hstepB2 : hstepB), btr); PG8_STAGE(PG8_SA(1, 0), a3, voffA); PG8_WAIT_V(8); }
            PG8_WAIT_L(0); PG8_BAR; PG8_MMA(1, 0, At, B0); PG8_MMA(1, 1, At, B1); PG8_BAR; PG8_SCHED;
        }
        if (wr == 0) PG8_BAR;
#ifndef EPI_REP
#define EPI_REP 1
#endif
        if (HT && cur_tr) { if constexpr (HT) { Unit z; z.pm = 0; z.pn = 0; E2(acc, z, wr, wc, fr, fq); } }
        else if constexpr (Epi::MUTATES) { E.mut(acc, cur, wr, wc, fr, fq); }
        else if constexpr (Epi::HAS_ROWSCALE) { E.scaled(acc, cur, wr, wc, fr, fq, ui < 4 ? rtab + ui * 256 : (PG8_LAS float*)nullptr, !has_next); }
        else if constexpr (Epi::HAS_FUSED) { if (has_next) E(acc, cur, wr, wc, fr, fq); } else { E(acc, cur, wr, wc, fr, fq); if constexpr (Epi::IDEMPOTENT && EPI_REP > 1) { int er_ = 1; asm volatile("" : "+s"(er_)); if (er_) E(acc, cur, wr, wc, fr, fq); } }
        if (!has_next) break;
#pragma unroll
        for (int a = 0; a < 2; ++a)
#pragma unroll
            for (int b = 0; b < 2; ++b)
#pragma unroll
                for (int m = 0; m < 4; ++m)
#pragma unroll
                    for (int n = 0; n < 2; ++n) acc[a][b][m][n] = (f32x4){0.f, 0.f, 0.f, 0.f};
        cur = nxt; cA1 = nA1; cA2 = nA2; cB = nB; ++ui;
        if constexpr (HT) { cur_tr = nxt_tr; if (cur_tr) { cnt = tr.nt; cnt1 = tr.nt; } }
        if (wr == 1) PG8_BAR;
    }
    PG8_WAIT_V(0);
    PG8_BAR;
    if constexpr (Epi::HAS_FUSED) E.fused(acc, cur, wr, wc, fr, fq, lds);
#undef PG8_TA
#undef PG8_TB
#undef PG8_BP
#undef PG8_SA
#undef PG8_SB
#undef PG8_STAGE
#undef PG8_STAGEB
#undef PG8_LDA
#undef PG8_LDB
#undef PG8_MMA
#undef PG8_WAIT_V
#undef PG8_WAIT_L
#undef PG8_BAR
#undef PG8_SCHED
}
}
typedef f32x4 AccT[2][2][4][2];

__device__ __forceinline__ u32x4 pack8(const f32x4 a, const f32x4 b) { u32x4 w; w.x = cvt_pk_bf16(a.x, a.y); w.y = cvt_pk_bf16(a.z, a.w); w.z = cvt_pk_bf16(b.x, b.y); w.w = cvt_pk_bf16(b.z, b.w); return w; }
struct EpiProj {
    static constexpr bool MUTATES = false;
    static constexpr bool HAS_ROWSCALE = true;
    static constexpr bool IDEMPOTENT = true;
    static constexpr bool HAS_FUSED = false;
    bf16_t* dst0; size_t seg_stride; const float* RS; unsigned silu_bits; float* LNS; int lns_seg; int use_rstd; int pitch; unsigned char* scr; unsigned hm_bits = 0u; bf16_t* seg0 = nullptr;
    __device__ __forceinline__ void row(int row, int colbase, float (&v)[8]) const {
        const float rs = use_rstd ? rstd_of(RS, row) : 1.0f;
        float s0 = 0.f, q0 = 0.f;
#pragma unroll
        for (int j = 0; j < 8; ++j) {
            const int col = colbase + 32 * j, seg = col >> 10, c = col & 1023;
            float x = v[j] * rs;
            s0 += x; q0 += x * x;
            if ((silu_bits >> (2 * seg + (c >> 9))) & 1u) x = silu_f(x);
            dst0[(size_t)seg * seg_stride + (((hm_bits >> seg) & 1u) ? ((size_t)(((row >> 11) * 16 + (c >> 6)) * 2048 + (row & 2047)) * 64 + (c & 63)) : ((size_t)row * pitch + c))] = f2bf(x);
        }
        if (LNS) {
            const int seg = colbase >> 10;
            if (seg == lns_seg) {
                s0 = half_sum32(s0); q0 = half_sum32(q0);
                if ((threadIdx.x & 31) == 0) { const int slot = (colbase & 1023) >> 8; LNS[(size_t)slot * M + row] = s0; LNS[(size_t)(4 + slot) * M + row] = q0; }
            }
        }
    }
    __device__ __forceinline__ float row_scale(int row) const { return use_rstd ? rstd_of(RS, row) : 1.0f; }
    __device__ __forceinline__ void operator()(const AccT& acc, const pg8::Unit& u, int wr, int wc, int fr, int fq) const { scaled(acc, u, wr, wc, fr, fq, (PG8_LAS float*)nullptr, true); }
    __device__ __forceinline__ void scaled(const AccT& acc, const pg8::Unit& u, int wr, int wc, int fr, int fq, PG8_LAS float* rtab, const bool wt) const {
        const int colt = u.pn * 256, seg = colt >> 10, cb = (colt & 1023) + wc * 32 + 8 * fq, row0 = u.pm * 256 + wr * 64 + fr;
        bf16_t* base = (seg == 0 && seg0) ? seg0 : dst0 + (size_t)seg * seg_stride;
        const bool st = (LNS != nullptr) && (seg == lns_seg);
        const bool act = (silu_bits >> (2 * seg + ((colt & 1023) >> 9))) & 1u;
        const bool hm = (hm_bits >> seg) & 1u;
        PG8_LAS float* P = (PG8_LAS float*)scr;
#pragma unroll
        for (int ai = 0; ai < 2; ++ai)
#pragma unroll
            for (int m = 0; m < 4; ++m) {
                const int row = row0 + ai * 128 + m * 16; const float rs = rtab ? rtab[ai * 128 + wr * 64 + m * 16 + fr] : row_scale(row);
                float s = 0.f, q = 0.f;
#pragma unroll
                for (int bj = 0; bj < 2; ++bj) {
                    f32x4 v0 = acc[ai][bj][m][0] * rs, v1 = acc[ai][bj][m][1] * rs;
                    if (st) { s += (v0.x + v0.y) + (v0.z + v0.w) + (v1.x + v1.y) + (v1.z + v1.w);
                              q += (v0.x * v0.x + v0.y * v0.y) + (v0.z * v0.z + v0.w * v0.w) + (v1.x * v1.x + v1.y * v1.y) + (v1.z * v1.z + v1.w * v1.w); }
                    if (act) { v0.x = fsilu(v0.x); v0.y = fsilu(v0.y); v0.z = fsilu(v0.z); v0.w = fsilu(v0.w); v1.x = fsilu(v1.x); v1.y = fsilu(v1.y); v1.z = fsilu(v1.z); v1.w = fsilu(v1.w); }
                    { const int c_ = cb + 128 * bj; const size_t off_ = hm ? ((size_t)(((row >> 11) * 16 + (c_ >> 6)) * 2048 + (row & 2047)) * 64 + (c_ & 63)) : ((size_t)row * pitch + c_);
                      if (wt) wst16(base, off_ * 2, pack8(v0, v1)); else gst<u32x4>((unsigned char*)base + off_ * 2, pack8(v0, v1)); }
                }
                if (st) { s = quad_rows_sum(s); q = quad_rows_sum(q);
                          if (fq == 0) { const int rl = ai * 128 + wr * 64 + m * 16 + fr; P[(rl * 4 + wc) * 2] = s; P[(rl * 4 + wc) * 2 + 1] = q; } }
            }
        if (st) {
            asm volatile("s_waitcnt lgkmcnt(0)" ::: "memory"); __builtin_amdgcn_s_barrier(); asm volatile("" ::: "memory");
            const int t = (wr * 4 + wc) * 64 + fr + 16 * fq;
            if (t < 256) { const float s = (P[(t * 4 + 0) * 2] + P[(t * 4 + 1) * 2]) + (P[(t * 4 + 2) * 2] + P[(t * 4 + 3) * 2]);
                           const float q = (P[(t * 4 + 0) * 2 + 1] + P[(t * 4 + 1) * 2 + 1]) + (P[(t * 4 + 2) * 2 + 1] + P[(t * 4 + 3) * 2 + 1]);
                           const int slot = (colt & 1023) >> 8; gst<float>(LNS + (size_t)slot * M + u.pm * 256 + t, s); gst<float>(LNS + (size_t)(4 + slot) * M + u.pm * 256 + t, q); }
        }
    }
};
struct EpiKV {
    static constexpr bool MUTATES = false;
    static constexpr bool HAS_ROWSCALE = false;
    static constexpr bool IDEMPOTENT = true;
    static constexpr bool HAS_FUSED = false;
    bf16_t* dst;
    __device__ __forceinline__ void row(int row, int colbase, float (&v)[8]) const {
#pragma unroll
        for (int j = 0; j < 8; ++j) { const int col = colbase + 32 * j; dst[(size_t)(col >> 11) * MM * 2048 + (size_t)row * 2048 + (col & 2047)] = f2bf(v[j]); }
    }
    __device__ __forceinline__ void operator()(const AccT& acc, const pg8::Unit& u, int wr, int wc, int fr, int fq) const {
        const int l = u.pn >> 3, cb = (u.pn & 7) * 256 + wc * 32 + 8 * fq, row0 = u.pm * 256 + wr * 64 + fr;
        bf16_t* base = dst + (size_t)l * MM * 2048;
#pragma unroll
        for (int ai = 0; ai < 2; ++ai)
#pragma unroll
            for (int m = 0; m < 4; ++m) { const int row = row0 + ai * 128 + m * 16;
#pragma unroll
                for (int bj = 0; bj < 2; ++bj) *(u32x4*)(base + (size_t)row * 2048 + cb + 128 * bj) = pack8(acc[ai][bj][m][0], acc[ai][bj][m][1]); }
    }
};
struct EpiGateA {
    static constexpr bool MUTATES = false;
    static constexpr bool HAS_ROWSCALE = false;
    static constexpr bool IDEMPOTENT = false;
    static constexpr bool HAS_FUSED = false;
    bf16_t* A0; const float* RS; int dry; bool wt = true;
    __device__ __forceinline__ void row(int row, int colbase, float (&v)[8]) const {
        const float rs = rstd_of(RS, row);
#pragma unroll
        for (int j = 0; j < 8; ++j) { bf16_t* q = A0 + (size_t)row * 1024 + colbase + 32 * j; *q = f2bf(bf2f(*q) * silu_f(v[j] * rs)); }
    }
    __device__ __forceinline__ void operator()(const AccT& acc, const pg8::Unit& u, int wr, int wc, int fr, int fq) const {
        const int cb = u.pn * 256 + wc * 32 + 8 * fq, row0 = u.pm * 256 + wr * 64 + fr;
#pragma unroll
        for (int ai = 0; ai < 2; ++ai) {
            float rsv[4]; u32x4 av[4][2];
#pragma unroll
            for (int m = 0; m < 4; ++m) { const int row = row0 + ai * 128 + m * 16; rsv[m] = rstd_of(RS, row);
#pragma unroll
                for (int bj = 0; bj < 2; ++bj) av[m][bj] = gld<u32x4>(A0 + (size_t)row * 1024 + cb + 128 * bj); }
#pragma unroll
            for (int m = 0; m < 4; ++m) {
                const int row = row0 + ai * 128 + m * 16; const float rs = rsv[m];
#pragma unroll
                for (int bj = 0; bj < 2; ++bj) {
                    f32x4 g0 = acc[ai][bj][m][0] * rs, g1 = acc[ai][bj][m][1] * rs;
                    g0.x = fsilu(g0.x); g0.y = fsilu(g0.y); g0.z = fsilu(g0.z); g0.w = fsilu(g0.w); g1.x = fsilu(g1.x); g1.y = fsilu(g1.y); g1.z = fsilu(g1.z); g1.w = fsilu(g1.w);
                    const size_t off = (size_t)row * 1024 + cb + 128 * bj;
                    const u32x4 a = av[m][bj];
                    const f32x4 o0 = (f32x4){bflo(a.x) * g0.x, bfhi(a.x) * g0.y, bflo(a.y) * g0.z, bfhi(a.y) * g0.w}, o1 = (f32x4){bflo(a.z) * g1.x, bfhi(a.z) * g1.y, bflo(a.w) * g1.z, bfhi(a.w) * g1.w};
                    if (!dry) st16(A0, off * 2, pack8(o0, o1), wt);
                }
            }
        }
    }
};
__device__ __forceinline__ float poolop(const bf16_t* U, int row, int c) {
    const int w = 2 << (c >> 8), t = row & (SEQ - 1), n = (t + 1 < w) ? (t + 1) : w;
    float s = 0.f;
    for (int i = 0; i < n; ++i) s += bf2f(U[(size_t)(row - i) * 1024 + c]);
    return s / (float)n - bf2f(U[(size_t)row * 1024 + c]);
}
struct EpiGateB {
    static constexpr bool MUTATES = false;
    static constexpr bool HAS_ROWSCALE = false;
    static constexpr bool IDEMPOTENT = false;
    static constexpr bool HAS_FUSED = true;
    bf16_t* A1; const bf16_t* U; const float* RS; int dry;
    __device__ __forceinline__ void row(int row, int colbase, float (&v)[8]) const {
        const float rs = rstd_of(RS, row);
#pragma unroll
        for (int j = 0; j < 8; ++j) { const int c = colbase + 32 * j; A1[(size_t)row * 1024 + c] = f2bf(poolop(U, row, c) * silu_f(v[j] * rs)); }
    }
    __device__ __forceinline__ void operator()(const AccT& acc, const pg8::Unit& u, int wr, int wc, int fr, int fq) const {
        const int cb = u.pn * 256 + wc * 32 + 8 * fq, row0 = u.pm * 256 + wr * 64 + fr, w = 2 << u.pn;
#pragma unroll
        for (int ai = 0; ai < 2; ++ai)
#pragma unroll
            for (int m = 0; m < 4; ++m) {
                const int row = row0 + ai * 128 + m * 16; const float rs = rstd_of(RS, row);
#pragma unroll
                for (int bj = 0; bj < 2; ++bj) {
                    f32x4 g0 = acc[ai][bj][m][0] * rs, g1 = acc[ai][bj][m][1] * rs;
                    g0.x = fsilu(g0.x); g0.y = fsilu(g0.y); g0.z = fsilu(g0.z); g0.w = fsilu(g0.w); g1.x = fsilu(g1.x); g1.y = fsilu(g1.y); g1.z = fsilu(g1.z); g1.w = fsilu(g1.w);
                    const size_t off = (size_t)row * 1024 + cb + 128 * bj;
                    const int t = row & (SEQ - 1), n = (t + 1 < w) ? (t + 1) : w;
                    const u32x4 c = gld<u32x4>(U + off);
                    f32x4 s0 = (f32x4){bflo(c.x), bfhi(c.x), bflo(c.y), bfhi(c.y)}, s1 = (f32x4){bflo(c.z), bfhi(c.z), bflo(c.w), bfhi(c.w)};
                    const f32x4 c0 = s0, c1 = s1;
                    for (int i = 1; i < w; ++i) if (i <= t) { const u32x4 a = gld<u32x4>(U + off - (size_t)i * 1024);
                        s0 += (f32x4){bflo(a.x), bfhi(a.x), bflo(a.y), bfhi(a.y)}; s1 += (f32x4){bflo(a.z), bfhi(a.z), bflo(a.w), bfhi(a.w)}; }
                    const float inv = 1.0f / (float)n;
                    if (!dry) wst16(A1, off * 2, pack8((s0 * inv - c0) * g0, (s1 * inv - c1) * g1));
                }
            }
    }
    __device__ __forceinline__ void fused(const AccT& acc, const pg8::Unit& u, int wr, int wc, int fr, int fq, PG8_LAS unsigned char* lds) const {
        const int R0 = u.pm * 256, C0 = u.pn * 256, w = 2 << u.pn, tid = (wr * 4 + wc) * 64 + fr + 16 * fq;
        const int tb = R0 & (SEQ - 1);
        float rsv[2][4];
#pragma unroll
        for (int ai = 0; ai < 2; ++ai)
#pragma unroll
            for (int m = 0; m < 4; ++m) rsv[ai][m] = rstd_of(RS, R0 + ai * 128 + wr * 64 + m * 16 + fr);
        for (int id = tid; id < 271 * 32; id += NT) { const int rl = id >> 5, ch = id & 31;
            if (rl >= 15 || tb != 0) *(PG8_LAS u32x4*)(lds + rl * 528 + ch * 16) = gld<u32x4>(U + (size_t)(R0 - 15 + rl) * 1024 + C0 + ch * 8); }
        asm volatile("s_waitcnt vmcnt(0) lgkmcnt(0)" ::: "memory"); __builtin_amdgcn_s_barrier(); asm volatile("" ::: "memory");
#pragma unroll
        for (int ai = 0; ai < 2; ++ai)
#pragma unroll
            for (int m = 0; m < 4; ++m) {
                const int rloc = ai * 128 + wr * 64 + m * 16 + fr, row = R0 + rloc; const float rs = rsv[ai][m];
                const int t = row & (SEQ - 1), n = (t + 1 < w) ? (t + 1) : w;
                const float inv = 1.0f / (float)n;
#pragma unroll
                for (int bj = 0; bj < 2; ++bj) {
                    f32x4 g0 = acc[ai][bj][m][0] * rs, g1 = acc[ai][bj][m][1] * rs;
                    g0.x = fsilu(g0.x); g0.y = fsilu(g0.y); g0.z = fsilu(g0.z); g0.w = fsilu(g0.w); g1.x = fsilu(g1.x); g1.y = fsilu(g1.y); g1.z = fsilu(g1.z); g1.w = fsilu(g1.w);
                    const PG8_LAS unsigned char* lp = lds + (15 + rloc) * 528 + (128 * bj + wc * 32 + 8 * fq) * 2;
                    const u32x4 c = *(const PG8_LAS u32x4*)lp;
                    f32x4 s0 = (f32x4){bflo(c.x), bfhi(c.x), bflo(c.y), bfhi(c.y)}, s1 = (f32x4){bflo(c.z), bfhi(c.z), bflo(c.w), bfhi(c.w)};
                    const f32x4 c0 = s0, c1 = s1;
                    for (int i = 1; i < n; ++i) { const u32x4 a = *(const PG8_LAS u32x4*)(lp - i * 528);
                        s0 += (f32x4){bflo(a.x), bfhi(a.x), bflo(a.y), bfhi(a.y)}; s1 += (f32x4){bflo(a.z), bfhi(a.z), bflo(a.w), bfhi(a.w)}; }
                    if (!dry) wst16(A1, ((size_t)row * 1024 + C0 + 128 * bj + wc * 32 + 8 * fq) * 2, pack8((s0 * inv - c0) * g0, (s1 * inv - c1) * g1));
                }
            }
    }
};
struct EpiGates {
    static constexpr bool MUTATES = false;
    static constexpr bool HAS_ROWSCALE = false;
    static constexpr bool IDEMPOTENT = false;
    static constexpr bool HAS_FUSED = true;
    EpiGateA ga; EpiGateB gb;
    __device__ __forceinline__ void row(int row, int colbase, float (&v)[8]) const { if (colbase < 1024) ga.row(row, colbase, v); else gb.row(row, colbase - 1024, v); }
    __device__ __forceinline__ void operator()(const AccT& acc, const pg8::Unit& u, int wr, int wc, int fr, int fq) const {
        if (u.pn < 4) { EpiGateA g2 = ga; g2.wt = false; g2(acc, u, wr, wc, fr, fq); }
        else { pg8::Unit v; v.pm = u.pm; v.pn = u.pn - 4; gb(acc, v, wr, wc, fr, fq); }
    }
    __device__ __forceinline__ void fused(const AccT& acc, const pg8::Unit& u, int wr, int wc, int fr, int fq, PG8_LAS unsigned char* lds) const {
        if (u.pn < 4) ga(acc, u, wr, wc, fr, fq);
        else { pg8::Unit v; v.pm = u.pm; v.pn = u.pn - 4; gb.fused(acc, v, wr, wc, fr, fq, lds); }
    }
};
struct EpiResid {
    static constexpr bool MUTATES = false;
    static constexpr bool HAS_ROWSCALE = false;
    static constexpr bool IDEMPOTENT = false;
    static constexpr bool HAS_FUSED = false;
    bf16_t* XB; float* RSn; unsigned char* scr; int dry; bool wt = true;
    __device__ __forceinline__ void row(int row, int colbase, float (&v)[8]) const {
        float q0 = 0.f;
#pragma unroll
        for (int j = 0; j < 8; ++j) { const int col = colbase + 32 * j; bf16_t* xp = XB + (size_t)row * 1024 + col; const float x = bf2f(*xp) + v[j]; *xp = f2bf(x); q0 += x * x; }
        q0 = half_sum32(q0);
        if ((threadIdx.x & 31) == 0) RSn[(size_t)(colbase >> 8) * M + row] = q0;
    }
    __device__ __forceinline__ void operator()(const AccT& acc, const pg8::Unit& u, int wr, int wc, int fr, int fq) const {
        const int cb = u.pn * 256 + wc * 32 + 8 * fq, row0 = u.pm * 256 + wr * 64 + fr;
        PG8_LAS float* P = (PG8_LAS float*)scr;
#pragma unroll
        for (int ai = 0; ai < 2; ++ai) {
            u32x4 ov[4][2];
#pragma unroll
            for (int m = 0; m < 4; ++m)
#pragma unroll
                for (int bj = 0; bj < 2; ++bj) ov[m][bj] = gld<u32x4>(XB + (size_t)(row0 + ai * 128 + m * 16) * 1024 + cb + 128 * bj);
#pragma unroll
            for (int m = 0; m < 4; ++m) {
                const int row = row0 + ai * 128 + m * 16; float q = 0.f;
#pragma unroll
                for (int bj = 0; bj < 2; ++bj) {
                    const u32x4 o = ov[m][bj];
                    const f32x4 x0 = (f32x4){bflo(o.x), bfhi(o.x), bflo(o.y), bfhi(o.y)} + acc[ai][bj][m][0], x1 = (f32x4){bflo(o.z), bfhi(o.z), bflo(o.w), bfhi(o.w)} + acc[ai][bj][m][1];
                    if (!dry) st16(XB, ((size_t)row * 1024 + cb + 128 * bj) * 2, pack8(x0, x1), wt);
                    q += (x0.x * x0.x + x0.y * x0.y) + (x0.z * x0.z + x0.w * x0.w) + (x1.x * x1.x + x1.y * x1.y) + (x1.z * x1.z + x1.w * x1.w);
                }
                q = quad_rows_sum(q);
                if (fq == 0) P[(ai * 128 + wr * 64 + m * 16 + fr) * 4 + wc] = q;
            }
        }
        asm volatile("s_waitcnt lgkmcnt(0)" ::: "memory"); __builtin_amdgcn_s_barrier(); asm volatile("" ::: "memory");
        const int t = (wr * 4 + wc) * 64 + fr + 16 * fq;
        if (t < 256 && !dry) gst<float>(RSn + (size_t)u.pn * M + u.pm * 256 + t, (P[t * 4 + 0] + P[t * 4 + 1]) + (P[t * 4 + 2] + P[t * 4 + 3]));
    }
};
struct EpiGlu {
    static constexpr bool MUTATES = false;
    static constexpr bool HAS_ROWSCALE = false;
    static constexpr bool IDEMPOTENT = false;
    static constexpr bool HAS_FUSED = false;
    bf16_t* D; int dry;
    __device__ __forceinline__ void row(int row, int colbase, float (&v)[8]) const {
#pragma unroll
        for (int j = 0; j < 4; ++j) { const int c = (colbase >> 8) * 128 + (colbase & 255) + 32 * j; bf16_t* d = D + (size_t)row * 1024 + c;
            *d = f2bf(v[j] * sigmoid_f(v[j + 4]) * bf2f(*d)); }
    }
    __device__ __forceinline__ void operator()(const AccT& acc, const pg8::Unit& u, int wr, int wc, int fr, int fq) const {
        const int cb = u.pn * 128 + wc * 32 + 8 * fq, row0 = u.pm * 256 + wr * 64 + fr;
        u32x4 gv[2][4];
#pragma unroll
        for (int ai = 0; ai < 2; ++ai)
#pragma unroll
            for (int m = 0; m < 4; ++m) gv[ai][m] = gld<u32x4>(D + (size_t)(row0 + ai * 128 + m * 16) * 1024 + cb);
#pragma unroll
        for (int ai = 0; ai < 2; ++ai)
#pragma unroll
            for (int m = 0; m < 4; ++m) {
                const int row = row0 + ai * 128 + m * 16;
                const u32x4 g = gv[ai][m]; const f32x4 a0 = acc[ai][0][m][0], a1 = acc[ai][0][m][1], b0 = acc[ai][1][m][0], b1 = acc[ai][1][m][1];
                const f32x4 o0 = (f32x4){a0.x * fsigmoid(b0.x) * bflo(g.x), a0.y * fsigmoid(b0.y) * bfhi(g.x), a0.z * fsigmoid(b0.z) * bflo(g.y), a0.w * fsigmoid(b0.w) * bfhi(g.y)};
                const f32x4 o1 = (f32x4){a1.x * fsigmoid(b1.x) * bflo(g.z), a1.y * fsigmoid(b1.y) * bfhi(g.z), a1.z * fsigmoid(b1.z) * bflo(g.w), a1.w * fsigmoid(b1.w) * bfhi(g.w)};
                if (!dry) wst16(D, ((size_t)row * 1024 + cb) * 2, pack8(o0, o1));
            }
    }
};
struct EpiFold {
    static constexpr bool MUTATES = false;
    static constexpr bool HAS_ROWSCALE = false;
    static constexpr bool IDEMPOTENT = true;
    static constexpr bool HAS_FUSED = false;
    bf16_t* dst; const float* scale;
    __device__ __forceinline__ void row(int row, int colbase, float (&v)[8]) const {
#pragma unroll
        for (int j = 0; j < 8; ++j) dst[(size_t)row * WIN_LD + colbase + 32 * j] = f2bf(v[j] * scale[row]);
    }
    __device__ __forceinline__ void operator()(const AccT& acc, const pg8::Unit& u, int wr, int wc, int fr, int fq) const {
        const int cb = u.pn * 256 + wc * 32 + 8 * fq, row0 = u.pm * 256 + wr * 64 + fr;
#pragma unroll
        for (int ai = 0; ai < 2; ++ai)
#pragma unroll
            for (int m = 0; m < 4; ++m) { const int row = row0 + ai * 128 + m * 16; const float sc = gld<float>(scale + row);
#pragma unroll
                for (int bj = 0; bj < 2; ++bj) gst<u32x4>(dst + (size_t)row * WIN_LD + cb + 128 * bj, pack8(acc[ai][bj][m][0] * sc, acc[ai][bj][m][1] * sc)); }
    }
};
struct EpiSoftmaxP {
    static constexpr bool MUTATES = true;
    static constexpr bool HAS_ROWSCALE = false;
    static constexpr bool IDEMPOTENT = false;
    static constexpr bool HAS_FUSED = false;
    bf16_t* Pdst; const float* RSu; unsigned char* scr;
    __device__ __forceinline__ void row(int row, int colbase, float (&v)[8]) const { (void)row; (void)colbase; (void)v; }
    __device__ __forceinline__ void operator()(const AccT& acc, const pg8::Unit& u, int wr, int wc, int fr, int fq) const { (void)acc; (void)u; (void)wr; (void)wc; (void)fr; (void)fq; }
    __device__ __forceinline__ void mut(AccT& acc, const pg8::Unit& u, int wr, int wc, int fr, int fq) const {
        PG8_LAS float* P1 = (PG8_LAS float*)scr; PG8_LAS float* P2 = P1 + 1024; PG8_LAS float* R = P2 + 1024;
        { const int t = (wr * 4 + wc) * 64 + fr + 16 * fq;
          if (t < 256) R[t] = rsqrtf(((gld<float>(RSu + t) + gld<float>(RSu + (size_t)M + t)) + (gld<float>(RSu + (size_t)2 * M + t) + gld<float>(RSu + (size_t)3 * M + t))) * (1.0f / 1024.f) + EPS); }
#pragma unroll
        for (int ai = 0; ai < 2; ++ai)
#pragma unroll
            for (int m = 0; m < 4; ++m) { float mx = -3.0e38f;
#pragma unroll
                for (int bj = 0; bj < 2; ++bj)
#pragma unroll
                    for (int n = 0; n < 2; ++n) { const f32x4 x = acc[ai][bj][m][n]; mx = fmaxf(mx, fmaxf(fmaxf(x.x, x.y), fmaxf(x.z, x.w))); }
                mx = quad_rows_max(mx);
                if (fq == 0) P1[(ai * 128 + wr * 64 + m * 16 + fr) * 4 + wc] = mx; }
        asm volatile("s_waitcnt lgkmcnt(0)" ::: "memory"); __builtin_amdgcn_s_barrier(); asm volatile("" ::: "memory");
#pragma unroll
        for (int ai = 0; ai < 2; ++ai)
#pragma unroll
            for (int m = 0; m < 4; ++m) { const int rl = ai * 128 + wr * 64 + m * 16 + fr; const float rs = R[rl];
                const float mx = fmaxf(fmaxf(P1[rl * 4 + 0], P1[rl * 4 + 1]), fmaxf(P1[rl * 4 + 2], P1[rl * 4 + 3])); float sm = 0.f;
#pragma unroll
                for (int bj = 0; bj < 2; ++bj)
#pragma unroll
                    for (int n = 0; n < 2; ++n) { f32x4 x = acc[ai][bj][m][n];
                        x.x = __builtin_amdgcn_exp2f((x.x - mx) * rs); x.y = __builtin_amdgcn_exp2f((x.y - mx) * rs); x.z = __builtin_amdgcn_exp2f((x.z - mx) * rs); x.w = __builtin_amdgcn_exp2f((x.w - mx) * rs);
                        sm += (x.x + x.y) + (x.z + x.w); acc[ai][bj][m][n] = x; }
                sm = quad_rows_sum(sm);
                if (fq == 0) P2[rl * 4 + wc] = sm; }
        asm volatile("s_waitcnt lgkmcnt(0)" ::: "memory"); __builtin_amdgcn_s_barrier(); asm volatile("" ::: "memory");
        const int cb = u.pn * 256 + wc * 32 + 8 * fq;
#pragma unroll
        for (int ai = 0; ai < 2; ++ai)
#pragma unroll
            for (int m = 0; m < 4; ++m) { const int rl = ai * 128 + wr * 64 + m * 16 + fr;
                const float inv = 1.0f / ((P2[rl * 4 + 0] + P2[rl * 4 + 1]) + (P2[rl * 4 + 2] + P2[rl * 4 + 3]));
#pragma unroll
                for (int bj = 0; bj < 2; ++bj) wst16(Pdst, ((size_t)(u.pm * 256 + rl) * 1024 + cb + 128 * bj) * 2, pack8(acc[ai][bj][m][0] * inv, acc[ai][bj][m][1] * inv)); }
    }
};
struct EpiTile {
    static constexpr bool MUTATES = false;
    static constexpr bool HAS_ROWSCALE = false;
    static constexpr bool IDEMPOTENT = true;
    static constexpr bool HAS_FUSED = false;
    bf16_t* dst;
    __device__ __forceinline__ void row(int row, int colbase, float (&v)[8]) const {
#pragma unroll
        for (int j = 0; j < 8; ++j) dst[(size_t)row * 1024 + colbase + 32 * j] = f2bf(v[j]);
    }
    __device__ __forceinline__ void operator()(const AccT& acc, const pg8::Unit& u, int wr, int wc, int fr, int fq) const {
        const int cb = u.pn * 256 + wc * 32 + 8 * fq, row0 = u.pm * 256 + wr * 64 + fr;
#pragma unroll
        for (int ai = 0; ai < 2; ++ai)
#pragma unroll
            for (int m = 0; m < 4; ++m) { const int row = row0 + ai * 128 + m * 16;
#pragma unroll
                for (int bj = 0; bj < 2; ++bj) wst16(dst, ((size_t)row * 1024 + cb + 128 * bj) * 2, pack8(acc[ai][bj][m][0], acc[ai][bj][m][1])); }
    }
};
template <int FAST, class Epi, bool TAIL = true>
__device__ __forceinline__ void run_gemm(unsigned char* lds, const bf16_t* A1, const bf16_t* A2, int K1, const bf16_t* Bt, int Mrows, int N, int K, const Epi& E, int a_grp = 1 << 20, int a_skip = 0, int b_grp = 1 << 20, int b_skip = 0, int vG = 0, int vc = 0, int lda = 1024, int ldb = 0, const bf16_t* Bt2 = nullptr, int nsplit = 1 << 20) {
    if constexpr (FAST) { pg8::Gemm g{A1, A2, K1 / 64, lda, Bt, Mrows, N, K, a_grp, a_skip, b_grp, b_skip, vG, vc, ldb ? ldb : K, Bt2, nsplit}; pg8::gemm_phase<Epi, TAIL>((PG8_LAS unsigned char*)lds, g, E); }
    else ngemm(lds, A1, A2, K1, lda, Bt, Mrows, N, K, E);
}
__device__ __forceinline__ void zero_f32(float* p, int n) { for (int i = blockIdx.x * NT + tid_l(); i < n; i += gridDim.x * NT) p[i] = 0.f; }

__device__ __forceinline__ void init_rows(const Params& p) {
    unsigned char* wsl = p.ws; asm volatile("" : "+s"(wsl));
    const int tidl = tid_l(), lane = tidl & 63, gw = blockIdx.x * (NT / 64) + (tidl >> 6), ngw = gridDim.x * (NT / 64);
    float* RS = (float*)(wsl + WS_RS); bf16_t* XB = (bf16_t*)(wsl + WS_XB); bf16_t* MB = (bf16_t*)(wsl + WS_MEMNB);
    for (int row = gw; row < M; row += ngw) {
        const f32x4* xr = (const f32x4*)(p.in[0] + (size_t)row * DM) + lane; u32x2* xb = (u32x2*)(XB + (size_t)row * DM) + lane;
        float s = 0.f;
#pragma unroll
        for (int j = 0; j < 4; ++j) { const f32x4 v = gld<f32x4>(xr + 64 * j); s += v.x * v.x + v.y * v.y + v.z * v.z + v.w * v.w;
            u32x2 w; w.x = cvt_pk_bf16(v.x, v.y); w.y = cvt_pk_bf16(v.z, v.w); gst<u32x2>(XB + (size_t)row * DM + 4 * (lane + 64 * j), w); }
        s = wave_sum(s);
        if (lane < 4) RS[(size_t)lane * M + row] = (lane == 0) ? s : 0.f;
    }
    for (int row = gw; row < MM; row += ngw) {
        const f32x4* xr = (const f32x4*)(p.in[1] + (size_t)row * DM) + lane; const f32x4* gr = (const f32x4*)(p.in[28]) + lane; u32x2* xb = (u32x2*)(MB + (size_t)row * DM) + lane;
        f32x4 v[4]; float s = 0.f;
#pragma unroll
        for (int j = 0; j < 4; ++j) { v[j] = xr[64 * j]; s += v[j].x * v[j].x + v[j].y * v[j].y + v[j].z * v[j].z + v[j].w * v[j].w; }
        s = wave_sum(s); const float r = rsqrtf(s * (1.0f / DM) + EPS);
#pragma unroll
        for (int j = 0; j < 4; ++j) { const f32x4 g = gr[64 * j]; u32x2 w; w.x = (unsigned)f2bf(v[j].x * r * g.x) | ((unsigned)f2bf(v[j].y * r * g.y) << 16);
            w.y = (unsigned)f2bf(v[j].z * r * g.z) | ((unsigned)f2bf(v[j].w * r * g.w) << 16); xb[64 * j] = w; }
    }
}
__device__ __forceinline__ void cvt_wvb(const Params& p) {
    unsigned char* wsl = p.ws; asm volatile("" : "+s"(wsl));
    bf16_t* WVB = (bf16_t*)(wsl + WS_WVB);
    for (int e8 = blockIdx.x * NT + tid_l(); e8 < 2 * 4 * 1024 * 32; e8 += gridDim.x * NT) {
        const int c8 = e8 & 31, k = (e8 >> 5) & 1023, g = (e8 >> 15) & 3, i = e8 >> 17;
        const float* src = p.in[3] + (size_t)i * 1024 * 6144 + (size_t)k * 6144 + 4096 + g * 256 + 8 * c8; const float gn = p.in[2][i * 1024 + k];
        const f32x4 a = gld<f32x4>(src) * gn, c = gld<f32x4>(src + 4) * gn;
        wst16(WVB, (size_t)e8 * 16, pack8(a, c));
    }
}

__device__ __forceinline__ void cvt_wxqn(const Params& p) {
    unsigned char* wsl = p.ws; asm volatile("" : "+s"(wsl));
    bf16_t* W = (bf16_t*)(wsl + WS_WXQ);
    for (int e8 = blockIdx.x * NT + tid_l(); e8 < 4 * 1024 * 128; e8 += gridDim.x * NT) {
        const int i = (e8 >> 7) & 1023, l = e8 >> 17;
        const float* src = p.in[25] + (size_t)e8 * 8; const float gn = p.in[24][l * 1024 + i] * (0.0625f * 1.4426950408889634f);
        const f32x4 a = gld<f32x4>(src) * gn, c = gld<f32x4>(src + 4) * gn;
        wst16(W, (size_t)e8 * 16, pack8(a, c));
    }
}

__device__ __forceinline__ int dil_pos(int t, int s) { return (s < 129) ? (t - s) : (s < 258) ? (t - 4 * (s - 129)) : (t - 16 * (s - 258)); }
__device__ __forceinline__ void dil_attn_naive(const Params& p) {
    unsigned char* wsl = p.ws; asm volatile("" : "+s"(wsl));
    bf16_t* Q = (bf16_t*)(wsl + WS_B0); const bf16_t* Kb = (const bf16_t*)(wsl + WS_B1); const bf16_t* Vb = (const bf16_t*)(wsl + WS_B2);
    const int tidl = tid_l(), lane = tidl & 63, gw = blockIdx.x * (NT / 64) + (tidl >> 6), ngw = gridDim.x * (NT / 64);
    for (int item = gw; item < M * 16; item += ngw) {
        const int row = item >> 4, h = item & 15, t = row & (SEQ - 1), rowb = row - t;
        float q[64];
        { const u32x4* qp = (const u32x4*)(Q + (size_t)row * 1024 + h * 64);
#pragma unroll
          for (int i = 0; i < 8; ++i) { const u32x4 w = qp[i];
              q[8 * i + 0] = __uint_as_float(w.x << 16); q[8 * i + 1] = __uint_as_float(w.x & 0xffff0000u); q[8 * i + 2] = __uint_as_float(w.y << 16); q[8 * i + 3] = __uint_as_float(w.y & 0xffff0000u);
              q[8 * i + 4] = __uint_as_float(w.z << 16); q[8 * i + 5] = __uint_as_float(w.z & 0xffff0000u); q[8 * i + 6] = __uint_as_float(w.w << 16); q[8 * i + 7] = __uint_as_float(w.w & 0xffff0000u); } }
        float sc[7]; float mx = -3.0e38f;
#pragma unroll
        for (int i = 0; i < 7; ++i) {
            const int s = lane + 64 * i, pos = dil_pos(t, s); const bool valid = (s < 386) && (pos >= 0);
            float d = -3.0e38f;
            if (valid) { const u32x4* kp = (const u32x4*)(Kb + (size_t)(rowb + pos) * 1024 + h * 64); d = 0.f;
#pragma unroll
                for (int c = 0; c < 8; ++c) { const u32x4 w = kp[c];
                    d += q[8 * c + 0] * __uint_as_float(w.x << 16) + q[8 * c + 1] * __uint_as_float(w.x & 0xffff0000u) + q[8 * c + 2] * __uint_as_float(w.y << 16) + q[8 * c + 3] * __uint_as_float(w.y & 0xffff0000u)
                       + q[8 * c + 4] * __uint_as_float(w.z << 16) + q[8 * c + 5] * __uint_as_float(w.z & 0xffff0000u) + q[8 * c + 6] * __uint_as_float(w.w << 16) + q[8 * c + 7] * __uint_as_float(w.w & 0xffff0000u); } }
            sc[i] = d; mx = fmaxf(mx, d);
        }
        mx = wave_max(mx);
        float l = 0.f;
#pragma unroll
        for (int i = 0; i < 7; ++i) { const int s = lane + 64 * i, pos = dil_pos(t, s); const bool valid = (s < 386) && (pos >= 0); sc[i] = valid ? expf(sc[i] - mx) : 0.f; l += sc[i]; }
        l = wave_sum(l);
        float o = 0.f;
#pragma unroll
        for (int i = 0; i < 7; ++i) {
            for (int j = 0; j < 64; ++j) { const int s = 64 * i + j; if (s >= 386) break; const int pos = dil_pos(t, s); const float pj = __shfl(sc[i], j);
                if (pos >= 0) o += pj * bf2f(Vb[(size_t)(rowb + pos) * 1024 + h * 64 + lane]); }
        }
        Q[(size_t)row * 1024 + h * 64 + lane] = f2bf(o / l);
    }
}

typedef float f32x16 __attribute__((ext_vector_type(16)));
typedef short s16x8 __attribute__((ext_vector_type(8)));
typedef short s16x4 __attribute__((ext_vector_type(4)));
__device__ __forceinline__ void dil_tile(f32x16 (&oacc)[2], float& m, float& l, const s16x8 (&qf)[4], const u32x4 (&kk)[4], const u32x4 (&vv)[4], unsigned char* Vw, unsigned tr_base,
                                         int lane, int q, int h, int qpos, int kpb, bool need_mask) {
#pragma unroll
    for (int i2 = 0; i2 < 4; ++i2) *(u32x4*)(Vw + ((lane >> 3) + 8 * i2) * 144 + (lane & 7) * 16) = kk[i2];
    s16x8 kf[4];
#pragma unroll
    for (int ks = 0; ks < 4; ++ks) kf[ks] = *(const s16x8*)(Vw + q * 144 + (16 * ks + 8 * h) * 2);
    asm volatile("s_waitcnt lgkmcnt(0)" ::: "memory");
#pragma unroll
    for (int i2 = 0; i2 < 4; ++i2) *(u32x4*)(Vw + ((lane >> 3) + 8 * i2) * 192 + (lane & 7) * 16) = vv[i2];
    f32x16 sacc;
#pragma unroll
    for (int e = 0; e < 16; ++e) sacc[e] = 0.f;
#pragma unroll
    for (int ks = 0; ks < 4; ++ks) sacc = __builtin_amdgcn_mfma_f32_32x32x16_bf16(kf[ks], qf[ks], sacc, 0, 0, 0);
    if (need_mask) {
        const int hi = qpos - kpb - 4 * h, l1 = hi - 128, l2 = -(kpb + 4 * h), lo = l1 > l2 ? l1 : l2;
        const unsigned mhi = hi < 0 ? 0u : (hi >= 31 ? 0xffffffffu : ((2u << hi) - 1u));
        const unsigned mlo = lo <= 0 ? 0xffffffffu : (lo >= 32 ? 0u : (0xffffffffu << lo));
        const unsigned mk = mhi & mlo;
#pragma unroll
        for (int e = 0; e < 16; ++e) { const int c = (e & 3) + 8 * (e >> 2); const unsigned mm = (unsigned)(((int)(mk << (31 - c))) >> 31);
            sacc[e] = __uint_as_float((__float_as_uint(sacc[e]) & mm) | (0xff800000u & ~mm)); }
    }
    typedef float f32x2_ __attribute__((ext_vector_type(2)));
    f32x2_ t2[8];
    { const f32x2_ nm = (f32x2_){-m, -m};
#pragma unroll
      for (int e = 0; e < 8; ++e) t2[e] = (f32x2_){sacc[2 * e], sacc[2 * e + 1]} + nm; }
    float mt;
    { const float r0 = fmaxf(fmaxf(t2[0].x, t2[0].y), t2[1].x), r1 = fmaxf(fmaxf(t2[1].y, t2[2].x), t2[2].y), r2 = fmaxf(fmaxf(t2[3].x, t2[3].y), t2[4].x),
                  r3 = fmaxf(fmaxf(t2[4].y, t2[5].x), t2[5].y), r4 = fmaxf(fmaxf(t2[6].x, t2[6].y), t2[7].x);
      mt = fmaxf(fmaxf(fmaxf(r0, r1), r2), fmaxf(fmaxf(r3, r4), t2[7].y)); }
    { const auto rr = __builtin_amdgcn_permlane32_swap(__float_as_uint(mt), __float_as_uint(mt), false, false); mt = __builtin_amdgcn_fmed3f(__uint_as_float(rr[0]), __uint_as_float(rr[1]), INFINITY); }
    if (!__all(mt <= 8.0f)) {
        float ms;
        { float m4[4];
#pragma unroll
          for (int e = 0; e < 4; ++e) m4[e] = fmaxf(fmaxf(sacc[4 * e], sacc[4 * e + 1]), fmaxf(sacc[4 * e + 2], sacc[4 * e + 3]));
          ms = fmaxf(fmaxf(m4[0], m4[1]), fmaxf(m4[2], m4[3])); }
        { const auto rr = __builtin_amdgcn_permlane32_swap(__float_as_uint(ms), __float_as_uint(ms), false, false); ms = fmaxf(__uint_as_float(rr[0]), __uint_as_float(rr[1])); }
        const float mnew = fmaxf(m, ms), alpha = __builtin_amdgcn_exp2f(m - mnew); m = mnew; l *= alpha;
#pragma unroll
        for (int dt = 0; dt < 2; ++dt)
#pragma unroll
            for (int e = 0; e < 16; ++e) oacc[dt][e] *= alpha;
        const f32x2_ nm = (f32x2_){-m, -m};
#pragma unroll
        for (int e = 0; e < 8; ++e) t2[e] = (f32x2_){sacc[2 * e], sacc[2 * e + 1]} + nm;
    }
#pragma unroll
    for (int e = 0; e < 8; ++e) { sacc[2 * e] = __builtin_amdgcn_exp2f(t2[e].x); sacc[2 * e + 1] = __builtin_amdgcn_exp2f(t2[e].y); }
    float ps;
    { float s4[4];
#pragma unroll
      for (int e = 0; e < 4; ++e) s4[e] = (sacc[4 * e] + sacc[4 * e + 1]) + (sacc[4 * e + 2] + sacc[4 * e + 3]);
      ps = (s4[0] + s4[1]) + (s4[2] + s4[3]); }
    { const auto rr = __builtin_amdgcn_permlane32_swap(__float_as_uint(ps), __float_as_uint(ps), false, false); ps = __uint_as_float(rr[0]) + __uint_as_float(rr[1]); }
    l += ps;
    s16x8 pf[2];
#pragma unroll
    for (int s2 = 0; s2 < 2; ++s2) { u32x4 w; w.x = cvt_pk_bf16(sacc[8 * s2 + 0], sacc[8 * s2 + 1]); w.y = cvt_pk_bf16(sacc[8 * s2 + 2], sacc[8 * s2 + 3]);
        w.z = cvt_pk_bf16(sacc[8 * s2 + 4], sacc[8 * s2 + 5]); w.w = cvt_pk_bf16(sacc[8 * s2 + 6], sacc[8 * s2 + 7]); pf[s2] = __builtin_bit_cast(s16x8, w); }
    s16x4 t00, t01, t02, t03, t10, t11, t12, t13;
    asm volatile("ds_read_b64_tr_b16 %0, %8 offset:0\n\tds_read_b64_tr_b16 %1, %8 offset:1536\n\tds_read_b64_tr_b16 %2, %8 offset:3072\n\tds_read_b64_tr_b16 %3, %8 offset:4608\n\t"
                 "ds_read_b64_tr_b16 %4, %8 offset:64\n\tds_read_b64_tr_b16 %5, %8 offset:1600\n\tds_read_b64_tr_b16 %6, %8 offset:3136\n\tds_read_b64_tr_b16 %7, %8 offset:4672\n\ts_waitcnt lgkmcnt(0)"
                 : "=&v"(t00), "=&v"(t01), "=&v"(t02), "=&v"(t03), "=&v"(t10), "=&v"(t11), "=&v"(t12), "=&v"(t13) : "v"(tr_base) : "memory");
    oacc[0] = __builtin_amdgcn_mfma_f32_32x32x16_bf16(__builtin_shufflevector(t00, t01, 0, 1, 2, 3, 4, 5, 6, 7), pf[0], oacc[0], 0, 0, 0);
    oacc[1] = __builtin_amdgcn_mfma_f32_32x32x16_bf16(__builtin_shufflevector(t10, t11, 0, 1, 2, 3, 4, 5, 6, 7), pf[0], oacc[1], 0, 0, 0);
    oacc[0] = __builtin_amdgcn_mfma_f32_32x32x16_bf16(__builtin_shufflevector(t02, t03, 0, 1, 2, 3, 4, 5, 6, 7), pf[1], oacc[0], 0, 0, 0);
    oacc[1] = __builtin_amdgcn_mfma_f32_32x32x16_bf16(__builtin_shufflevector(t12, t13, 0, 1, 2, 3, 4, 5, 6, 7), pf[1], oacc[1], 0, 0, 0);
}
__device__ __forceinline__ void dil_attn_mfma(unsigned char* lds, const Params& p, const int dry) {
    unsigned char* wsl = p.ws; asm volatile("" : "+s"(wsl));
    const bf16_t* Qb = (const bf16_t*)p.out; const bf16_t* Kb = (const bf16_t*)(wsl + WS_B1); const bf16_t* Vb = (const bf16_t*)(wsl + WS_B2);
    bf16_t* Ob = (bf16_t*)(wsl + WS_B0);
    const int tid = tid_l(), lane = tid & 63, wid = tid >> 6, q = lane & 31, h = lane >> 5;
    unsigned char* OST = lds;
    float* MST = (float*)(lds + 65536); float* LST = (float*)(lds + 67584);
    unsigned char* Vw = lds + 69632 + wid * 6144;
    const unsigned tr_base = (unsigned)(size_t)Vw + (unsigned)((4 * h + ((lane & 15) >> 2)) * 192 + (16 * ((lane >> 4) & 1) + 4 * (lane & 3)) * 2);
    for (int uu = bid_l(); uu < 512; uu += gridDim.x) {
        const int u = uu & 255, b = u & 7, hd = (u >> 3) & 15, cb_ = u >> 7, c = (uu < 256) ? cb_ : 3 - cb_, rowb = b * SEQ, T0 = 512 * c;
        __syncthreads();
#pragma unroll 1
        for (int stage = 0; stage < 3; ++stage) {
#pragma unroll 1
            for (int g = 0; g < 2; ++g) {
                int dil, r, pos0, kp0, nkt;
                if (stage == 0) { dil = 1; r = 0; pos0 = T0 + 64 * wid + 32 * g; kp0 = pos0 - 128; nkt = 5; }
                else if (stage == 1) { dil = 4; r = wid >> 1; pos0 = 128 * c + 64 * (wid & 1) + 32 * g; kp0 = pos0 - 128; nkt = 5; }
                else { dil = 16; r = 2 * wid + g; pos0 = 32 * c; kp0 = 0; nkt = c + 1; }
                const int qpos = pos0 + q, qtok = dil * qpos + r, tau = qtok - T0;
                const int fsw = ((tau >> 2) ^ (tau >> 4)) & 15;
                s16x8 qf[4];
                { const bf16_t* qp = Qb + ((size_t)(b * 16 + hd) * 2048 + qtok) * 64 + 8 * h;
#pragma unroll
                  for (int ks = 0; ks < 4; ++ks) qf[ks] = gld<s16x8>(qp + 16 * ks); }
                f32x16 oacc[2]; float m = -1.0e30f, l = 0.f;
                if (stage == 0) {
#pragma unroll
                    for (int dt = 0; dt < 2; ++dt)
#pragma unroll
                        for (int e = 0; e < 16; ++e) oacc[dt][e] = 0.f;
                } else {
                    m = MST[tau]; l = LST[tau];
#pragma unroll
                    for (int dt = 0; dt < 2; ++dt)
#pragma unroll
                        for (int gg = 0; gg < 4; ++gg) { const u32x2 w = *(const u32x2*)(OST + tau * 128 + (((8 * dt + 2 * gg + h) ^ fsw) * 8));
                            oacc[dt][4 * gg + 0] = bflo(w.x); oacc[dt][4 * gg + 1] = bfhi(w.x); oacc[dt][4 * gg + 2] = bflo(w.y); oacc[dt][4 * gg + 3] = bfhi(w.y); }
                }
#define DIL_LOAD(KT, KK, VV) do { const int kpb_ = kp0 + 32 * (KT); \
                    _Pragma("unroll") for (int i2 = 0; i2 < 4; ++i2) { int kpos_ = kpb_ + (lane >> 3) + 8 * i2; if (kpos_ < 0) kpos_ = 0; \
                        const unsigned ro_ = (unsigned)(dil * kpos_ + r) * 64u; KK[i2] = gld<u32x4>(kbase + ro_); VV[i2] = gld<u32x4>(vbase + ro_); } } while (0)
                const bf16_t* kbase = Kb + (size_t)(b * 16 + hd) * 2048 * 64 + 8 * (lane & 7); const bf16_t* vbase = Vb + (size_t)(b * 16 + hd) * 2048 * 64 + 8 * (lane & 7);
                u32x4 kA[4], vA[4], kB[4], vB[4];
                DIL_LOAD(0, kA, vA);
#pragma unroll 1
                for (int kt = 0; kt < nkt; kt += 2) {
                    if (kt + 1 < nkt) DIL_LOAD(kt + 1, kB, vB);
                    dil_tile(oacc, m, l, qf, kA, vA, Vw, tr_base, lane, q, h, qpos, kp0 + 32 * kt, kt == 0 || kt == nkt - 1 || kp0 + 32 * kt < 0);
                    if (kt + 1 < nkt) {
                        if (kt + 2 < nkt) DIL_LOAD(kt + 2, kA, vA);
                        dil_tile(oacc, m, l, qf, kB, vB, Vw, tr_base, lane, q, h, qpos, kp0 + 32 * (kt + 1), kt + 1 == nkt - 1 || kp0 + 32 * (kt + 1) < 0);
                    }
                }
                if (stage < 2) {
                    if (h == 0) { MST[tau] = m; LST[tau] = l; }
#pragma unroll
                    for (int dt = 0; dt < 2; ++dt)
#pragma unroll
                        for (int gg = 0; gg < 4; ++gg) { u32x2 w; w.x = cvt_pk_bf16(oacc[dt][4 * gg + 0], oacc[dt][4 * gg + 1]); w.y = cvt_pk_bf16(oacc[dt][4 * gg + 2], oacc[dt][4 * gg + 3]);
                            *(u32x2*)(OST + tau * 128 + (((8 * dt + 2 * gg + h) ^ fsw) * 8)) = w; }
                } else if (!dry) {
                    const float inv = 1.0f / l;
                    bf16_t* op = Ob + (size_t)(rowb + qtok) * 1024 + hd * 64 + 4 * h;
#pragma unroll
                    for (int dt = 0; dt < 2; ++dt)
#pragma unroll
                        for (int gg = 0; gg < 4; ++gg) { u32x2 w; w.x = cvt_pk_bf16(oacc[dt][4 * gg + 0] * inv, oacc[dt][4 * gg + 1] * inv); w.y = cvt_pk_bf16(oacc[dt][4 * gg + 2] * inv, oacc[dt][4 * gg + 3] * inv);
                            gst<u32x2>(op + 32 * dt + 8 * gg, w); }
                }
            }
            __syncthreads();
        }
    }
}

__device__ __forceinline__ void xattn_naive(unsigned char* lds, const Params& p, int l) {
    unsigned char* wsl = p.ws; asm volatile("" : "+s"(wsl));
    const bf16_t* Qb = (const bf16_t*)(wsl + WS_B2); bf16_t* O = (bf16_t*)(wsl + WS_B3); const bf16_t* KV = (const bf16_t*)(wsl + WS_KVX) + (size_t)l * MM * 2048;
    const int tidl = tid_l(), lane = tidl & 63, wid = tidl >> 6, gw = blockIdx.x * (NT / 64) + wid, ngw = gridDim.x * (NT / 64);
    float* qs = (float*)lds + wid * 256;
    for (int item = gw; item < M * 4; item += ngw) {
        const int row = item >> 2, h = item & 3, b = row >> 11;
        { const u32x2 w = *((const u32x2*)(Qb + (size_t)row * 1024 + h * 256) + lane);
          qs[4 * lane + 0] = __uint_as_float(w.x << 16); qs[4 * lane + 1] = __uint_as_float(w.x & 0xffff0000u); qs[4 * lane + 2] = __uint_as_float(w.y << 16); qs[4 * lane + 3] = __uint_as_float(w.y & 0xffff0000u); }
        __builtin_amdgcn_wave_barrier();
        float sc[4]; float mx = -3.0e38f;
#pragma unroll
        for (int i = 0; i < 4; ++i) { const int key = lane + 64 * i; const u32x4* kp = (const u32x4*)(KV + (size_t)(b * MEML + key) * 2048 + h * 256); float d = 0.f;
#pragma unroll 4
            for (int c = 0; c < 32; ++c) { const u32x4 w = kp[c]; const float* qq = qs + 8 * c;
                d += qq[0] * __uint_as_float(w.x << 16) + qq[1] * __uint_as_float(w.x & 0xffff0000u) + qq[2] * __uint_as_float(w.y << 16) + qq[3] * __uint_as_float(w.y & 0xffff0000u)
                   + qq[4] * __uint_as_float(w.z << 16) + qq[5] * __uint_as_float(w.z & 0xffff0000u) + qq[6] * __uint_as_float(w.w << 16) + qq[7] * __uint_as_float(w.w & 0xffff0000u); }
            sc[i] = d; mx = fmaxf(mx, d); }
        mx = wave_max(mx);
        float lsum = 0.f;
#pragma unroll
        for (int i = 0; i < 4; ++i) { sc[i] = expf(sc[i] - mx); lsum += sc[i]; }
        lsum = wave_sum(lsum);
        float o[4] = {0.f, 0.f, 0.f, 0.f};
#pragma unroll
        for (int i = 0; i < 4; ++i)
            for (int j = 0; j < 64; ++j) { const int key = 64 * i + j; const float pj = __shfl(sc[i], j); const bf16_t* vp = KV + (size_t)(b * MEML + key) * 2048 + 1024 + h * 256 + lane;
                o[0] += pj * bf2f(vp[0]); o[1] += pj * bf2f(vp[64]); o[2] += pj * bf2f(vp[128]); o[3] += pj * bf2f(vp[192]); }
        const float inv = 1.0f / lsum;
#pragma unroll
        for (int jj = 0; jj < 4; ++jj) O[(size_t)row * 1024 + h * 256 + lane + 64 * jj] = f2bf(o[jj] * inv);
        __builtin_amdgcn_wave_barrier();
    }
}

__device__ __forceinline__ void xattn_units(unsigned char* lds, const Params& p, int l, int unit0, int unit_step) {
    unsigned char* wsl = p.ws; asm volatile("" : "+s"(wsl));
    const bf16_t* Qb = (const bf16_t*)(wsl + WS_B2); bf16_t* O = (bf16_t*)(wsl + WS_B3);
    const bf16_t* KX = (const bf16_t*)(wsl + WS_KVX) + (size_t)l * MM * 1024; const bf16_t* VT = (const bf16_t*)(wsl + WS_VTX) + (size_t)l * 1024 * MM;
    const int tid = tid_l(), lane = tid & 63, wid = tid >> 6, q = lane & 31, h = lane >> 5;
#ifndef XREP_A
#define XREP_A 1
#endif
#ifndef XREP_B
#define XREP_B 1
#endif
#ifndef XREP_S
#define XREP_S 1
#endif
    for (int unit = unit0; unit < 256; unit += unit_step) {
        const int pm = unit >> 2, hd = unit & 3, b = pm >> 3;
        const int row = pm * 256 + wid * 32 + q;
        const bf16_t* qp = Qb + (size_t)row * 1024 + hd * 256 + 8 * h;
#pragma unroll 4
        for (int i = 0; i < 16; ++i) { const int id = tid + 512 * i, key = id >> 5, ch = id & 31;
            const u32x4 w = gld<u32x4>(KX + (size_t)(b * MEML + key) * 1024 + hd * 256 + ch * 8);
            *(u32x4*)(lds + key * 528 + ch * 16) = w; }
        __syncthreads();
        f32x16 sacc[8];
        {
#pragma unroll
        for (int kt = 0; kt < 8; ++kt)
#pragma unroll
            for (int r = 0; r < 16; ++r) sacc[kt][r] = 0.f;
#pragma unroll 4
        for (int ks = 0; ks < 16; ++ks) {
            const s16x8 qf = gld<s16x8>(qp + 16 * ks);
#pragma unroll
            for (int kt = 0; kt < 8; ++kt) { const s16x8 kf = *(const s16x8*)(lds + (32 * kt + q) * 528 + (16 * ks + 8 * h) * 2);
                sacc[kt] = __builtin_amdgcn_mfma_f32_32x32x16_bf16(kf, qf, sacc[kt], 0, 0, 0); }
        }
        }
        float mx = -3.0e38f;
#pragma unroll
        for (int kt = 0; kt < 8; ++kt)
#pragma unroll
            for (int r = 0; r < 16; ++r) mx = fmaxf(mx, sacc[kt][r]);
        mx = fmaxf(mx, __shfl_xor(mx, 32));
        float ls = 0.f;
        s16x8 pf[8][2];
#pragma unroll
        for (int kt = 0; kt < 8; ++kt) {
#pragma unroll
            for (int r = 0; r < 16; ++r) { const float e = __builtin_amdgcn_exp2f(sacc[kt][r] - mx); sacc[kt][r] = e; ls += e; }
#pragma unroll
            for (int s2 = 0; s2 < 2; ++s2) { u32x4 w;
                w.x = cvt_pk_bf16(sacc[kt][8 * s2 + 0], sacc[kt][8 * s2 + 1]); w.y = cvt_pk_bf16(sacc[kt][8 * s2 + 2], sacc[kt][8 * s2 + 3]);
                w.z = cvt_pk_bf16(sacc[kt][8 * s2 + 4], sacc[kt][8 * s2 + 5]); w.w = cvt_pk_bf16(sacc[kt][8 * s2 + 6], sacc[kt][8 * s2 + 7]);
                pf[kt][s2] = __builtin_bit_cast(s16x8, w); }
        }
        ls += __shfl_xor(ls, 32);
        const float inv = 1.0f / ls;
        __syncthreads();
#pragma unroll 8
        for (int i = 0; i < 16; ++i) { const int id = tid + 512 * i, d = id >> 5, ch = id & 31; const u32x4 w = gld<u32x4>(VT + (size_t)(hd * 256 + d) * MM + b * MEML + ch * 8);
            unsigned char* gp_ = lds + d * 528 + (ch >> 1) * 32 + (ch & 1) * 8;
            *(u32x2*)gp_ = (u32x2){w.x, w.y}; *(u32x2*)(gp_ + 16) = (u32x2){w.z, w.w}; }
        __syncthreads();
#pragma unroll 1
        for (int dt = 0; dt < 8; ++dt) {
            f32x16 oacc;
#pragma unroll
            for (int r = 0; r < 16; ++r) oacc[r] = 0.f;
            const unsigned char* vb = lds + (32 * dt + q) * 528 + 16 * h;
#pragma unroll
            for (int kt = 0; kt < 8; ++kt)
#pragma unroll
                for (int s2 = 0; s2 < 2; ++s2) {
                    const s16x8 vf = *(const s16x8*)(vb + (32 * kt + 16 * s2) * 2);
                    oacc = __builtin_amdgcn_mfma_f32_32x32x16_bf16(vf, pf[kt][s2], oacc, 0, 0, 0);
                }
            __syncthreads();
            unsigned char* ow = lds + (32 * dt) * 528 + wid * 2048 + q * 64 + 8 * h;
#pragma unroll
            for (int g = 0; g < 4; ++g) { u32x2 w; w.x = cvt_pk_bf16(oacc[4 * g + 0] * inv, oacc[4 * g + 1] * inv); w.y = cvt_pk_bf16(oacc[4 * g + 2] * inv, oacc[4 * g + 3] * inv);
                *(u32x2*)(ow + 16 * g) = w; }
        }
        __builtin_amdgcn_wave_barrier();
        {
          const unsigned char* orow = lds + ((lane & 31) >> 2) * (32 * 528) + wid * 2048 + (lane & 3) * 16;
          bf16_t* obase = O + (size_t)(pm * 256 + wid * 32) * 1024 + hd * 256 + 8 * (lane & 31);
#pragma unroll
          for (int i = 0; i < 16; ++i) { const int r = (lane >> 5) + 2 * i; gst<u32x4>(obase + (size_t)r * 1024, *(const u32x4*)(orow + r * 64)); }
        }
        __syncthreads();
    }
}

__device__ __forceinline__ void sgu_naive(unsigned char* lds, const Params& p, int i) {
    unsigned char* wsl = p.ws; asm volatile("" : "+s"(wsl));
    bf16_t* U = (bf16_t*)(wsl + WS_B0); const bf16_t* V = (const bf16_t*)(wsl + WS_B1); const bf16_t* G = (const bf16_t*)(wsl + WS_B2); const float* LNS = (const float*)(wsl + WS_LNS);
    const float* lng = p.in[9] + i * 1024; const float* lnb = p.in[10] + i * 1024; const float* Ws = p.in[11] + (size_t)i * 4 * 128 * 128; const float* bs = p.in[12] + i * 4 * 128;
    float* vn = (float*)lds;
    float* mu = vn + 128 * 256;
    float* rsd = mu + 128;
    const int tid = tid_l();
    for (int item = bid_l(); item < 128 * 4; item += gridDim.x) {
        const int chunk = item >> 2, g = item & 3, row0 = chunk * 128;
        if (tid < 128) { float s = 0.f, q = 0.f;
            for (int k = 0; k < 4; ++k) { s += LNS[(size_t)k * M + row0 + tid]; q += LNS[(size_t)(4 + k) * M + row0 + tid]; }
            const float m = s * (1.0f / 1024.f); const float var = q * (1.0f / 1024.f) - m * m; mu[tid] = m; rsd[tid] = rsqrtf(fmaxf(var, 0.f) + EPS); }
        __syncthreads();
#pragma unroll 2
        for (int e = tid; e < 128 * 256; e += NT) { const int j = e >> 8, c = e & 255, col = g * 256 + c;
            vn[e] = (bf2f(V[(size_t)(row0 + j) * 1024 + col]) - mu[j]) * rsd[j] * lng[col] + lnb[col]; }
        __syncthreads();
#pragma unroll 1
        for (int e = tid; e < 128 * 256; e += NT) { const int ii = e >> 8, c = e & 255, col = g * 256 + c; const float* wr = Ws + (size_t)g * 128 * 128 + (size_t)ii * 128;
            float acc = 0.f;
#pragma unroll 4
            for (int j = 0; j <= ii; ++j) acc += wr[j] * vn[j * 256 + c];
            acc += bs[g * 128 + ii];
            const size_t off = (size_t)(row0 + ii) * 1024 + col;
            U[off] = f2bf(bf2f(U[off]) * acc * bf2f(G[off])); }
        __syncthreads();
    }
}

constexpr size_t WS_WP = WS_B2, WS_VP = WS_B2 + 16 * MiB;
__device__ __forceinline__ void xattn_prep_unit(unsigned char* wsl, int l, int j, const bf16_t*& A, const bf16_t*& Bt, bf16_t*& dst) {
    const bf16_t* KX = (const bf16_t*)(wsl + WS_KVX) + (size_t)l * MM * 1024; const bf16_t* VX = (const bf16_t*)(wsl + WS_VTX) + (size_t)l * MM * 1024;
    const bf16_t* WQ = (const bf16_t*)(wsl + WS_WXQ) + (size_t)l * 1024 * 1024; const bf16_t* WO = (const bf16_t*)(wsl + WS_WXO) + (size_t)l * 1024 * 1024;
    const int jj = j & 127, b = jj >> 4, hd = (jj >> 2) & 3, t4 = jj & 3;
    if (j < 128) { A = KX + (size_t)(b * MEML) * 1024 + hd * 256; Bt = WQ + (size_t)(t4 * 256) * 1024 + hd * 256; dst = (bf16_t*)(wsl + WS_WP) + (size_t)(b * 1024 + hd * 256) * 1024 + t4 * 256; }
    else         { A = WO + (size_t)(t4 * 256) * 1024 + hd * 256; Bt = VX + (size_t)(b * MEML) * 1024 + hd * 256; dst = (bf16_t*)(wsl + WS_VP) + (size_t)(b * 1024 + t4 * 256) * 1024 + hd * 256; }
}
__device__ __forceinline__ void xattn_prep(unsigned char* lds, const Params& p, int l) {
    unsigned char* wsl = p.ws; asm volatile("" : "+s"(wsl));
    for (int j = bid_l(); j < 256; j += gridDim.x) {
        const bf16_t* A; const bf16_t* Bt; bf16_t* dst;
        xattn_prep_unit(wsl, l, j, A, Bt, dst);
        EpiTile E{dst};
        run_gemm<1>(lds, A, A, 256, Bt, 256, 256, 256, E, 1 << 20, 0, 1 << 20, 0, 1, 0, 1024, 1024);
    }
}
__device__ __forceinline__ void xattn_s(unsigned char* lds, const Params& p) {
    unsigned char* wsl = p.ws; asm volatile("" : "+s"(wsl));
    for (int i = 0;; ++i) {
        const int pu = pg8::static_unit(M, 1024, (int)gridDim.x, bid_l(), i); if (pu < 0) break;
        const int pm = __builtin_amdgcn_readfirstlane(pu >> 16), hd = __builtin_amdgcn_readfirstlane(pu & 65535), b = pm >> 3;
        const bf16_t* A = (const bf16_t*)(wsl + WS_XB) + (size_t)(pm * 256) * 1024;
        EpiSoftmaxP E{(bf16_t*)(wsl + WS_B0) + (size_t)(pm * 256) * 1024 + hd * 256, (const float*)(wsl + WS_RS) + pm * 256, lds + 131072};
        run_gemm<1>(lds, A, A, 1024, (const bf16_t*)(wsl + WS_WP) + (size_t)(b * 1024 + hd * 256) * 1024, 256, 256, 1024, E, 1 << 20, 0, 1 << 20, 0, 1, 0, 1024, 1024);
    }
}
__device__ __forceinline__ void xattn_o(unsigned char* lds, const Params& p, const int dry) {
    unsigned char* wsl = p.ws; asm volatile("" : "+s"(wsl));
    for (int i = 0;; ++i) {
        const int pu = pg8::static_unit(M, 1024, (int)gridDim.x, bid_l(), i); if (pu < 0) break;
        const int pm = __builtin_amdgcn_readfirstlane(pu >> 16), pn = __builtin_amdgcn_readfirstlane(pu & 65535), b = pm >> 3;
        const bf16_t* A = (const bf16_t*)(wsl + WS_B0) + (size_t)(pm * 256) * 1024;
        EpiResid E{(bf16_t*)(wsl + WS_XB) + (size_t)(pm * 256) * 1024 + pn * 256, (float*)(wsl + WS_RS) + (size_t)pn * M + pm * 256, lds + 131072, dry};
        run_gemm<1>(lds, A, A, 1024, (const bf16_t*)(wsl + WS_VP) + (size_t)(b * 1024 + pn * 256) * 1024, 256, 256, 1024, E, 1 << 20, 0, 1 << 20, 0, 1, 0, 1024, 1024);
    }
}

__device__ __forceinline__ void sgu_mfma(unsigned char* lds, const Params& p, int i, const int dry) {
    unsigned char* wsl = p.ws; asm volatile("" : "+s"(wsl));
    bf16_t* U = (bf16_t*)(wsl + WS_B0); const bf16_t* V = (const bf16_t*)(wsl + WS_B1); const bf16_t* G = (const bf16_t*)(wsl + WS_B2); const float* LNS = (const float*)(wsl + WS_LNS);
    const bf16_t* SW = (const bf16_t*)(wsl + WS_SGUW) + (size_t)i * 4 * 128 * 128;
    const float* lng = p.in[9] + i * 1024; const float* lnb = p.in[10] + i * 1024; const float* bs = p.in[12] + i * 4 * 128;
    const int tid = tid_l(), lane = tid & 63, wid = tid >> 6, q = lane & 31, h = lane >> 5;
    float* mu = (float*)(lds + 73728); float* rsd = mu + 128;
    const unsigned tr_base = (unsigned)(size_t)lds + (unsigned)((8 * h + ((lane & 15) >> 2)) * 576 + (32 * wid + 16 * ((lane >> 4) & 1) + 4 * (lane & 3)) * 2);
    for (int item = bid_l(); item < 128 * 4; item += gridDim.x) {
        const int chunk = item >> 2, g = item & 3, row0 = chunk * 128;
        __syncthreads();
        if (tid < 128) { float sm = 0.f, qq = 0.f;
#pragma unroll
            for (int k = 0; k < 4; ++k) { sm += LNS[(size_t)k * M + row0 + tid]; qq += LNS[(size_t)(4 + k) * M + row0 + tid]; }
            const float mm = sm * (1.0f / 1024.f); const float var = qq * (1.0f / 1024.f) - mm * mm; mu[tid] = mm; rsd[tid] = rsqrtf(fmaxf(var, 0.f) + EPS); }
        __syncthreads();
#pragma unroll 2
        for (int k = 0; k < 8; ++k) { const int id = tid + 512 * k, j = id >> 5, c8 = id & 31, col = g * 256 + 8 * c8;
            const u32x4 w = gld<u32x4>(V + (size_t)(row0 + j) * 1024 + col);
            const f32x4 g0 = gld<f32x4>(lng + col), g1 = gld<f32x4>(lng + col + 4), b0 = gld<f32x4>(lnb + col), b1 = gld<f32x4>(lnb + col + 4);
            const float m_ = mu[j], r_ = rsd[j];
            const f32x4 v0 = (f32x4){(bflo(w.x) - m_) * r_ * g0.x + b0.x, (bfhi(w.x) - m_) * r_ * g0.y + b0.y, (bflo(w.y) - m_) * r_ * g0.z + b0.z, (bfhi(w.y) - m_) * r_ * g0.w + b0.w};
            const f32x4 v1 = (f32x4){(bflo(w.z) - m_) * r_ * g1.x + b1.x, (bfhi(w.z) - m_) * r_ * g1.y + b1.y, (bflo(w.w) - m_) * r_ * g1.z + b1.z, (bfhi(w.w) - m_) * r_ * g1.w + b1.w};
            *(u32x4*)(lds + j * 576 + c8 * 16) = pack8(v0, v1); }
        __syncthreads();
        f32x16 acc[4];
#pragma unroll
        for (int it = 0; it < 4; ++it)
#pragma unroll
            for (int e = 0; e < 16; ++e) acc[it][e] = 0.f;
        const bf16_t* wp = SW + (size_t)g * 128 * 128 + (size_t)q * 128 + 8 * h;
#pragma unroll
        for (int ks = 0; ks < 8; ++ks) {
            s16x4 t0, t1; const unsigned a = tr_base + ks * 9216;
            asm volatile("ds_read_b64_tr_b16 %0, %2 offset:0\n\tds_read_b64_tr_b16 %1, %2 offset:2304\n\ts_waitcnt lgkmcnt(0)" : "=&v"(t0), "=&v"(t1) : "v"(a) : "memory");
            const s16x8 vf = __builtin_shufflevector(t0, t1, 0, 1, 2, 3, 4, 5, 6, 7);
#pragma unroll
            for (int it = ks >> 1; it < 4; ++it) { const s16x8 wf = gld<s16x8>(wp + (size_t)(32 * it) * 128 + 16 * ks);
                acc[it] = __builtin_amdgcn_mfma_f32_32x32x16_bf16(vf, wf, acc[it], 0, 0, 0); }
        }
        __syncthreads();
#pragma unroll
        for (int it = 0; it < 4; ++it)
#pragma unroll
            for (int gg = 0; gg < 4; ++gg)
                *(f32x4*)(lds + (32 * it + q) * 1040 + (32 * wid + 8 * gg + 4 * h) * 4) = (f32x4){acc[it][4 * gg + 0], acc[it][4 * gg + 1], acc[it][4 * gg + 2], acc[it][4 * gg + 3]};
        __syncthreads();
#pragma unroll 2
        for (int k = 0; k < 8; ++k) { const int id = tid + 512 * k, ii = id >> 5, c8 = id & 31;
            const size_t off = (size_t)(row0 + ii) * 1024 + g * 256 + 8 * c8;
            const u32x4 uu = gld<u32x4>(U + off), gv = gld<u32x4>(G + off);
            const f32x4 d0 = *(const f32x4*)(lds + ii * 1040 + c8 * 32), d1 = *(const f32x4*)(lds + ii * 1040 + c8 * 32 + 16);
            const float bias = gld<float>(bs + g * 128 + ii);
            const f32x4 o0 = (f32x4){(d0.x + bias) * bflo(uu.x) * bflo(gv.x), (d0.y + bias) * bfhi(uu.x) * bfhi(gv.x), (d0.z + bias) * bflo(uu.y) * bflo(gv.y), (d0.w + bias) * bfhi(uu.y) * bfhi(gv.y)};
            const f32x4 o1 = (f32x4){(d1.x + bias) * bflo(uu.z) * bflo(gv.z), (d1.y + bias) * bfhi(uu.z) * bfhi(gv.z), (d1.z + bias) * bflo(uu.w) * bflo(gv.w), (d1.w + bias) * bfhi(uu.w) * bfhi(gv.w)};
            if (!dry) wst16(U, off * 2, pack8(o0, o1)); }
    }
}
__device__ __forceinline__ void conv_sguw(const Params& p) {
    unsigned char* wsl = p.ws; asm volatile("" : "+s"(wsl));
    bf16_t* SW = (bf16_t*)(wsl + WS_SGUW);
    for (int e = blockIdx.x * NT + tid_l(); e < 2 * 4 * 128 * 128; e += gridDim.x * NT) { const int ii = (e >> 7) & 127, j = e & 127; SW[e] = f2bf(j <= ii ? p.in[11][e] : 0.f); }
}

__device__ __forceinline__ void s5_naive(const Params& p, int i) {
    unsigned char* wsl = p.ws; asm volatile("" : "+s"(wsl));
    bf16_t* XD = (bf16_t*)(wsl + WS_B3);
    const int tidl = tid_l(), lane = tidl & 63, wid = tidl >> 6;
    if (wid != 0) return;
    for (int item = bid_l(); item < BATCH * 32; item += gridDim.x) {
        const int b = item >> 5, g = item & 31;
        const float dt = expf(p.in[15][i * 32 + g]);
        const float ar = p.in[13][(i * 32 + g) * 64 + lane], ai = p.in[14][(i * 32 + g) * 64 + lane];
        const float mag = expf(dt * ar), abr = mag * cosf(dt * ai), abi = mag * sinf(dt * ai);
        const float nr = abr - 1.0f, ni = abi, inv = 1.0f / (ar * ar + ai * ai);
        const float cr = (nr * ar + ni * ai) * inv, ci = (ni * ar - nr * ai) * inv;
        float bbr[16], bbi[16], cre[16], cim[16];
#pragma unroll
        for (int h = 0; h < 16; ++h) {
            const float br = p.in[16][((size_t)(i * 32 + g) * 64 + lane) * 16 + h], bi = p.in[17][((size_t)(i * 32 + g) * 64 + lane) * 16 + h];
            bbr[h] = cr * br - ci * bi; bbi[h] = cr * bi + ci * br;
            cre[h] = p.in[18][((size_t)(i * 32 + g) * 16 + h) * 64 + lane]; cim[h] = p.in[19][((size_t)(i * 32 + g) * 16 + h) * 64 + lane];
        }
        const float dsk = (lane < 16) ? p.in[20][i * 512 + g * 16 + lane] : 0.f;
        float hr = 0.f, hi = 0.f;
#pragma unroll 1
        for (int t = 0; t < SEQ; ++t) {
            bf16_t* up = XD + (size_t)(b * SEQ + t) * 1024 + g * 16;
            const u32x4 w0 = *(const u32x4*)up, w1 = *(const u32x4*)(up + 8);
            float u[16];
            u[0] = __uint_as_float(w0.x << 16); u[1] = __uint_as_float(w0.x & 0xffff0000u); u[2] = __uint_as_float(w0.y << 16); u[3] = __uint_as_float(w0.y & 0xffff0000u);
            u[4] = __uint_as_float(w0.z << 16); u[5] = __uint_as_float(w0.z & 0xffff0000u); u[6] = __uint_as_float(w0.w << 16); u[7] = __uint_as_float(w0.w & 0xffff0000u);
            u[8] = __uint_as_float(w1.x << 16); u[9] = __uint_as_float(w1.x & 0xffff0000u); u[10] = __uint_as_float(w1.y << 16); u[11] = __uint_as_float(w1.y & 0xffff0000u);
            u[12] = __uint_as_float(w1.z << 16); u[13] = __uint_as_float(w1.z & 0xffff0000u); u[14] = __uint_as_float(w1.w << 16); u[15] = __uint_as_float(w1.w & 0xffff0000u);
            float bur = 0.f, bui = 0.f;
#pragma unroll
            for (int h = 0; h < 16; ++h) { bur += u[h] * bbr[h]; bui += u[h] * bbi[h]; }
            const float nhr = abr * hr - abi * hi + bur, nhi = abr * hi + abi * hr + bui; hr = nhr; hi = nhi;
            float mine = 0.f, umine = 0.f;
#pragma unroll
            for (int h = 0; h < 16; ++h) { const float r = wave_sum(hr * cre[h] - hi * cim[h]); if (lane == h) { mine = r; umine = u[h]; } }
            if (lane < 16) up[lane] = f2bf(gelu_tanh_f(mine + dsk * umine));
        }
    }
}

typedef float f32x4v __attribute__((ext_vector_type(4)));
typedef float f32x2v_ __attribute__((ext_vector_type(2)));
template <int PASS>
__device__ __forceinline__ void s5_pass(float& hr, float& hi, const float (&pwr)[4], const float (&pwi)[4], const pg8::bf16x8 (&bfrag)[8], const pg8::bf16x8 (&cfrag)[4], const f32x4v dsk,
                                        bf16_t* XD, unsigned char* BUw, unsigned char* Hw, int b, int g, int wid, int lane, int tl, int kq, const int dry) {
            bf16_t* ubase = XD + (size_t)(b * SEQ + wid * 256 + tl) * 1024 + g * 16;
            pg8::bf16x8 ufn[2]; u32x2 uen[2];
#pragma unroll
            for (int k2 = 0; k2 < 2; ++k2) { ufn[k2] = (pg8::bf16x8){0, 0, 0, 0, 0, 0, 0, 0}; uen[k2] = (u32x2){0u, 0u};
                if (kq < 2) ufn[k2] = gld<pg8::bf16x8>(ubase + (size_t)(16 * k2) * 1024 + 8 * kq);
                if constexpr (PASS == 1) uen[k2] = gld<u32x2>(ubase + (size_t)(16 * k2) * 1024 + 4 * kq); }
#pragma unroll 1
            for (int tt = 0; tt < 16; ++tt) {
                bf16_t* urow = ubase + (size_t)(16 * tt) * 1024;
                const pg8::bf16x8 ufrag = ufn[0]; const u32x2 ue = uen[0];
                ufn[0] = ufn[1]; uen[0] = uen[1];
                if (tt + 2 < 16) { if (kq < 2) ufn[1] = gld<pg8::bf16x8>(urow + (size_t)32 * 1024 + 8 * kq); if constexpr (PASS == 1) uen[1] = gld<u32x2>(urow + (size_t)32 * 1024 + 4 * kq); }
#pragma unroll
                for (int rt = 0; rt < 8; ++rt) {
                    const f32x4 d = __builtin_amdgcn_mfma_f32_16x16x32_bf16(bfrag[rt], ufrag, (f32x4){0.f, 0.f, 0.f, 0.f}, 0, 0, 0);
                    *(u32x2*)(BUw + tl * 272 + (8 * rt + 2 * kq) * 4) = (u32x2){cvt_pk_bf16(d.x, d.y), cvt_pk_bf16(d.z, d.w)};
                }
                __builtin_amdgcn_wave_barrier();
                float bur[16], bui[16];
#pragma unroll
                for (int t = 0; t < 16; ++t) { const unsigned bw = *(const unsigned*)(BUw + t * 272 + lane * 4); bur[t] = bflo(bw); bui[t] = bfhi(bw); }
#pragma unroll
                for (int j = 0; j < 4; ++j)
#pragma unroll
                    for (int i2 = 1; i2 < 4; ++i2) { const int t = 4 * j + i2;
                        const float lr = fmaf(pwr[0], bur[t - 1], fmaf(-pwi[0], bui[t - 1], bur[t])), li = fmaf(pwr[0], bui[t - 1], fmaf(pwi[0], bur[t - 1], bui[t])); bur[t] = lr; bui[t] = li; }
#pragma unroll
                for (int j = 0; j < 4; ++j) {
                    const float cr = hr, ci = hi;
#pragma unroll
                    for (int i2 = 0; i2 < 4; ++i2) { const int t = 4 * j + i2;
                        const float xr = fmaf(pwr[i2], cr, fmaf(-pwi[i2], ci, bur[t])), xi = fmaf(pwr[i2], ci, fmaf(pwi[i2], cr, bui[t]));
                        if constexpr (PASS == 1) *(unsigned*)(Hw + t * 272 + lane * 4) = cvt_pk_bf16(xr, xi);
                        if (i2 == 3) { hr = xr; hi = xi; } }
                }
                if constexpr (PASS == 1) {
                    __builtin_amdgcn_wave_barrier();
                    f32x4 y = (f32x4){0.f, 0.f, 0.f, 0.f};
#pragma unroll
                    for (int kk = 0; kk < 4; ++kk) { const pg8::bf16x8 hf = *(const pg8::bf16x8*)(Hw + tl * 272 + (32 * kk + 8 * kq) * 2);
                        y = __builtin_amdgcn_mfma_f32_16x16x32_bf16(cfrag[kk], hf, y, 0, 0, 0); }
                    float yy[4] = {y.x + dsk.x * bflo(ue.x), y.y + dsk.y * bfhi(ue.x), y.z + dsk.z * bflo(ue.y), y.w + dsk.w * bfhi(ue.y)};
#pragma unroll
                    for (int r = 0; r < 4; ++r) { const float x = yy[r]; yy[r] = x * fsigmoid(1.5957691216057308f * (x + 0.044715f * x * x * x)); }
                    u32x2 w; w.x = cvt_pk_bf16(yy[0], yy[1]); w.y = cvt_pk_bf16(yy[2], yy[3]);
                    if (!dry) gst<u32x2>(urow + 4 * kq, w);
                }
                __builtin_amdgcn_wave_barrier();
            }
}
__device__ __forceinline__ void s5_mfma(unsigned char* lds, const Params& p, int i, const int dry) {
    unsigned char* wsl = p.ws; asm volatile("" : "+s"(wsl));
    bf16_t* XD = (bf16_t*)(wsl + WS_B3);
    const int tid = tid_l(), lane = tid & 63, wid = tid >> 6, tl = lane & 15, kq = lane >> 4;
    bf16_t* TB = (bf16_t*)lds;
    bf16_t* TC = (bf16_t*)(lds + 4096);
    float* AB = (float*)(lds + 8192);
    float* A256 = (float*)(lds + 8704);
    float* HE = (float*)(lds + 9216);
    unsigned char* BUw = lds + 16384 + wid * 12800;
    unsigned char* Hw = BUw + 8448;
    for (int item = bid_l(); item < BATCH * 32; item += gridDim.x) {
        const int b = item >> 5, g = item & 31;
        __syncthreads();
        if (tid < 64) {
            const int pp = tid;
            const float dt = expf(p.in[15][i * 32 + g]);
            const float ar = p.in[13][(i * 32 + g) * 64 + pp], ai = p.in[14][(i * 32 + g) * 64 + pp];
            const float mag = expf(dt * ar), abr = mag * cosf(dt * ai), abi = mag * sinf(dt * ai);
            const float nr = abr - 1.0f, ni = abi, inv = 1.0f / (ar * ar + ai * ai);
            const float cr = (nr * ar + ni * ai) * inv, ci = (ni * ar - nr * ai) * inv;
#pragma unroll
            for (int h = 0; h < 16; ++h) {
                const float br = p.in[16][((size_t)(i * 32 + g) * 64 + pp) * 16 + h], bi = p.in[17][((size_t)(i * 32 + g) * 64 + pp) * 16 + h];
                TB[(2 * pp) * 16 + h] = f2bf(cr * br - ci * bi); TB[(2 * pp + 1) * 16 + h] = f2bf(cr * bi + ci * br);
                TC[h * 128 + 2 * pp] = f2bf(p.in[18][((size_t)(i * 32 + g) * 16 + h) * 64 + pp]); TC[h * 128 + 2 * pp + 1] = f2bf(-p.in[19][((size_t)(i * 32 + g) * 16 + h) * 64 + pp]);
            }
            AB[pp] = abr; AB[64 + pp] = abi;
            float xr = abr, xi = abi;
#pragma unroll
            for (int k = 0; k < 8; ++k) { const float t2 = xr * xr - xi * xi; xi = 2.0f * xr * xi; xr = t2; }
            A256[pp] = xr; A256[64 + pp] = xi;
        }
        __syncthreads();
        const float abr = AB[lane], abi = AB[64 + lane];
        float pwr[4], pwi[4]; pwr[0] = abr; pwi[0] = abi;
#pragma unroll
        for (int k = 1; k < 4; ++k) { pwr[k] = pwr[k - 1] * abr - pwi[k - 1] * abi; pwi[k] = pwr[k - 1] * abi + pwi[k - 1] * abr; }
        pg8::bf16x8 bfrag[8], cfrag[4];
#pragma unroll
        for (int rt = 0; rt < 8; ++rt) { if (kq < 2) bfrag[rt] = *(const pg8::bf16x8*)(TB + (16 * rt + tl) * 16 + 8 * kq); else bfrag[rt] = (pg8::bf16x8){0, 0, 0, 0, 0, 0, 0, 0}; }
#pragma unroll
        for (int kk = 0; kk < 4; ++kk) cfrag[kk] = *(const pg8::bf16x8*)(TC + tl * 128 + 32 * kk + 8 * kq);
        const f32x4v dsk = *(const f32x4v*)(p.in[20] + i * 512 + g * 16 + 4 * kq);
        float hr = 0.f, hi = 0.f;
#pragma unroll 1
        for (int pass = 0; pass < 2; ++pass) {
            if (pass == 1) {
                HE[(wid * 2 + 0) * 64 + lane] = hr; HE[(wid * 2 + 1) * 64 + lane] = hi;
                __syncthreads();
                const float a2r = A256[lane], a2i = A256[64 + lane];
                hr = 0.f; hi = 0.f;
                for (int w2 = 0; w2 < wid; ++w2) { const float er = HE[(w2 * 2 + 0) * 64 + lane], ei = HE[(w2 * 2 + 1) * 64 + lane];
                    const float nr2 = a2r * hr - a2i * hi + er, ni2 = a2r * hi + a2i * hr + ei; hr = nr2; hi = ni2; }
            }
            if (pass == 0) s5_pass<0>(hr, hi, pwr, pwi, bfrag, cfrag, dsk, XD, BUw, Hw, b, g, wid, lane, tl, kq, dry);
            else s5_pass<1>(hr, hi, pwr, pwi, bfrag, cfrag, dsk, XD, BUw, Hw, b, g, wid, lane, tl, kq, dry);
        }
    }
}

__device__ __forceinline__ void final_norm(const Params& p) {
    unsigned char* wsl = p.ws; asm volatile("" : "+s"(wsl));
    const bf16_t* XB = (const bf16_t*)(wsl + WS_XB);
    const int tidl = tid_l(), lane = tidl & 63, gw = blockIdx.x * (NT / 64) + (tidl >> 6), ngw = gridDim.x * (NT / 64);
    for (int row = gw; row < M; row += ngw) {
        const u32x4 a = gld<u32x4>(XB + (size_t)row * DM + 8 * lane), c = gld<u32x4>(XB + (size_t)row * DM + 512 + 8 * lane);
        float v[16] = {bflo(a.x), bfhi(a.x), bflo(a.y), bfhi(a.y), bflo(a.z), bfhi(a.z), bflo(a.w), bfhi(a.w), bflo(c.x), bfhi(c.x), bflo(c.y), bfhi(c.y), bflo(c.z), bfhi(c.z), bflo(c.w), bfhi(c.w)};
        float s = 0.f;
#pragma unroll
        for (int j = 0; j < 16; ++j) s += v[j] * v[j];
        s = wave_sum(s); const float r = rsqrtf(s * (1.0f / DM) + EPS);
        const float* gp = p.in[29] + 8 * lane; float* op = p.out + (size_t)row * DM + 8 * lane;
#pragma unroll
        for (int hh = 0; hh < 2; ++hh) { const f32x4 g0 = gld<f32x4>(gp + 512 * hh), g1 = gld<f32x4>(gp + 512 * hh + 4);
            gst<f32x4>(op + 512 * hh, (f32x4){v[8 * hh + 0] * r * g0.x, v[8 * hh + 1] * r * g0.y, v[8 * hh + 2] * r * g0.z, v[8 * hh + 3] * r * g0.w});
            gst<f32x4>(op + 512 * hh + 4, (f32x4){v[8 * hh + 4] * r * g1.x, v[8 * hh + 5] * r * g1.y, v[8 * hh + 6] * r * g1.z, v[8 * hh + 7] * r * g1.w}); }
    }
}

#define WSL(name) unsigned char* name = p.ws; asm volatile("" : "+s"(name))
#define PBF(ws_, off) ((bf16_t*)((ws_) + (off)))
#define PF32(ws_, off) ((float*)((ws_) + (off)))
#ifndef F_KV
#define F_KV 1
#endif
#ifndef F_G1
#define F_G1 1
#endif
#ifndef F_G1U
#define F_G1U 1
#endif
#ifndef F_GG
#define F_GG 1
#endif
#ifndef F_G2
#define F_G2 1
#endif
#ifndef F_G1O
#define F_G1O 1
#endif
#ifndef F_GLU
#define F_GLU 1
#endif
#ifndef F_G2O
#define F_G2O 1
#endif
#ifndef F_G3
#define F_G3 1
#endif
#ifndef F_G4
#define F_G4 1
#endif
#define XB_TMO      128
#define XB_XCNT(j)  (256  + 64 * (j))
#define XB_XSUB(j)  (1280 + 64 * (j))
#define XB_XGEN(j)  (2304 + 64 * (j))
#define XB_TOP      3328
#define XB_TOPGEN   3392
#define XCD_BAR_WORDS 3456
#define XB_SPIN_CAP (1u << 22)
__device__ __forceinline__ unsigned xb_ld(unsigned* p)              { return __hip_atomic_load(p, __ATOMIC_RELAXED, __HIP_MEMORY_SCOPE_AGENT); }
__device__ __forceinline__ unsigned xb_add(unsigned* p, unsigned v) { return __hip_atomic_fetch_add(p, v, __ATOMIC_RELAXED, __HIP_MEMORY_SCOPE_AGENT); }
__device__ __forceinline__ unsigned xb_xcc_id() { return (unsigned)__builtin_amdgcn_s_getreg((3 << 11) | 20) & 0xFu; }
#define XB_SPIN(cond, bar) do { unsigned _sp = 0; while (cond) { __builtin_amdgcn_s_sleep(1); \
    if ((++_sp & 255u) == 0u) { if (xb_ld(&(bar)[XB_TMO])) break; if (_sp > XB_SPIN_CAP) { atomicAdd(&(bar)[XB_TMO], 1u); break; } } } } while (0)
struct XcdBarrier { unsigned* bar; unsigned x; volatile PG8_LAS unsigned* st; };
__device__ __forceinline__ XcdBarrier xcd_barrier_post(unsigned* bar, volatile PG8_LAS unsigned* st) {
    XcdBarrier b; b.bar = bar; b.x = xb_xcc_id(); b.st = st;
    if (threadIdx.x == 0) (void)xb_add(&bar[XB_XCNT(b.x)], 1u);
    return b;
}
__device__ __forceinline__ void xcd_barrier_complete(unsigned* bar, unsigned x, unsigned& nloc, unsigned& nx) {
    const unsigned G = gridDim.x * gridDim.y * gridDim.z;
    unsigned sum, cnt, mine, sp = 0u;
    for (;;) {
        sum = 0u; cnt = 0u; mine = 0u;
#pragma unroll
        for (unsigned j = 0; j < 16; ++j) { const unsigned c = xb_ld(&bar[XB_XCNT(j)]); sum += c; cnt += (c > 0u) ? 1u : 0u; mine = (j == x) ? c : mine; }
        if (sum == G) break;
        __builtin_amdgcn_s_sleep(1);
        if ((++sp & 255u) == 0u) { if (xb_ld(&bar[XB_TMO])) break; if (sp > XB_SPIN_CAP) { atomicAdd(&bar[XB_TMO], 1u); break; } }
    }
    nloc = mine > 0u ? mine : 1u; nx = cnt > 0u ? cnt : 1u;
}
__device__ __forceinline__ void xcd_barrier(const XcdBarrier& b) {
    asm volatile("s_waitcnt vmcnt(0)" ::: "memory");
    __syncthreads();
    if (threadIdx.x == 0) {
        unsigned* bar = b.bar;
        __builtin_amdgcn_s_waitcnt(0);
        unsigned nloc = b.st[0], nx = b.st[1];
        if (nloc == 0u) { xcd_barrier_complete(bar, b.x, nloc, nx); b.st[0] = nloc; b.st[1] = nx; }
        const unsigned old = xb_add(&bar[XB_XSUB(b.x)], 1u);
        const unsigned gen = old / nloc;
        if (old + 1u == (gen + 1u) * nloc) {
            __builtin_amdgcn_fence(__ATOMIC_RELEASE, "agent");
            asm volatile("s_waitcnt vmcnt(0)" ::: "memory");
            const unsigned og = xb_add(&bar[XB_TOP], 1u);
            const unsigned tg = og / nx;
            if (og + 1u == (tg + 1u) * nx) xb_add(&bar[XB_TOPGEN], 1u);
            else XB_SPIN(xb_ld(&bar[XB_TOPGEN]) == tg, bar);
            __builtin_amdgcn_fence(__ATOMIC_ACQUIRE, "agent");
            xb_add(&bar[XB_XGEN(b.x)], 1u);
            asm volatile("s_waitcnt vmcnt(0)" ::: "memory");
        } else {
            XB_SPIN(xb_ld(&bar[XB_XGEN(b.x)]) == gen, bar);
            __builtin_amdgcn_fence(__ATOMIC_ACQUIRE, "agent");
            asm volatile("s_waitcnt vmcnt(0)" ::: "memory");
        }
    }
    __syncthreads();
}

#ifndef REPEAT_MASK
#define REPEAT_MASK 0
#endif
#ifndef SYNC_REP
#define SYNC_REP 1
#endif
#define REPN(ty) (((REPEAT_MASK >> (ty)) & 1) ? 2 : 1)
#define RUN(ty, ...) do { for (int rep_ = 0; rep_ < REPN(ty); ++rep_) { int dry = rep_; asm volatile("" : "+s"(dry)); __VA_ARGS__ } } while (0)
#define GSYNC() do { for (int sr_ = 0; sr_ < SYNC_REP; ++sr_) xcd_barrier(xbar); } while (0)
__global__ void __launch_bounds__(NT) mega(Params p) {
    extern __shared__ __attribute__((aligned(16))) unsigned char lds[];
    if (threadIdx.x < 2) ((volatile PG8_LAS unsigned*)((PG8_LAS unsigned char*)lds + 143360))[threadIdx.x] = 0u;
    __syncthreads();
    const XcdBarrier xbar = xcd_barrier_post((unsigned*)p.ws, (volatile PG8_LAS unsigned*)((PG8_LAS unsigned char*)lds + 143360));
    constexpr size_t SEG = (size_t)(WS_B1 - WS_B0) / 2;

    RUN(0, {
        WSL(ws);
#ifndef PREP
#define PREP 0
#endif
        init_rows(p); if (PREP & 1) init_rows(p);
        cvt_wvb(p);
        cvt_wxqn(p);
        conv_sguw(p);
        for (int pr_ = 0; pr_ < ((PREP & 4) ? 2 : 1); ++pr_) {
        int tc = 0;
        for (int l = 0; l < 4; ++l) conv_job(lds, p.in[26] + (size_t)l * 1024 * 2048, 2048, 0, 2048, 1024, PBF(ws, WS_WKVT) + (size_t)l * 2048 * 1024, nullptr, 1.0f, tc);
        conv_inproj(lds, p, 0, tc);
        for (int ig = 0; ig < 8; ++ig) conv_job(lds, p.in[4] + (size_t)ig * 256 * 256, 256, 0, 256, 256, PBF(ws, WS_PWT) + (size_t)ig * 256 * 256, nullptr, 1.0f, tc);
        for (int i = 0; i < 2; ++i) conv_job(lds, p.in[6] + (size_t)i * 2048 * 1024, 1024, 0, 1024, 2048, PBF(ws, WS_WOAB) + (size_t)i * 1024 * 2048, nullptr, 1.0f, tc);
        for (int i = 0; i < 2; ++i) conv_job(lds, p.in[23] + (size_t)i * 1536 * 1024, 1024, 0, 1024, 1536, PBF(ws, WS_WOCD) + (size_t)i * 1024 * 1536, nullptr, 1.0f, tc);
        for (int l = 0; l < 4; ++l) conv_job(lds, p.in[27] + (size_t)l * 1024 * 1024, 1024, 0, 1024, 1024, PBF(ws, WS_WXO) + (size_t)l * 1024 * 1024, nullptr, 1.0f, tc);
        for (int i = 0; i < 2; ++i)
            for (int j = 0; j < 4; ++j) {
                conv_job(lds, p.in[21] + (size_t)i * 512 * 512, 512, 128 * j, 128, 512, PBF(ws, WS_GLU) + (size_t)i * 1024 * 512 + (size_t)(256 * j) * 512, nullptr, 1.0f, tc);
                conv_job(lds, p.in[22] + (size_t)i * 512 * 512, 512, 128 * j, 128, 512, PBF(ws, WS_GLU) + (size_t)i * 1024 * 512 + (size_t)(256 * j + 128) * 512, nullptr, 1.0f, tc);
            }
        }
        (void)dry;
    });
    GSYNC();
    RUN(1, {
        WSL(ws);
        for (int ig = 0; ig < 8; ++ig) { const int vcf = (int)blockIdx.x - 4 * ig;
            EpiFold E{PBF(ws, WS_WUT) + (size_t)(ig >> 2) * 1024 * WIN_LD + (size_t)(ig & 3) * 256 * WIN_LD, p.in[5] + (ig >> 2) * 1024 + (ig & 3) * 256};
            run_gemm<1>(lds, PBF(ws, WS_PWT) + (size_t)ig * 256 * 256, PBF(ws, WS_PWT) + (size_t)ig * 256 * 256, 256, PBF(ws, WS_WVB) + (size_t)ig * 1024 * 256, 256, 1024, 256, E, 1 << 20, 0, 1 << 20, 0, 4, (vcf >= 0 && vcf < 4) ? vcf : -1, 256); }
        const int hg = (int)gridDim.x >> 1;
        { EpiProj E{PBF(ws, WS_KVX), (size_t)MM * 1024, nullptr, 0u, nullptr, -1, 0, 1024, nullptr}; run_gemm<F_KV>(lds, PBF(ws, WS_MEMNB), PBF(ws, WS_MEMNB), 1024, PBF(ws, WS_WKVT), MM, 4096, 1024, E, 1 << 20, 0, 4, 4, hg, (int)blockIdx.x < hg ? (int)blockIdx.x : -1); }
        { EpiProj E{PBF(ws, WS_VTX), (size_t)MM * 1024, nullptr, 0u, nullptr, -1, 0, 1024, nullptr}; run_gemm<F_KV>(lds, PBF(ws, WS_MEMNB), PBF(ws, WS_MEMNB), 1024, PBF(ws, WS_WKVT) + (size_t)1024 * 1024, MM, 4096, 1024, E, 1 << 20, 0, 4, 4, hg, (int)blockIdx.x >= hg ? (int)blockIdx.x - hg : -1); }
        (void)dry;
    });
    GSYNC();

    const bool trail_ok = gridDim.x == 256;
#pragma unroll 1
    for (int l = 0; l < 4; ++l) {
        const int i = l >> 1;
        if ((l & 1) == 0) {
            RUN(2, {
            { WSL(ws); EpiProj E{PBF(ws, WS_B0), SEG, PF32(ws, WS_RS), 0u, nullptr, -1, 1, 1024, nullptr, 7u, (bf16_t*)p.out};
              run_gemm<F_G1, EpiProj, false>(lds, PBF(ws, WS_XB), PBF(ws, WS_XB), 1024, PBF(ws, WS_WIN), M, 4096, 1024, E, 1 << 20, 0, 1 << 20, 0, 0, 0, 1024, WIN_LD, PBF(ws, WS_WUT) + (size_t)i * 1024 * WIN_LD, 12); }
            (void)dry; });
            GSYNC();
            RUN(3, { dil_attn_mfma(lds, p, dry); });
            GSYNC();
            RUN(4, { WSL(ws); EpiGates E{EpiGateA{PBF(ws, WS_B0), PF32(ws, WS_RS), dry}, EpiGateB{PBF(ws, WS_B1), PBF(ws, WS_B3), PF32(ws, WS_RS), dry}};
                     run_gemm<F_GG>(lds, PBF(ws, WS_XB), PBF(ws, WS_XB), 1024, PBF(ws, WS_WIN) + (size_t)3072 * WIN_LD, M, 2048, 1024, E, 1 << 20, 0, 1 << 20, 0, 0, 0, 1024, WIN_LD); });
            GSYNC();
            RUN(5, { WSL(ws); EpiResid E{PBF(ws, WS_XB), PF32(ws, WS_RS), lds + 131072, dry, !trail_ok};
                     if (trail_ok) { const bf16_t* tA; const bf16_t* tB; bf16_t* tD; xattn_prep_unit(ws, l, bid_l(), tA, tB, tD); EpiTile E2{tD};
                         pg8::Gemm g{PBF(ws, WS_B0), PBF(ws, WS_B1), 1024 / 64, 1024, PBF(ws, WS_WOAB) + (size_t)i * 1024 * 2048, M, 1024, 2048, 1 << 20, 0, 1 << 20, 0, 0, 0, 2048, nullptr, 1 << 20};
                         pg8::gemm_phase<EpiResid, true, EpiTile>((PG8_LAS unsigned char*)lds, g, E, pg8::Trail{tA, tB, 4, 1024}, E2); }
                     else run_gemm<F_G2>(lds, PBF(ws, WS_B0), PBF(ws, WS_B1), 1024, PBF(ws, WS_WOAB) + (size_t)i * 1024 * 2048, M, 1024, 2048, E); });
        } else {
            RUN(6, { WSL(ws); EpiProj E{PBF(ws, WS_B0), SEG, PF32(ws, WS_RS), (3u << 4) | (2u << 6), PF32(ws, WS_LNS), 1, 1, 1024, lds + 131072}; run_gemm<F_G1O, EpiProj, false>(lds, PBF(ws, WS_XB), PBF(ws, WS_XB), 1024, PBF(ws, WS_WIN), M, 4096, 1024, E, 1 << 20, 0, 1 << 20, 0, 0, 0, 1024, WIN_LD); (void)dry; });
            GSYNC();
            RUN(7, { s5_mfma(lds, p, i, dry); __syncthreads(); });
            RUN(13, { sgu_mfma(lds, p, i, dry); __syncthreads(); });
            GSYNC();
            RUN(8, { WSL(ws); EpiGlu E{PBF(ws, WS_B3) + 512, dry}; run_gemm<F_GLU>(lds, PBF(ws, WS_B3), PBF(ws, WS_B3), 512, PBF(ws, WS_GLU) + (size_t)i * 1024 * 512, M, 1024, 512, E); });
            GSYNC();
            RUN(9, { WSL(ws); EpiResid E{PBF(ws, WS_XB), PF32(ws, WS_RS), lds + 131072, dry, !trail_ok};
                     if (trail_ok) { const bf16_t* tA; const bf16_t* tB; bf16_t* tD; xattn_prep_unit(ws, l, bid_l(), tA, tB, tD); EpiTile E2{tD};
                         pg8::Gemm g{PBF(ws, WS_B0), PBF(ws, WS_B3) + 512, 1024 / 64, 1024, PBF(ws, WS_WOCD) + (size_t)i * 1024 * 1536, M, 1024, 1536, 1 << 20, 0, 1 << 20, 0, 0, 0, 1536, nullptr, 1 << 20};
                         pg8::gemm_phase<EpiResid, true, EpiTile>((PG8_LAS unsigned char*)lds, g, E, pg8::Trail{tA, tB, 4, 1024}, E2); }
                     else run_gemm<F_G2O>(lds, PBF(ws, WS_B0), PBF(ws, WS_B3) + 512, 1024, PBF(ws, WS_WOCD) + (size_t)i * 1024 * 1536, M, 1024, 1536, E); });
        }
        if (!trail_ok) RUN(10, { xattn_prep(lds, p, l); (void)dry; });
        GSYNC();
        RUN(11, {
            { int tc = 0; if (l < 3) conv_inproj(lds, p, l + 1, tc); }
            __syncthreads();
            xattn_s(lds, p);
            (void)dry; });
        GSYNC();
        RUN(12, { xattn_o(lds, p, dry); });
        GSYNC();
    }
    final_norm(p);
}

extern "C" void kernel_launch(void* const* d_in, const int* in_sizes, int n_in, void* d_out, int out_size, void* d_ws, size_t ws_size, hipStream_t stream) {
    static int grid = 0;
    if (grid == 0) {
        if (n_in != 30 || out_size != M * DM || ws_size < WS_END) { fprintf(stderr, "kernel_launch: unexpected shapes n_in %d out %d ws %zu\n", n_in, out_size, ws_size); grid = -1; return; }
        int dev = 0, cus = 0, per_cu = 0;
        (void)hipGetDevice(&dev);
        (void)hipDeviceGetAttribute(&cus, hipDeviceAttributeMultiprocessorCount, dev);
        (void)hipFuncSetAttribute((const void*)mega, hipFuncAttributeMaxDynamicSharedMemorySize, LDS_BYTES);
        (void)hipOccupancyMaxActiveBlocksPerMultiprocessor(&per_cu, (const void*)mega, NT, LDS_BYTES);
        if (per_cu < 1) per_cu = 1;
        grid = cus * per_cu;
    }
    if (grid < 0) return;
    Params p{};
    for (int i = 0; i < 30; ++i) p.in[i] = (const float*)d_in[i];
    p.out = (float*)d_out; p.ws = (unsigned char*)d_ws;
    (void)hipMemsetAsync(d_ws, 0, 16384, stream);
    void* args[] = {&p};
    hipError_t e = hipLaunchCooperativeKernel((void*)mega, dim3(grid), dim3(NT), args, LDS_BYTES, stream);
    if (e != hipSuccess) fprintf(stderr, "cooperative launch failed: %s (grid %d)\n", hipGetErrorString(e), grid);
}
```

```cpp
#include <hip/hip_runtime.h>
#include <hip/hip_cooperative_groups.h>
#include <cstdio>
#include <cstdint>
namespace cg = cooperative_groups;

typedef unsigned short bf16_t;
typedef float f32x4 __attribute__((ext_vector_type(4)));
typedef unsigned u32x4 __attribute__((ext_vector_type(4)));
typedef unsigned u32x2 __attribute__((ext_vector_type(2)));

constexpr int BATCH = 8, SEQ = 2048, DM = 1024, M = BATCH * SEQ, MEML = 256, MM = BATCH * MEML;
constexpr float EPS = 1e-6f;
constexpr int NT = 512;
constexpr int LDS_BYTES = 147456;

constexpr size_t MiB = 1u << 20;
constexpr size_t WS_RS = 1 * MiB;
constexpr size_t WS_LNS = 2 * MiB;
constexpr size_t WS_SGUW = 3 * MiB;
constexpr size_t WS_XB = 8 * MiB;
constexpr size_t WS_B0 = 40 * MiB, WS_B1 = 72 * MiB, WS_B2 = 104 * MiB, WS_B3 = 136 * MiB;
constexpr size_t WS_KVX = 168 * MiB;
constexpr size_t WS_VTX = 184 * MiB;
constexpr int WIN_LD = 1088;
constexpr size_t WS_WIN = 200 * MiB;
constexpr size_t WS_WUT = 248 * MiB;
constexpr size_t WS_WOAB = 216 * MiB;
constexpr size_t WS_WOCD = 224 * MiB;
constexpr size_t WS_WXQ = 230 * MiB;
constexpr size_t WS_WXO = 238 * MiB;
constexpr size_t WS_GLU = 246 * MiB;
constexpr size_t WS_END = 253 * MiB;
constexpr size_t WS_WKVT = WS_B0;
constexpr size_t WS_MEMNB = WS_B1;
constexpr size_t WS_PWT = WS_B2;
constexpr size_t WS_WVB = WS_B2 + 2 * MiB;

struct Params { const float* in[30]; float* out; unsigned char* ws; };

#define GAS __attribute__((address_space(1)))
template <class T> __device__ __forceinline__ T gld(const void* p) { return *(const GAS T*)p; }
template <class T> __device__ __forceinline__ void gst(void* p, T v) { *(GAS T*)p = v; }
#ifndef WT_STORES
#define WT_STORES 1
#endif
__device__ __forceinline__ void wst8(void* base, size_t off, u32x2 v) {
#if WT_STORES
    const __amdgpu_buffer_rsrc_t r = __builtin_amdgcn_make_buffer_rsrc(base, (short)0, 0x7fffffff, 0x00020000);
    __builtin_amdgcn_raw_buffer_store_b64(v, r, (unsigned)off, 0, 16);
#else
    *(GAS u32x2*)((unsigned char*)base + off) = v;
#endif
}
__device__ __forceinline__ void wst16(void* base, size_t off, u32x4 v) {
#if WT_STORES
    const __amdgpu_buffer_rsrc_t r = __builtin_amdgcn_make_buffer_rsrc(base, (short)0, 0x7fffffff, 0x00020000);
    __builtin_amdgcn_raw_buffer_store_b128(v, r, (unsigned)off, 0, 16);
#else
    *(GAS u32x4*)((unsigned char*)base + off) = v;
#endif
}
__device__ __forceinline__ void st16(void* base, size_t off, u32x4 v, const bool wt) { if (wt) wst16(base, off, v); else *(GAS u32x4*)((unsigned char*)base + off) = v; }
__device__ __forceinline__ int tid_l() { int t = threadIdx.x; asm volatile("" : "+v"(t)); return t; }
__device__ __forceinline__ int bid_l() { int b = blockIdx.x; asm volatile("" : "+s"(b)); return b; }
__device__ __forceinline__ float quad_rows_sum(float v) {
    { const auto r = __builtin_amdgcn_permlane16_swap(__float_as_uint(v), __float_as_uint(v), false, false); v = __uint_as_float(r[0]) + __uint_as_float(r[1]); }
    { const auto r = __builtin_amdgcn_permlane32_swap(__float_as_uint(v), __float_as_uint(v), false, false); v = __uint_as_float(r[0]) + __uint_as_float(r[1]); }
    return v;
}
__device__ __forceinline__ float quad_rows_max(float v) {
    { const auto r = __builtin_amdgcn_permlane16_swap(__float_as_uint(v), __float_as_uint(v), false, false); v = fmaxf(__uint_as_float(r[0]), __uint_as_float(r[1])); }
    { const auto r = __builtin_amdgcn_permlane32_swap(__float_as_uint(v), __float_as_uint(v), false, false); v = fmaxf(__uint_as_float(r[0]), __uint_as_float(r[1])); }
    return v;
}
__device__ __forceinline__ float bf2f(bf16_t v) { return __uint_as_float(((unsigned)v) << 16); }
__device__ __forceinline__ bf16_t f2bf(float f) { unsigned u = __float_as_uint(f); u += 0x7fffu + ((u >> 16) & 1u); return (bf16_t)(u >> 16); }
__device__ __forceinline__ float wave_sum(float v) {
#pragma unroll
    for (int o = 1; o < 64; o <<= 1) v += __shfl_xor(v, o);
    return v;
}
__device__ __forceinline__ float wave_max(float v) {
#pragma unroll
    for (int o = 1; o < 64; o <<= 1) v = fmaxf(v, __shfl_xor(v, o));
    return v;
}
__device__ __forceinline__ float half_sum32(float v) {
#pragma unroll
    for (int o = 1; o < 32; o <<= 1) v += __shfl_xor(v, o);
    return v;
}
__device__ __forceinline__ float silu_f(float x) { return x / (1.0f + expf(-x)); }
__device__ __forceinline__ float sigmoid_f(float x) { return 1.0f / (1.0f + expf(-x)); }
__device__ __forceinline__ float gelu_tanh_f(float x) { return 0.5f * x * (1.0f + tanhf(0.7978845608028654f * (x + 0.044715f * x * x * x))); }
__device__ __forceinline__ float rstd_of(const float* RS, int row) { return rsqrtf(((gld<float>(RS + row) + gld<float>(RS + M + row)) + (gld<float>(RS + 2 * M + row) + gld<float>(RS + 3 * M + row))) * (1.0f / DM) + EPS); }
__device__ __forceinline__ float fsilu(float x) { return x * __builtin_amdgcn_rcpf(1.0f + __builtin_amdgcn_exp2f(-1.4426950408889634f * x)); }
__device__ __forceinline__ float fsigmoid(float x) { return __builtin_amdgcn_rcpf(1.0f + __builtin_amdgcn_exp2f(-1.4426950408889634f * x)); }
typedef float cvt_f32x2 __attribute__((ext_vector_type(2)));
typedef __bf16 cvt_bf16x2 __attribute__((ext_vector_type(2)));
__device__ __forceinline__ unsigned cvt_pk_bf16(float lo, float hi) { const cvt_f32x2 v = {lo, hi}; return __builtin_bit_cast(unsigned, __builtin_convertvector(v, cvt_bf16x2)); }
__device__ __forceinline__ float bflo(unsigned w) { return __uint_as_float(w << 16); }
__device__ __forceinline__ float bfhi(unsigned w) { return __uint_as_float(w & 0xffff0000u); }

__device__ __forceinline__ void conv_job(unsigned char* lds, const float* src, int ldn, int n0, int Nrows, int K, bf16_t* dst, const float* rs, float scale, int& tc, int ldd = 0, const bool wt = true) {
    if (ldd == 0) ldd = K;
    const int tid = tid_l(), lane = tid & 63, wid = tid >> 6;
    float* T = (float*)lds + wid * (64 * 65);
    const int nnt = Nrows / 64, ntile = (K / 64) * nnt, gw = blockIdx.x * (NT / 64) + wid, ngw = gridDim.x * (NT / 64);
    const int r4 = lane >> 4, c16 = lane & 15;
    for (int t = ((gw - tc) % ngw + ngw) % ngw; t < ntile; t += ngw) {
        const int kt = t / nnt, nt = t % nnt, k0 = kt * 64, nn0 = nt * 64;
        f32x4 v[16];
#pragma unroll
        for (int i = 0; i < 16; ++i) v[i] = gld<f32x4>(src + (size_t)(k0 + r4 + 4 * i) * ldn + n0 + nn0 + 4 * c16);
#pragma unroll
        for (int i = 0; i < 16; ++i) { const int kk = r4 + 4 * i; const float sc = rs ? scale * gld<float>(rs + k0 + kk) : scale; float* tp = T + kk * 65 + 4 * c16;
            tp[0] = v[i].x * sc; tp[1] = v[i].y * sc; tp[2] = v[i].z * sc; tp[3] = v[i].w * sc; }
        __builtin_amdgcn_wave_barrier();
#pragma unroll
        for (int j = 0; j < 8; ++j) { const int nn = (lane >> 3) + 8 * j, kc = (lane & 7) * 8; const float* tp = T + kc * 65 + nn; u32x4 o;
            o.x = cvt_pk_bf16(tp[0], tp[65]); o.y = cvt_pk_bf16(tp[2 * 65], tp[3 * 65]); o.z = cvt_pk_bf16(tp[4 * 65], tp[5 * 65]); o.w = cvt_pk_bf16(tp[6 * 65], tp[7 * 65]);
            st16(dst, ((size_t)(nn0 + nn) * ldd + k0 + kc) * 2, o, wt); }
        __builtin_amdgcn_wave_barrier();
    }
    tc += ntile;
}

__device__ __forceinline__ void conv_inproj(unsigned char* lds, const Params& p, int l, int& tc, const bool wt = true) {
    unsigned char* wsl = p.ws; asm volatile("" : "+s"(wsl));
    bf16_t* W = (bf16_t*)(wsl + WS_WIN);
    const int i = l >> 1;
    if ((l & 1) == 0) {
        const float* src = p.in[3] + (size_t)i * 1024 * 6144; const float* g = p.in[2] + i * 1024;
        conv_job(lds, src, 6144, 0, 1024, 1024, W, g, 0.125f * 1.4426950408889634f, tc, WIN_LD, wt);
        conv_job(lds, src, 6144, 1024, 3072, 1024, W + (size_t)1024 * WIN_LD, g, 1.0f, tc, WIN_LD, wt);
        conv_job(lds, src, 6144, 5120, 1024, 1024, W + (size_t)4096 * WIN_LD, g, 1.0f, tc, WIN_LD, wt);
    } else {
        const float* src = p.in[8] + (size_t)i * 1024 * 4096; const float* g = p.in[7] + i * 1024;
        conv_job(lds, src, 4096, 0, 4096, 1024, W, g, 1.0f, tc, WIN_LD, wt);
    }
}

template <class Epi>
__device__ __forceinline__ void ngemm(unsigned char* lds, const bf16_t* A1, const bf16_t* A2, int K1, int lda, const bf16_t* Bt, int Mrows, int N, int K, const Epi& E) {
    float* As = (float*)lds;
    float* Bs = As + 32 * 68;
    const int tid = tid_l(), tx = tid & 31, ty = tid >> 5;
    const int ntm = Mrows / 64, ntn = N / 256;
    for (int tile = blockIdx.x; tile < ntm * ntn; tile += gridDim.x) {
        const int tm = tile % ntm, tn = tile / ntm;
        float acc[4][8];
#pragma unroll
        for (int r = 0; r < 4; ++r)
#pragma unroll
            for (int j = 0; j < 8; ++j) acc[r][j] = 0.f;
        for (int k0 = 0; k0 < K; k0 += 32) {
            { const int r = tid >> 3, kc = (tid & 7) * 4;
              const bf16_t* ap = (k0 < K1) ? (A1 + (size_t)(tm * 64 + r) * lda + k0 + kc) : (A2 + (size_t)(tm * 64 + r) * lda + (k0 - K1) + kc);
              const u32x2 w = *(const u32x2*)ap;
              As[(kc + 0) * 68 + r] = __uint_as_float(w.x << 16); As[(kc + 1) * 68 + r] = __uint_as_float(w.x & 0xffff0000u);
              As[(kc + 2) * 68 + r] = __uint_as_float(w.y << 16); As[(kc + 3) * 68 + r] = __uint_as_float(w.y & 0xffff0000u); }
            { const int n = tid >> 1, kc = (tid & 1) * 16;
              const bf16_t* bp = Bt + (size_t)(tn * 256 + n) * K + k0 + kc;
#pragma unroll
              for (int h = 0; h < 2; ++h) { const u32x4 w = *(const u32x4*)(bp + 8 * h); const int kk = kc + 8 * h;
                  Bs[(kk + 0) * 260 + n] = __uint_as_float(w.x << 16); Bs[(kk + 1) * 260 + n] = __uint_as_float(w.x & 0xffff0000u);
                  Bs[(kk + 2) * 260 + n] = __uint_as_float(w.y << 16); Bs[(kk + 3) * 260 + n] = __uint_as_float(w.y & 0xffff0000u);
                  Bs[(kk + 4) * 260 + n] = __uint_as_float(w.z << 16); Bs[(kk + 5) * 260 + n] = __uint_as_float(w.z & 0xffff0000u);
                  Bs[(kk + 6) * 260 + n] = __uint_as_float(w.w << 16); Bs[(kk + 7) * 260 + n] = __uint_as_float(w.w & 0xffff0000u); } }
            __syncthreads();
#pragma unroll 8
            for (int k = 0; k < 32; ++k) {
                const f32x4 a = *(const f32x4*)(As + k * 68 + ty * 4);
                float b[8];
#pragma unroll
                for (int j = 0; j < 8; ++j) b[j] = Bs[k * 260 + tx + 32 * j];
#pragma unroll
                for (int j = 0; j < 8; ++j) { acc[0][j] += a.x * b[j]; acc[1][j] += a.y * b[j]; acc[2][j] += a.z * b[j]; acc[3][j] += a.w * b[j]; }
            }
            __syncthreads();
        }
#pragma unroll
        for (int r = 0; r < 4; ++r) E.row(tm * 64 + ty * 4 + r, tn * 256 + tx, acc[r]);
    }
}

namespace pg8 {
#define PG8_LAS __attribute__((address_space(3)))
typedef short bf16x8 __attribute__((ext_vector_type(8)));
constexpr int BM = 256, BK = 64, HALF = 128, HTB = HALF * BK * 2, STAGE_BYTES = 8 * HTB, NXCD = 8, WGM = 8;
__host__ __device__ __forceinline__ int lds_byte(int r, int c) { const int st = (r >> 4) * 2 + (c >> 5), rr = r & 15, cc = c & 31, ob = rr * 64 + cc * 2; return st * 1024 + (ob ^ (((ob >> 9) & 1) << 5)); }
__host__ __device__ __forceinline__ void stage_rc(int b, int& R, int& C) { const int st = b / 1024, sb = b % 1024, swz = sb ^ (((sb >> 9) & 1) << 5); R = (st >> 1) * 16 + swz / 64; C = (st & 1) * 32 + (swz % 64) / 2; }
__host__ __device__ __forceinline__ int perm32(int rho) { const int n = rho >> 4, i = rho & 15; return 8 * (i >> 2) + 4 * n + (i & 3); }
struct Unit { int pm, pn; };
struct Gemm { const bf16_t* A1; const bf16_t* A2; int nt1; int lda; const bf16_t* Bt; int M, N, K; int a_grp, a_skip, b_grp, b_skip; int vG, vc; int ldb; const bf16_t* Bt2; int nsplit; };
struct StaticOrder {
    int nM, nN, nwg, G, c;
    __device__ void init(int M_, int N_, int G_, int c_) { nM = M_ / BM; nN = N_ / BM; nwg = nM * nN; G = G_; c = c_; }
    __device__ bool next(int i, Unit& u) const {
        const long L = (long)i * G + c; if (L >= nwg) return false;
        int wgid = (int)L; { const int q = nwg / NXCD, r = nwg % NXCD, xcd = wgid % NXCD, off = wgid / NXCD; wgid = (xcd < r ? xcd * (q + 1) : r * (q + 1) + (xcd - r) * q) + off; }
        const int nig = WGM * nN, gid = wgid / nig, fm = gid * WGM, gsz = (nM - fm) < WGM ? (nM - fm) : WGM;
        u.pm = fm + ((wgid % nig) % gsz); u.pn = (wgid % nig) / gsz; return true;
    }
};
__device__ __forceinline__ int static_unit(int M_, int N_, int G, int c, int i) {
    const int nM = M_ / BM, nN = N_ / BM, nwg = nM * nN; const long L = (long)i * G + c; if (L >= nwg) return -1;
    int wgid = (int)L; { const int q = nwg / NXCD, r = nwg % NXCD, xcd = wgid % NXCD, off = wgid / NXCD; wgid = (xcd < r ? xcd * (q + 1) : r * (q + 1) + (xcd - r) * q) + off; }
    const int nig = WGM * nN, gid = wgid / nig, fm = gid * WGM, gsz = (nM - fm) < WGM ? (nM - fm) : WGM;
    return (fm + ((wgid % nig) % gsz)) * 65536 + (wgid % nig) / gsz;
}
template <class Epi, bool TAIL = true>
__device__ __forceinline__ void gemm_phase(PG8_LAS unsigned char* lds, const Gemm g, const Epi& E) {
    const int tid = tid_l(), wid = __builtin_amdgcn_readfirstlane(tid >> 6), lane = tid & 63, wr = wid >> 2, wc = wid & 3, fr = lane & 15, fq = lane >> 4;
    if (g.vG > 0 && g.vc < 0) return;
    StaticOrder S; S.init(g.M, g.N, g.vG > 0 ? g.vG : (int)gridDim.x, g.vG > 0 ? g.vc : bid_l());
    const int K = g.K, nt = K / BK, nt1 = g.nt1;
    unsigned voffA[2], voffB[2];
#pragma unroll
    for (int i = 0; i < 2; ++i) { int R, C; stage_rc(tid * 16 + i * 8192, R, C); const int Rb = (R & ~31) + perm32(R & 31);
        voffA[i] = (unsigned)(R * g.lda + C) * 2u; voffB[i] = (unsigned)(Rb * g.ldb + C) * 2u; }
    const size_t kstep = (size_t)(BK * 2);
    const size_t hstepA = (size_t)HALF * g.lda * 2, tstepA = 2 * hstepA;
    const size_t hstepB = (size_t)HALF * g.ldb * 2, tstepB = 2 * hstepB;
    const unsigned ldsw = (unsigned)wid * 1024u;
    const int aoff = lds_byte(wr * 64 + fr, fq * 8), boff = lds_byte(wc * 32 + fr, fq * 8);
#define PG8_SA(b, h) (((b) * 2 + (h)) * HTB)
#define PG8_SB(b, h) ((4 + (b) * 2 + (h)) * HTB)
#define PG8_STAGE(bufoff, gbase, voff) do { _Pragma("unroll") for (int _i = 0; _i < 2; ++_i) \
        __builtin_amdgcn_global_load_lds((const unsigned*)((const char*)(gbase) + (voff)[_i]), (PG8_LAS unsigned*)(lds + (bufoff) + ldsw + _i * 8192), 16, 0, 0); } while (0)
#define PG8_LDA(dst, b, h) do { _Pragma("unroll") for (int m = 0; m < 4; ++m) _Pragma("unroll") for (int k = 0; k < 2; ++k) dst[m][k] = *(const PG8_LAS bf16x8*)(lds + PG8_SA(b, h) + aoff + m * 2048 + k * 1024); } while (0)
#define PG8_LDB(dst, b, h) do { _Pragma("unroll") for (int n = 0; n < 2; ++n) _Pragma("unroll") for (int k = 0; k < 2; ++k) dst[n][k] = *(const PG8_LAS bf16x8*)(lds + PG8_SB(b, h) + boff + n * 2048 + k * 1024); } while (0)
#define PG8_MMA(ai, bj, At, Bt) do { __builtin_amdgcn_s_setprio(1); _Pragma("unroll") for (int m = 0; m < 4; ++m) _Pragma("unroll") for (int n = 0; n < 2; ++n) _Pragma("unroll") for (int k = 0; k < 2; ++k) \
        acc[ai][bj][m][n] = __builtin_amdgcn_mfma_f32_16x16x32_bf16(Bt[n][k], At[m][k], acc[ai][bj][m][n], 0, 0, 0); __builtin_amdgcn_s_setprio(0); } while (0)
#define PG8_WAIT_V(n) asm volatile("s_waitcnt vmcnt(" #n ")" ::: "memory")
#define PG8_WAIT_L(n) asm volatile("s_waitcnt lgkmcnt(" #n ")" ::: "memory")
#define PG8_BAR __builtin_amdgcn_s_barrier()
#define PG8_SCHED __builtin_amdgcn_sched_barrier(0)
    Unit cur, nxt; int ui = 0;
    if (!S.next(0, cur)) return;
    PG8_LAS float* rtab = (PG8_LAS float*)(lds + 139264);
    if constexpr (Epi::HAS_ROWSCALE) {
        Unit tu;
        for (int i = 0; i < 4 && S.next(i, tu); ++i) if (tid < 256) rtab[i * 256 + tid] = E.row_scale(tu.pm * 256 + tid);
        asm volatile("s_waitcnt vmcnt(0) lgkmcnt(0)" ::: "memory"); __builtin_amdgcn_s_barrier();
    }
    f32x4 acc[2][2][4][2];
#pragma unroll
    for (int a = 0; a < 2; ++a)
#pragma unroll
        for (int b = 0; b < 2; ++b)
#pragma unroll
            for (int m = 0; m < 4; ++m)
#pragma unroll
                for (int n = 0; n < 2; ++n) acc[a][b][m][n] = (f32x4){0.f, 0.f, 0.f, 0.f};
    bf16x8 At[4][2], B0[2][2], B1[2][2];
#define PG8_TA(pm_) ((size_t)((pm_) + ((pm_) / g.a_grp) * g.a_skip) * tstepA)
#define PG8_TB(pn_) ((size_t)((pn_) + ((pn_) / g.b_grp) * g.b_skip) * tstepB)
#define PG8_BP(pn_) ((pn_) < g.nsplit ? (const char*)g.Bt + PG8_TB(pn_) : (const char*)g.Bt2 + PG8_TB((pn_) - g.nsplit))
    const char* cA1 = (const char*)g.A1 + PG8_TA(cur.pm); const char* cA2 = (const char*)g.A2 + PG8_TA(cur.pm) - (size_t)nt1 * kstep; const char* cB = PG8_BP(cur.pn);
    PG8_STAGE(PG8_SB(0, 0), cB, voffB); PG8_STAGE(PG8_SB(0, 1), cB + hstepB, voffB); PG8_STAGE(PG8_SA(0, 0), cA1, voffA); PG8_STAGE(PG8_SA(0, 1), cA1 + hstepA, voffA);
    if (wr == 1) PG8_BAR;
    PG8_WAIT_V(2); PG8_BAR;
    PG8_STAGE(PG8_SB(1, 0), cB + kstep, voffB); PG8_STAGE(PG8_SA(1, 0), cA1 + kstep, voffA); PG8_STAGE(PG8_SB(1, 1), cB + hstepB + kstep, voffB);
    PG8_WAIT_V(6); PG8_BAR;
    for (;;) {
        const bool has_next = S.next(ui + 1, nxt);
        const char* nA1 = has_next ? (const char*)g.A1 + PG8_TA(nxt.pm) : cA1; const char* nA2 = has_next ? (const char*)g.A2 + PG8_TA(nxt.pm) - (size_t)nt1 * kstep : cA2;
        const char* nB = has_next ? PG8_BP(nxt.pn) : cB;
        for (int t = 0; t < nt; t += 2) {
            const bool last = (t == nt - 2);
            const char* a1 = ((t + 1 < nt1) ? cA1 : cA2) + (size_t)(t + 1) * kstep;
            const char* a2 = last ? nA1 : ((t + 2 < nt1) ? cA1 : cA2) + (size_t)(t + 2) * kstep; const char* b2 = last ? nB : cB + (size_t)(t + 2) * kstep;
            const char* a3 = a2 + kstep; const char* b3 = b2 + kstep;
            const bool tail = TAIL && last && !has_next;
            PG8_LDB(B0, 0, 0); PG8_LDB(B1, 0, 1); PG8_SCHED; PG8_LDA(At, 0, 0); PG8_STAGE(PG8_SA(1, 1), a1 + hstepA, voffA);
            PG8_WAIT_V(8); PG8_WAIT_L(0); PG8_BAR; PG8_MMA(0, 0, At, B0); PG8_MMA(0, 1, At, B1); PG8_BAR; PG8_SCHED;
            PG8_LDA(At, 0, 1);
            if (!tail) { PG8_STAGE(PG8_SB(0, 0), b2, voffB); PG8_STAGE(PG8_SB(0, 1), b2 + hstepB, voffB); PG8_STAGE(PG8_SA(0, 0), a2, voffA); PG8_WAIT_V(8); } else { PG8_WAIT_V(2); }
            PG8_WAIT_L(0); PG8_BAR; PG8_MMA(1, 0, At, B0); PG8_MMA(1, 1, At, B1); PG8_BAR; PG8_SCHED;
            PG8_LDB(B0, 1, 0); PG8_LDB(B1, 1, 1); PG8_SCHED; PG8_LDA(At, 1, 0);
            if (!tail) { PG8_STAGE(PG8_SA(0, 1), a2 + hstepA, voffA); PG8_WAIT_V(8); } else { PG8_WAIT_V(0); }
            PG8_WAIT_L(0); PG8_BAR; PG8_MMA(0, 0, At, B0); PG8_MMA(0, 1, At, B1); PG8_BAR; PG8_SCHED;
            PG8_LDA(At, 1, 1);
            if (!tail) { PG8_STAGE(PG8_SB(1, 0), b3, voffB); PG8_STAGE(PG8_SB(1, 1), b3 + hstepB, voffB); PG8_STAGE(PG8_SA(1, 0), a3, voffA); PG8_WAIT_V(8); }
            PG8_WAIT_L(0); PG8_BAR; PG8_MMA(1, 0, At, B0); PG8_MMA(1, 1, At, B1); PG8_BAR; PG8_SCHED;
        }
        if (wr == 0) PG8_BAR;
#ifndef EPI_REP
#define EPI_REP 1
#endif
        if constexpr (Epi::MUTATES) { E.mut(acc, cur, wr, wc, fr, fq); }
        else if constexpr (Epi::HAS_ROWSCALE) { E.scaled(acc, cur, wr, wc, fr, fq, ui < 4 ? rtab + ui * 256 : (PG8_LAS float*)nullptr, !has_next); }
        else if constexpr (Epi::HAS_FUSED) { if (has_next) E(acc, cur, wr, wc, fr, fq); } else { E(acc, cur, wr, wc, fr, fq); if constexpr (Epi::IDEMPOTENT && EPI_REP > 1) { int er_ = 1; asm volatile("" : "+s"(er_)); if (er_) E(acc, cur, wr, wc, fr, fq); } }
        if (!has_next) break;
#pragma unroll
        for (int a = 0; a < 2; ++a)
#pragma unroll
            for (int b = 0; b < 2; ++b)
#pragma unroll
                for (int m = 0; m < 4; ++m)
#pragma unroll
                    for (int n = 0; n < 2; ++n) acc[a][b][m][n] = (f32x4){0.f, 0.f, 0.f, 0.f};
        cur = nxt; cA1 = nA1; cA2 = nA2; cB = nB; ++ui;
        if (wr == 1) PG8_BAR;
    }
    PG8_WAIT_V(0);
    PG8_BAR;
    if constexpr (Epi::HAS_FUSED) E.fused(acc, cur, wr, wc, fr, fq, lds);
#undef PG8_TA
#undef PG8_TB
#undef PG8_BP
#undef PG8_SA
#undef PG8_SB
#undef PG8_STAGE
#undef PG8_LDA
#undef PG8_LDB
#undef PG8_MMA
#undef PG8_WAIT_V
#undef PG8_WAIT_L
#undef PG8_BAR
#undef PG8_SCHED
}
}
typedef f32x4 AccT[2][2][4][2];

__device__ __forceinline__ u32x4 pack8(const f32x4 a, const f32x4 b) { u32x4 w; w.x = cvt_pk_bf16(a.x, a.y); w.y = cvt_pk_bf16(a.z, a.w); w.z = cvt_pk_bf16(b.x, b.y); w.w = cvt_pk_bf16(b.z, b.w); return w; }
struct EpiProj {
    static constexpr bool MUTATES = false;
    static constexpr bool HAS_ROWSCALE = true;
    static constexpr bool IDEMPOTENT = true;
    static constexpr bool HAS_FUSED = false;
    bf16_t* dst0; size_t seg_stride; const float* RS; unsigned silu_bits; float* LNS; int lns_seg; int use_rstd; int pitch; unsigned char* scr; unsigned hm_bits = 0u; bf16_t* seg0 = nullptr;
    __device__ __forceinline__ void row(int row, int colbase, float (&v)[8]) const {
        const float rs = use_rstd ? rstd_of(RS, row) : 1.0f;
        float s0 = 0.f, q0 = 0.f;
#pragma unroll
        for (int j = 0; j < 8; ++j) {
            const int col = colbase + 32 * j, seg = col >> 10, c = col & 1023;
            float x = v[j] * rs;
            s0 += x; q0 += x * x;
            if ((silu_bits >> (2 * seg + (c >> 9))) & 1u) x = silu_f(x);
            dst0[(size_t)seg * seg_stride + (((hm_bits >> seg) & 1u) ? ((size_t)(((row >> 11) * 16 + (c >> 6)) * 2048 + (row & 2047)) * 64 + (c & 63)) : ((size_t)row * pitch + c))] = f2bf(x);
        }
        if (LNS) {
            const int seg = colbase >> 10;
            if (seg == lns_seg) {
                s0 = half_sum32(s0); q0 = half_sum32(q0);
                if ((threadIdx.x & 31) == 0) { const int slot = (colbase & 1023) >> 8; LNS[(size_t)slot * M + row] = s0; LNS[(size_t)(4 + slot) * M + row] = q0; }
            }
        }
    }
    __device__ __forceinline__ float row_scale(int row) const { return use_rstd ? rstd_of(RS, row) : 1.0f; }
    __device__ __forceinline__ void operator()(const AccT& acc, const pg8::Unit& u, int wr, int wc, int fr, int fq) const { scaled(acc, u, wr, wc, fr, fq, (PG8_LAS float*)nullptr, true); }
    __device__ __forceinline__ void scaled(const AccT& acc, const pg8::Unit& u, int wr, int wc, int fr, int fq, PG8_LAS float* rtab, const bool wt) const {
        const int colt = u.pn * 256, seg = colt >> 10, cb = (colt & 1023) + wc * 32 + 8 * fq, row0 = u.pm * 256 + wr * 64 + fr;
        bf16_t* base = (seg == 0 && seg0) ? seg0 : dst0 + (size_t)seg * seg_stride;
        const bool st = (LNS != nullptr) && (seg == lns_seg);
        const bool act = (silu_bits >> (2 * seg + ((colt & 1023) >> 9))) & 1u;
        const bool hm = (hm_bits >> seg) & 1u;
        PG8_LAS float* P = (PG8_LAS float*)scr;
#pragma unroll
        for (int ai = 0; ai < 2; ++ai)
#pragma unroll
            for (int m = 0; m < 4; ++m) {
                const int row = row0 + ai * 128 + m * 16; const float rs = rtab ? rtab[ai * 128 + wr * 64 + m * 16 + fr] : row_scale(row);
                float s = 0.f, q = 0.f;
#pragma unroll
                for (int bj = 0; bj < 2; ++bj) {
                    f32x4 v0 = acc[ai][bj][m][0] * rs, v1 = acc[ai][bj][m][1] * rs;
                    if (st) { s += (v0.x + v0.y) + (v0.z + v0.w) + (v1.x + v1.y) + (v1.z + v1.w);
                              q += (v0.x * v0.x + v0.y * v0.y) + (v0.z * v0.z + v0.w * v0.w) + (v1.x * v1.x + v1.y * v1.y) + (v1.z * v1.z + v1.w * v1.w); }
                    if (act) { v0.x = fsilu(v0.x); v0.y = fsilu(v0.y); v0.z = fsilu(v0.z); v0.w = fsilu(v0.w); v1.x = fsilu(v1.x); v1.y = fsilu(v1.y); v1.z = fsilu(v1.z); v1.w = fsilu(v1.w); }
                    { const int c_ = cb + 128 * bj; const size_t off_ = hm ? ((size_t)(((row >> 11) * 16 + (c_ >> 6)) * 2048 + (row & 2047)) * 64 + (c_ & 63)) : ((size_t)row * pitch + c_);
                      if (wt) wst16(base, off_ * 2, pack8(v0, v1)); else gst<u32x4>((unsigned char*)base + off_ * 2, pack8(v0, v1)); }
                }
                if (st) { s = quad_rows_sum(s); q = quad_rows_sum(q);
                          if (fq == 0) { const int rl = ai * 128 + wr * 64 + m * 16 + fr; P[(rl * 4 + wc) * 2] = s; P[(rl * 4 + wc) * 2 + 1] = q; } }
            }
        if (st) {
            asm volatile("s_waitcnt lgkmcnt(0)" ::: "memory"); __builtin_amdgcn_s_barrier(); asm volatile("" ::: "memory");
            const int t = (wr * 4 + wc) * 64 + fr + 16 * fq;
            if (t < 256) { const float s = (P[(t * 4 + 0) * 2] + P[(t * 4 + 1) * 2]) + (P[(t * 4 + 2) * 2] + P[(t * 4 + 3) * 2]);
                           const float q = (P[(t * 4 + 0) * 2 + 1] + P[(t * 4 + 1) * 2 + 1]) + (P[(t * 4 + 2) * 2 + 1] + P[(t * 4 + 3) * 2 + 1]);
                           const int slot = (colt & 1023) >> 8; gst<float>(LNS + (size_t)slot * M + u.pm * 256 + t, s); gst<float>(LNS + (size_t)(4 + slot) * M + u.pm * 256 + t, q); }
        }
    }
};
struct EpiKV {
    static constexpr bool MUTATES = false;
    static constexpr bool HAS_ROWSCALE = false;
    static constexpr bool IDEMPOTENT = true;
    static constexpr bool HAS_FUSED = false;
    bf16_t* dst;
    __device__ __forceinline__ void row(int row, int colbase, float (&v)[8]) const {
#pragma unroll
        for (int j = 0; j < 8; ++j) { const int col = colbase + 32 * j; dst[(size_t)(col >> 11) * MM * 2048 + (size_t)row * 2048 + (col & 2047)] = f2bf(v[j]); }
    }
    __device__ __forceinline__ void operator()(const AccT& acc, const pg8::Unit& u, int wr, int wc, int fr, int fq) const {
        const int l = u.pn >> 3, cb = (u.pn & 7) * 256 + wc * 32 + 8 * fq, row0 = u.pm * 256 + wr * 64 + fr;
        bf16_t* base = dst + (size_t)l * MM * 2048;
#pragma unroll
        for (int ai = 0; ai < 2; ++ai)
#pragma unroll
            for (int m = 0; m < 4; ++m) { const int row = row0 + ai * 128 + m * 16;
#pragma unroll
                for (int bj = 0; bj < 2; ++bj) *(u32x4*)(base + (size_t)row * 2048 + cb + 128 * bj) = pack8(acc[ai][bj][m][0], acc[ai][bj][m][1]); }
    }
};
struct EpiGateA {
    static constexpr bool MUTATES = false;
    static constexpr bool HAS_ROWSCALE = false;
    static constexpr bool IDEMPOTENT = false;
    static constexpr bool HAS_FUSED = false;
    bf16_t* A0; const float* RS; int dry; bool wt = true;
    __device__ __forceinline__ void row(int row, int colbase, float (&v)[8]) const {
        const float rs = rstd_of(RS, row);
#pragma unroll
        for (int j = 0; j < 8; ++j) { bf16_t* q = A0 + (size_t)row * 1024 + colbase + 32 * j; *q = f2bf(bf2f(*q) * silu_f(v[j] * rs)); }
    }
    __device__ __forceinline__ void operator()(const AccT& acc, const pg8::Unit& u, int wr, int wc, int fr, int fq) const {
        const int cb = u.pn * 256 + wc * 32 + 8 * fq, row0 = u.pm * 256 + wr * 64 + fr;
#pragma unroll
        for (int ai = 0; ai < 2; ++ai) {
            float rsv[4]; u32x4 av[4][2];
#pragma unroll
            for (int m = 0; m < 4; ++m) { const int row = row0 + ai * 128 + m * 16; rsv[m] = rstd_of(RS, row);
#pragma unroll
                for (int bj = 0; bj < 2; ++bj) av[m][bj] = gld<u32x4>(A0 + (size_t)row * 1024 + cb + 128 * bj); }
#pragma unroll
            for (int m = 0; m < 4; ++m) {
                const int row = row0 + ai * 128 + m * 16; const float rs = rsv[m];
#pragma unroll
                for (int bj = 0; bj < 2; ++bj) {
                    f32x4 g0 = acc[ai][bj][m][0] * rs, g1 = acc[ai][bj][m][1] * rs;
                    g0.x = fsilu(g0.x); g0.y = fsilu(g0.y); g0.z = fsilu(g0.z); g0.w = fsilu(g0.w); g1.x = fsilu(g1.x); g1.y = fsilu(g1.y); g1.z = fsilu(g1.z); g1.w = fsilu(g1.w);
                    const size_t off = (size_t)row * 1024 + cb + 128 * bj;
                    const u32x4 a = av[m][bj];
                    const f32x4 o0 = (f32x4){bflo(a.x) * g0.x, bfhi(a.x) * g0.y, bflo(a.y) * g0.z, bfhi(a.y) * g0.w}, o1 = (f32x4){bflo(a.z) * g1.x, bfhi(a.z) * g1.y, bflo(a.w) * g1.z, bfhi(a.w) * g1.w};
                    if (!dry) st16(A0, off * 2, pack8(o0, o1), wt);
                }
            }
        }
    }
};
__device__ __forceinline__ float poolop(const bf16_t* U, int row, int c) {
    const int w = 2 << (c >> 8), t = row & (SEQ - 1), n = (t + 1 < w) ? (t + 1) : w;
    float s = 0.f;
    for (int i = 0; i < n; ++i) s += bf2f(U[(size_t)(row - i) * 1024 + c]);
    return s / (float)n - bf2f(U[(size_t)row * 1024 + c]);
}
struct EpiGateB {
    static constexpr bool MUTATES = false;
    static constexpr bool HAS_ROWSCALE = false;
    static constexpr bool IDEMPOTENT = false;
    static constexpr bool HAS_FUSED = true;
    bf16_t* A1; const bf16_t* U; const float* RS; int dry;
    __device__ __forceinline__ void row(int row, int colbase, float (&v)[8]) const {
        const float rs = rstd_of(RS, row);
#pragma unroll
        for (int j = 0; j < 8; ++j) { const int c = colbase + 32 * j; A1[(size_t)row * 1024 + c] = f2bf(poolop(U, row, c) * silu_f(v[j] * rs)); }
    }
    __device__ __forceinline__ void operator()(const AccT& acc, const pg8::Unit& u, int wr, int wc, int fr, int fq) const {
        const int cb = u.pn * 256 + wc * 32 + 8 * fq, row0 = u.pm * 256 + wr * 64 + fr, w = 2 << u.pn;
#pragma unroll
        for (int ai = 0; ai < 2; ++ai)
#pragma unroll
            for (int m = 0; m < 4; ++m) {
                const int row = row0 + ai * 128 + m * 16; const float rs = rstd_of(RS, row);
#pragma unroll
                for (int bj = 0; bj < 2; ++bj) {
                    f32x4 g0 = acc[ai][bj][m][0] * rs, g1 = acc[ai][bj][m][1] * rs;
                    g0.x = fsilu(g0.x); g0.y = fsilu(g0.y); g0.z = fsilu(g0.z); g0.w = fsilu(g0.w); g1.x = fsilu(g1.x); g1.y = fsilu(g1.y); g1.z = fsilu(g1.z); g1.w = fsilu(g1.w);
                    const size_t off = (size_t)row * 1024 + cb + 128 * bj;
                    const int t = row & (SEQ - 1), n = (t + 1 < w) ? (t + 1) : w;
                    const u32x4 c = gld<u32x4>(U + off);
                    f32x4 s0 = (f32x4){bflo(c.x), bfhi(c.x), bflo(c.y), bfhi(c.y)}, s1 = (f32x4){bflo(c.z), bfhi(c.z), bflo(c.w), bfhi(c.w)};
                    const f32x4 c0 = s0, c1 = s1;
                    for (int i = 1; i < w; ++i) if (i <= t) { const u32x4 a = gld<u32x4>(U + off - (size_t)i * 1024);
                        s0 += (f32x4){bflo(a.x), bfhi(a.x), bflo(a.y), bfhi(a.y)}; s1 += (f32x4){bflo(a.z), bfhi(a.z), bflo(a.w), bfhi(a.w)}; }
                    const float inv = 1.0f / (float)n;
                    if (!dry) wst16(A1, off * 2, pack8((s0 * inv - c0) * g0, (s1 * inv - c1) * g1));
                }
            }
    }
    __device__ __forceinline__ void fused(const AccT& acc, const pg8::Unit& u, int wr, int wc, int fr, int fq, PG8_LAS unsigned char* lds) const {
        const int R0 = u.pm * 256, C0 = u.pn * 256, w = 2 << u.pn, tid = (wr * 4 + wc) * 64 + fr + 16 * fq;
        const int tb = R0 & (SEQ - 1);
        float rsv[2][4];
#pragma unroll
        for (int ai = 0; ai < 2; ++ai)
#pragma unroll
            for (int m = 0; m < 4; ++m) rsv[ai][m] = rstd_of(RS, R0 + ai * 128 + wr * 64 + m * 16 + fr);
        for (int id = tid; id < 271 * 32; id += NT) { const int rl = id >> 5, ch = id & 31;
            if (rl >= 15 || tb != 0) *(PG8_LAS u32x4*)(lds + rl * 528 + ch * 16) = gld<u32x4>(U + (size_t)(R0 - 15 + rl) * 1024 + C0 + ch * 8); }
        asm volatile("s_waitcnt vmcnt(0) lgkmcnt(0)" ::: "memory"); __builtin_amdgcn_s_barrier(); asm volatile("" ::: "memory");
#pragma unroll
        for (int ai = 0; ai < 2; ++ai)
#pragma unroll
            for (int m = 0; m < 4; ++m) {
                const int rloc = ai * 128 + wr * 64 + m * 16 + fr, row = R0 + rloc; const float rs = rsv[ai][m];
                const int t = row & (SEQ - 1), n = (t + 1 < w) ? (t + 1) : w;
                const float inv = 1.0f / (float)n;
#pragma unroll
                for (int bj = 0; bj < 2; ++bj) {
                    f32x4 g0 = acc[ai][bj][m][0] * rs, g1 = acc[ai][bj][m][1] * rs;
                    g0.x = fsilu(g0.x); g0.y = fsilu(g0.y); g0.z = fsilu(g0.z); g0.w = fsilu(g0.w); g1.x = fsilu(g1.x); g1.y = fsilu(g1.y); g1.z = fsilu(g1.z); g1.w = fsilu(g1.w);
                    const PG8_LAS unsigned char* lp = lds + (15 + rloc) * 528 + (128 * bj + wc * 32 + 8 * fq) * 2;
                    const u32x4 c = *(const PG8_LAS u32x4*)lp;
                    f32x4 s0 = (f32x4){bflo(c.x), bfhi(c.x), bflo(c.y), bfhi(c.y)}, s1 = (f32x4){bflo(c.z), bfhi(c.z), bflo(c.w), bfhi(c.w)};
                    const f32x4 c0 = s0, c1 = s1;
                    for (int i = 1; i < n; ++i) { const u32x4 a = *(const PG8_LAS u32x4*)(lp - i * 528);
                        s0 += (f32x4){bflo(a.x), bfhi(a.x), bflo(a.y), bfhi(a.y)}; s1 += (f32x4){bflo(a.z), bfhi(a.z), bflo(a.w), bfhi(a.w)}; }
                    if (!dry) wst16(A1, ((size_t)row * 1024 + C0 + 128 * bj + wc * 32 + 8 * fq) * 2, pack8((s0 * inv - c0) * g0, (s1 * inv - c1) * g1));
                }
            }
    }
};
struct EpiGates {
    static constexpr bool MUTATES = false;
    static constexpr bool HAS_ROWSCALE = false;
    static constexpr bool IDEMPOTENT = false;
    static constexpr bool HAS_FUSED = true;
    EpiGateA ga; EpiGateB gb;
    __device__ __forceinline__ void row(int row, int colbase, float (&v)[8]) const { if (colbase < 1024) ga.row(row, colbase, v); else gb.row(row, colbase - 1024, v); }
    __device__ __forceinline__ void operator()(const AccT& acc, const pg8::Unit& u, int wr, int wc, int fr, int fq) const {
        if (u.pn < 4) { EpiGateA g2 = ga; g2.wt = false; g2(acc, u, wr, wc, fr, fq); }
        else { pg8::Unit v; v.pm = u.pm; v.pn = u.pn - 4; gb(acc, v, wr, wc, fr, fq); }
    }
    __device__ __forceinline__ void fused(const AccT& acc, const pg8::Unit& u, int wr, int wc, int fr, int fq, PG8_LAS unsigned char* lds) const {
        if (u.pn < 4) ga(acc, u, wr, wc, fr, fq);
        else { pg8::Unit v; v.pm = u.pm; v.pn = u.pn - 4; gb.fused(acc, v, wr, wc, fr, fq, lds); }
    }
};
struct EpiResid {
    static constexpr bool MUTATES = false;
    static constexpr bool HAS_ROWSCALE = false;
    static constexpr bool IDEMPOTENT = false;
    static constexpr bool HAS_FUSED = false;
    bf16_t* XB; float* RSn; unsigned char* scr; int dry; bool wt = true;
    __device__ __forceinline__ void row(int row, int colbase, float (&v)[8]) const {
        float q0 = 0.f;
#pragma unroll
        for (int j = 0; j < 8; ++j) { const int col = colbase + 32 * j; bf16_t* xp = XB + (size_t)row * 1024 + col; const float x = bf2f(*xp) + v[j]; *xp = f2bf(x); q0 += x * x; }
        q0 = half_sum32(q0);
        if ((threadIdx.x & 31) == 0) RSn[(size_t)(colbase >> 8) * M + row] = q0;
    }
    __device__ __forceinline__ void operator()(const AccT& acc, const pg8::Unit& u, int wr, int wc, int fr, int fq) const {
        const int cb = u.pn * 256 + wc * 32 + 8 * fq, row0 = u.pm * 256 + wr * 64 + fr;
        PG8_LAS float* P = (PG8_LAS float*)scr;
        u32x4 ov[2][4][2];
#pragma unroll
        for (int ai = 0; ai < 2; ++ai)
#pragma unroll
            for (int m = 0; m < 4; ++m)
#pragma unroll
                for (int bj = 0; bj < 2; ++bj) ov[ai][m][bj] = gld<u32x4>(XB + (size_t)(row0 + ai * 128 + m * 16) * 1024 + cb + 128 * bj);
#pragma unroll
        for (int ai = 0; ai < 2; ++ai)
#pragma unroll
            for (int m = 0; m < 4; ++m) {
                const int row = row0 + ai * 128 + m * 16; float q = 0.f;
#pragma unroll
                for (int bj = 0; bj < 2; ++bj) {
                    const u32x4 o = ov[ai][m][bj];
                    const f32x4 x0 = (f32x4){bflo(o.x), bfhi(o.x), bflo(o.y), bfhi(o.y)} + acc[ai][bj][m][0], x1 = (f32x4){bflo(o.z), bfhi(o.z), bflo(o.w), bfhi(o.w)} + acc[ai][bj][m][1];
                    if (!dry) st16(XB, ((size_t)row * 1024 + cb + 128 * bj) * 2, pack8(x0, x1), wt);
                    q += (x0.x * x0.x + x0.y * x0.y) + (x0.z * x0.z + x0.w * x0.w) + (x1.x * x1.x + x1.y * x1.y) + (x1.z * x1.z + x1.w * x1.w);
                }
                q = quad_rows_sum(q);
                if (fq == 0) P[(ai * 128 + wr * 64 + m * 16 + fr) * 4 + wc] = q;
            }
        asm volatile("s_waitcnt lgkmcnt(0)" ::: "memory"); __builtin_amdgcn_s_barrier(); asm volatile("" ::: "memory");
        const int t = (wr * 4 + wc) * 64 + fr + 16 * fq;
        if (t < 256 && !dry) gst<float>(RSn + (size_t)u.pn * M + u.pm * 256 + t, (P[t * 4 + 0] + P[t * 4 + 1]) + (P[t * 4 + 2] + P[t * 4 + 3]));
    }
};
struct EpiGlu {
    static constexpr bool MUTATES = false;
    static constexpr bool HAS_ROWSCALE = false;
    static constexpr bool IDEMPOTENT = false;
    static constexpr bool HAS_FUSED = false;
    bf16_t* D; int dry;
    __device__ __forceinline__ void row(int row, int colbase, float (&v)[8]) const {
#pragma unroll
        for (int j = 0; j < 4; ++j) { const int c = (colbase >> 8) * 128 + (colbase & 255) + 32 * j; bf16_t* d = D + (size_t)row * 1024 + c;
            *d = f2bf(v[j] * sigmoid_f(v[j + 4]) * bf2f(*d)); }
    }
    __device__ __forceinline__ void operator()(const AccT& acc, const pg8::Unit& u, int wr, int wc, int fr, int fq) const {
        const int cb = u.pn * 128 + wc * 32 + 8 * fq, row0 = u.pm * 256 + wr * 64 + fr;
        u32x4 gv[2][4];
#pragma unroll
        for (int ai = 0; ai < 2; ++ai)
#pragma unroll
            for (int m = 0; m < 4; ++m) gv[ai][m] = gld<u32x4>(D + (size_t)(row0 + ai * 128 + m * 16) * 1024 + cb);
#pragma unroll
        for (int ai = 0; ai < 2; ++ai)
#pragma unroll
            for (int m = 0; m < 4; ++m) {
                const int row = row0 + ai * 128 + m * 16;
                const u32x4 g = gv[ai][m]; const f32x4 a0 = acc[ai][0][m][0], a1 = acc[ai][0][m][1], b0 = acc[ai][1][m][0], b1 = acc[ai][1][m][1];
                const f32x4 o0 = (f32x4){a0.x * fsigmoid(b0.x) * bflo(g.x), a0.y * fsigmoid(b0.y) * bfhi(g.x), a0.z * fsigmoid(b0.z) * bflo(g.y), a0.w * fsigmoid(b0.w) * bfhi(g.y)};
                const f32x4 o1 = (f32x4){a1.x * fsigmoid(b1.x) * bflo(g.z), a1.y * fsigmoid(b1.y) * bfhi(g.z), a1.z * fsigmoid(b1.z) * bflo(g.w), a1.w * fsigmoid(b1.w) * bfhi(g.w)};
                if (!dry) wst16(D, ((size_t)row * 1024 + cb) * 2, pack8(o0, o1));
            }
    }
};
struct EpiFold {
    static constexpr bool MUTATES = false;
    static constexpr bool HAS_ROWSCALE = false;
    static constexpr bool IDEMPOTENT = true;
    static constexpr bool HAS_FUSED = false;
    bf16_t* dst; const float* scale;
    __device__ __forceinline__ void row(int row, int colbase, float (&v)[8]) const {
#pragma unroll
        for (int j = 0; j < 8; ++j) dst[(size_t)row * WIN_LD + colbase + 32 * j] = f2bf(v[j] * scale[row]);
    }
    __device__ __forceinline__ void operator()(const AccT& acc, const pg8::Unit& u, int wr, int wc, int fr, int fq) const {
        const int cb = u.pn * 256 + wc * 32 + 8 * fq, row0 = u.pm * 256 + wr * 64 + fr;
#pragma unroll
        for (int ai = 0; ai < 2; ++ai)
#pragma unroll
            for (int m = 0; m < 4; ++m) { const int row = row0 + ai * 128 + m * 16; const float sc = gld<float>(scale + row);
#pragma unroll
                for (int bj = 0; bj < 2; ++bj) gst<u32x4>(dst + (size_t)row * WIN_LD + cb + 128 * bj, pack8(acc[ai][bj][m][0] * sc, acc[ai][bj][m][1] * sc)); }
    }
};
struct EpiSoftmaxP {
    static constexpr bool MUTATES = true;
    static constexpr bool HAS_ROWSCALE = false;
    static constexpr bool IDEMPOTENT = false;
    static constexpr bool HAS_FUSED = false;
    bf16_t* Pdst; const float* RSu; unsigned char* scr;
    __device__ __forceinline__ void row(int row, int colbase, float (&v)[8]) const { (void)row; (void)colbase; (void)v; }
    __device__ __forceinline__ void operator()(const AccT& acc, const pg8::Unit& u, int wr, int wc, int fr, int fq) const { (void)acc; (void)u; (void)wr; (void)wc; (void)fr; (void)fq; }
    __device__ __forceinline__ void mut(AccT& acc, const pg8::Unit& u, int wr, int wc, int fr, int fq) const {
        PG8_LAS float* P1 = (PG8_LAS float*)scr; PG8_LAS float* P2 = P1 + 1024; PG8_LAS float* R = P2 + 1024;
        { const int t = (wr * 4 + wc) * 64 + fr + 16 * fq;
          if (t < 256) R[t] = rsqrtf(((gld<float>(RSu + t) + gld<float>(RSu + (size_t)M + t)) + (gld<float>(RSu + (size_t)2 * M + t) + gld<float>(RSu + (size_t)3 * M + t))) * (1.0f / 1024.f) + EPS); }
#pragma unroll
        for (int ai = 0; ai < 2; ++ai)
#pragma unroll
            for (int m = 0; m < 4; ++m) { float mx = -3.0e38f;
#pragma unroll
                for (int bj = 0; bj < 2; ++bj)
#pragma unroll
                    for (int n = 0; n < 2; ++n) { const f32x4 x = acc[ai][bj][m][n]; mx = fmaxf(mx, fmaxf(fmaxf(x.x, x.y), fmaxf(x.z, x.w))); }
                mx = quad_rows_max(mx);
                if (fq == 0) P1[(ai * 128 + wr * 64 + m * 16 + fr) * 4 + wc] = mx; }
        asm volatile("s_waitcnt lgkmcnt(0)" ::: "memory"); __builtin_amdgcn_s_barrier(); asm volatile("" ::: "memory");
#pragma unroll
        for (int ai = 0; ai < 2; ++ai)
#pragma unroll
            for (int m = 0; m < 4; ++m) { const int rl = ai * 128 + wr * 64 + m * 16 + fr; const float rs = R[rl];
                const float mx = fmaxf(fmaxf(P1[rl * 4 + 0], P1[rl * 4 + 1]), fmaxf(P1[rl * 4 + 2], P1[rl * 4 + 3])); float sm = 0.f;
#pragma unroll
                for (int bj = 0; bj < 2; ++bj)
#pragma unroll
                    for (int n = 0; n < 2; ++n) { f32x4 x = acc[ai][bj][m][n];
                        x.x = __builtin_amdgcn_exp2f((x.x - mx) * rs); x.y = __builtin_amdgcn_exp2f((x.y - mx) * rs); x.z = __builtin_amdgcn_exp2f((x.z - mx) * rs); x.w = __builtin_amdgcn_exp2f((x.w - mx) * rs);
                        sm += (x.x + x.y) + (x.z + x.w); acc[ai][bj][m][n] = x; }
                sm = quad_rows_sum(sm);
                if (fq == 0) P2[rl * 4 + wc] = sm; }
        asm volatile("s_waitcnt lgkmcnt(0)" ::: "memory"); __builtin_amdgcn_s_barrier(); asm volatile("" ::: "memory");
        const int cb = u.pn * 256 + wc * 32 + 8 * fq;
#pragma unroll
        for (int ai = 0; ai < 2; ++ai)
#pragma unroll
            for (int m = 0; m < 4; ++m) { const int rl = ai * 128 + wr * 64 + m * 16 + fr;
                const float inv = 1.0f / ((P2[rl * 4 + 0] + P2[rl * 4 + 1]) + (P2[rl * 4 + 2] + P2[rl * 4 + 3]));
#pragma unroll
                for (int bj = 0; bj < 2; ++bj) wst16(Pdst, ((size_t)(u.pm * 256 + rl) * 1024 + cb + 128 * bj) * 2, pack8(acc[ai][bj][m][0] * inv, acc[ai][bj][m][1] * inv)); }
    }
};
struct EpiTile {
    static constexpr bool MUTATES = false;
    static constexpr bool HAS_ROWSCALE = false;
    static constexpr bool IDEMPOTENT = true;
    static constexpr bool HAS_FUSED = false;
    bf16_t* dst;
    __device__ __forceinline__ void row(int row, int colbase, float (&v)[8]) const {
#pragma unroll
        for (int j = 0; j < 8; ++j) dst[(size_t)row * 1024 + colbase + 32 * j] = f2bf(v[j]);
    }
    __device__ __forceinline__ void operator()(const AccT& acc, const pg8::Unit& u, int wr, int wc, int fr, int fq) const {
        const int cb = u.pn * 256 + wc * 32 + 8 * fq, row0 = u.pm * 256 + wr * 64 + fr;
#pragma unroll
        for (int ai = 0; ai < 2; ++ai)
#pragma unroll
            for (int m = 0; m < 4; ++m) { const int row = row0 + ai * 128 + m * 16;
#pragma unroll
                for (int bj = 0; bj < 2; ++bj) wst16(dst, ((size_t)row * 1024 + cb + 128 * bj) * 2, pack8(acc[ai][bj][m][0], acc[ai][bj][m][1])); }
    }
};
template <int FAST, class Epi, bool TAIL = true>
__device__ __forceinline__ void run_gemm(unsigned char* lds, const bf16_t* A1, const bf16_t* A2, int K1, const bf16_t* Bt, int Mrows, int N, int K, const Epi& E, int a_grp = 1 << 20, int a_skip = 0, int b_grp = 1 << 20, int b_skip = 0, int vG = 0, int vc = 0, int lda = 1024, int ldb = 0, const bf16_t* Bt2 = nullptr, int nsplit = 1 << 20) {
    if constexpr (FAST) { pg8::Gemm g{A1, A2, K1 / 64, lda, Bt, Mrows, N, K, a_grp, a_skip, b_grp, b_skip, vG, vc, ldb ? ldb : K, Bt2, nsplit}; pg8::gemm_phase<Epi, TAIL>((PG8_LAS unsigned char*)lds, g, E); }
    else ngemm(lds, A1, A2, K1, lda, Bt, Mrows, N, K, E);
}
__device__ __forceinline__ void zero_f32(float* p, int n) { for (int i = blockIdx.x * NT + tid_l(); i < n; i += gridDim.x * NT) p[i] = 0.f; }

__device__ __forceinline__ void init_rows(const Params& p) {
    unsigned char* wsl = p.ws; asm volatile("" : "+s"(wsl));
    const int tidl = tid_l(), lane = tidl & 63, gw = blockIdx.x * (NT / 64) + (tidl >> 6), ngw = gridDim.x * (NT / 64);
    float* RS = (float*)(wsl + WS_RS); bf16_t* XB = (bf16_t*)(wsl + WS_XB); bf16_t* MB = (bf16_t*)(wsl + WS_MEMNB);
    for (int row = gw; row < M; row += ngw) {
        const f32x4* xr = (const f32x4*)(p.in[0] + (size_t)row * DM) + lane; u32x2* xb = (u32x2*)(XB + (size_t)row * DM) + lane;
        float s = 0.f;
#pragma unroll
        for (int j = 0; j < 4; ++j) { const f32x4 v = gld<f32x4>(xr + 64 * j); s += v.x * v.x + v.y * v.y + v.z * v.z + v.w * v.w;
            u32x2 w; w.x = cvt_pk_bf16(v.x, v.y); w.y = cvt_pk_bf16(v.z, v.w); gst<u32x2>(XB + (size_t)row * DM + 4 * (lane + 64 * j), w); }
        s = wave_sum(s);
        if (lane < 4) RS[(size_t)lane * M + row] = (lane == 0) ? s : 0.f;
    }
    for (int row = gw; row < MM; row += ngw) {
        const f32x4* xr = (const f32x4*)(p.in[1] + (size_t)row * DM) + lane; const f32x4* gr = (const f32x4*)(p.in[28]) + lane; u32x2* xb = (u32x2*)(MB + (size_t)row * DM) + lane;
        f32x4 v[4]; float s = 0.f;
#pragma unroll
        for (int j = 0; j < 4; ++j) { v[j] = xr[64 * j]; s += v[j].x * v[j].x + v[j].y * v[j].y + v[j].z * v[j].z + v[j].w * v[j].w; }
        s = wave_sum(s); const float r = rsqrtf(s * (1.0f / DM) + EPS);
#pragma unroll
        for (int j = 0; j < 4; ++j) { const f32x4 g = gr[64 * j]; u32x2 w; w.x = (unsigned)f2bf(v[j].x * r * g.x) | ((unsigned)f2bf(v[j].y * r * g.y) << 16);
            w.y = (unsigned)f2bf(v[j].z * r * g.z) | ((unsigned)f2bf(v[j].w * r * g.w) << 16); xb[64 * j] = w; }
    }
}
__device__ __forceinline__ void cvt_wvb(const Params& p) {
    unsigned char* wsl = p.ws; asm volatile("" : "+s"(wsl));
    bf16_t* WVB = (bf16_t*)(wsl + WS_WVB);
    for (int e8 = blockIdx.x * NT + tid_l(); e8 < 2 * 4 * 1024 * 32; e8 += gridDim.x * NT) {
        const int c8 = e8 & 31, k = (e8 >> 5) & 1023, g = (e8 >> 15) & 3, i = e8 >> 17;
        const float* src = p.in[3] + (size_t)i * 1024 * 6144 + (size_t)k * 6144 + 4096 + g * 256 + 8 * c8; const float gn = p.in[2][i * 1024 + k];
        const f32x4 a = gld<f32x4>(src) * gn, c = gld<f32x4>(src + 4) * gn;
        wst16(WVB, (size_t)e8 * 16, pack8(a, c));
    }
}

__device__ __forceinline__ void cvt_wxqn(const Params& p) {
    unsigned char* wsl = p.ws; asm volatile("" : "+s"(wsl));
    bf16_t* W = (bf16_t*)(wsl + WS_WXQ);
    for (int e8 = blockIdx.x * NT + tid_l(); e8 < 4 * 1024 * 128; e8 += gridDim.x * NT) {
        const int i = (e8 >> 7) & 1023, l = e8 >> 17;
        const float* src = p.in[25] + (size_t)e8 * 8; const float gn = p.in[24][l * 1024 + i] * (0.0625f * 1.4426950408889634f);
        const f32x4 a = gld<f32x4>(src) * gn, c = gld<f32x4>(src + 4) * gn;
        wst16(W, (size_t)e8 * 16, pack8(a, c));
    }
}

__device__ __forceinline__ int dil_pos(int t, int s) { return (s < 129) ? (t - s) : (s < 258) ? (t - 4 * (s - 129)) : (t - 16 * (s - 258)); }
__device__ __forceinline__ void dil_attn_naive(const Params& p) {
    unsigned char* wsl = p.ws; asm volatile("" : "+s"(wsl));
    bf16_t* Q = (bf16_t*)(wsl + WS_B0); const bf16_t* Kb = (const bf16_t*)(wsl + WS_B1); const bf16_t* Vb = (const bf16_t*)(wsl + WS_B2);
    const int tidl = tid_l(), lane = tidl & 63, gw = blockIdx.x * (NT / 64) + (tidl >> 6), ngw = gridDim.x * (NT / 64);
    for (int item = gw; item < M * 16; item += ngw) {
        const int row = item >> 4, h = item & 15, t = row & (SEQ - 1), rowb = row - t;
        float q[64];
        { const u32x4* qp = (const u32x4*)(Q + (size_t)row * 1024 + h * 64);
#pragma unroll
          for (int i = 0; i < 8; ++i) { const u32x4 w = qp[i];
              q[8 * i + 0] = __uint_as_float(w.x << 16); q[8 * i + 1] = __uint_as_float(w.x & 0xffff0000u); q[8 * i + 2] = __uint_as_float(w.y << 16); q[8 * i + 3] = __uint_as_float(w.y & 0xffff0000u);
              q[8 * i + 4] = __uint_as_float(w.z << 16); q[8 * i + 5] = __uint_as_float(w.z & 0xffff0000u); q[8 * i + 6] = __uint_as_float(w.w << 16); q[8 * i + 7] = __uint_as_float(w.w & 0xffff0000u); } }
        float sc[7]; float mx = -3.0e38f;
#pragma unroll
        for (int i = 0; i < 7; ++i) {
            const int s = lane + 64 * i, pos = dil_pos(t, s); const bool valid = (s < 386) && (pos >= 0);
            float d = -3.0e38f;
            if (valid) { const u32x4* kp = (const u32x4*)(Kb + (size_t)(rowb + pos) * 1024 + h * 64); d = 0.f;
#pragma unroll
                for (int c = 0; c < 8; ++c) { const u32x4 w = kp[c];
                    d += q[8 * c + 0] * __uint_as_float(w.x << 16) + q[8 * c + 1] * __uint_as_float(w.x & 0xffff0000u) + q[8 * c + 2] * __uint_as_float(w.y << 16) + q[8 * c + 3] * __uint_as_float(w.y & 0xffff0000u)
                       + q[8 * c + 4] * __uint_as_float(w.z << 16) + q[8 * c + 5] * __uint_as_float(w.z & 0xffff0000u) + q[8 * c + 6] * __uint_as_float(w.w << 16) + q[8 * c + 7] * __uint_as_float(w.w & 0xffff0000u); } }
            sc[i] = d; mx = fmaxf(mx, d);
        }
        mx = wave_max(mx);
        float l = 0.f;
#pragma unroll
        for (int i = 0; i < 7; ++i) { const int s = lane + 64 * i, pos = dil_pos(t, s); const bool valid = (s < 386) && (pos >= 0); sc[i] = valid ? expf(sc[i] - mx) : 0.f; l += sc[i]; }
        l = wave_sum(l);
        float o = 0.f;
#pragma unroll
        for (int i = 0; i < 7; ++i) {
            for (int j = 0; j < 64; ++j) { const int s = 64 * i + j; if (s >= 386) break; const int pos = dil_pos(t, s); const float pj = __shfl(sc[i], j);
                if (pos >= 0) o += pj * bf2f(Vb[(size_t)(rowb + pos) * 1024 + h * 64 + lane]); }
        }
        Q[(size_t)row * 1024 + h * 64 + lane] = f2bf(o / l);
    }
}

typedef float f32x16 __attribute__((ext_vector_type(16)));
typedef short s16x8 __attribute__((ext_vector_type(8)));
typedef short s16x4 __attribute__((ext_vector_type(4)));
__device__ __forceinline__ void dil_tile(f32x16 (&oacc)[2], float& m, float& l, const s16x8 (&qf)[4], const u32x4 (&kk)[4], const u32x4 (&vv)[4], unsigned char* Vw, unsigned tr_base,
                                         int lane, int q, int h, int qpos, int kpb, bool need_mask) {
#pragma unroll
    for (int i2 = 0; i2 < 4; ++i2) *(u32x4*)(Vw + ((lane >> 3) + 8 * i2) * 144 + (lane & 7) * 16) = kk[i2];
    s16x8 kf[4];
#pragma unroll
    for (int ks = 0; ks < 4; ++ks) kf[ks] = *(const s16x8*)(Vw + q * 144 + (16 * ks + 8 * h) * 2);
    asm volatile("s_waitcnt lgkmcnt(0)" ::: "memory");
#pragma unroll
    for (int i2 = 0; i2 < 4; ++i2) *(u32x4*)(Vw + ((lane >> 3) + 8 * i2) * 192 + (lane & 7) * 16) = vv[i2];
    f32x16 sacc;
#pragma unroll
    for (int e = 0; e < 16; ++e) sacc[e] = 0.f;
#pragma unroll
    for (int ks = 0; ks < 4; ++ks) sacc = __builtin_amdgcn_mfma_f32_32x32x16_bf16(kf[ks], qf[ks], sacc, 0, 0, 0);
    if (need_mask) {
        const int hi = qpos - kpb - 4 * h, l1 = hi - 128, l2 = -(kpb + 4 * h), lo = l1 > l2 ? l1 : l2;
        const unsigned mhi = hi < 0 ? 0u : (hi >= 31 ? 0xffffffffu : ((2u << hi) - 1u));
        const unsigned mlo = lo <= 0 ? 0xffffffffu : (lo >= 32 ? 0u : (0xffffffffu << lo));
        const unsigned mk = mhi & mlo;
#pragma unroll
        for (int e = 0; e < 16; ++e) { const int c = (e & 3) + 8 * (e >> 2); const unsigned mm = (unsigned)(((int)(mk << (31 - c))) >> 31);
            sacc[e] = __uint_as_float((__float_as_uint(sacc[e]) & mm) | (0xff800000u & ~mm)); }
    }
    typedef float f32x2_ __attribute__((ext_vector_type(2)));
    f32x2_ t2[8];
    { const f32x2_ nm = (f32x2_){-m, -m};
#pragma unroll
      for (int e = 0; e < 8; ++e) t2[e] = (f32x2_){sacc[2 * e], sacc[2 * e + 1]} + nm; }
    float mt;
    { const float r0 = fmaxf(fmaxf(t2[0].x, t2[0].y), t2[1].x), r1 = fmaxf(fmaxf(t2[1].y, t2[2].x), t2[2].y), r2 = fmaxf(fmaxf(t2[3].x, t2[3].y), t2[4].x),
                  r3 = fmaxf(fmaxf(t2[4].y, t2[5].x), t2[5].y), r4 = fmaxf(fmaxf(t2[6].x, t2[6].y), t2[7].x);
      mt = fmaxf(fmaxf(fmaxf(r0, r1), r2), fmaxf(fmaxf(r3, r4), t2[7].y)); }
    { const auto rr = __builtin_amdgcn_permlane32_swap(__float_as_uint(mt), __float_as_uint(mt), false, false); mt = __builtin_amdgcn_fmed3f(__uint_as_float(rr[0]), __uint_as_float(rr[1]), INFINITY); }
    if (!__all(mt <= 8.0f)) {
        float ms;
        { float m4[4];
#pragma unroll
          for (int e = 0; e < 4; ++e) m4[e] = fmaxf(fmaxf(sacc[4 * e], sacc[4 * e + 1]), fmaxf(sacc[4 * e + 2], sacc[4 * e + 3]));
          ms = fmaxf(fmaxf(m4[0], m4[1]), fmaxf(m4[2], m4[3])); }
        { const auto rr = __builtin_amdgcn_permlane32_swap(__float_as_uint(ms), __float_as_uint(ms), false, false); ms = fmaxf(__uint_as_float(rr[0]), __uint_as_float(rr[1])); }
        const float mnew = fmaxf(m, ms), alpha = __builtin_amdgcn_exp2f(m - mnew); m = mnew; l *= alpha;
#pragma unroll
        for (int dt = 0; dt < 2; ++dt)
#pragma unroll
            for (int e = 0; e < 16; ++e) oacc[dt][e] *= alpha;
        const f32x2_ nm = (f32x2_){-m, -m};
#pragma unroll
        for (int e = 0; e < 8; ++e) t2[e] = (f32x2_){sacc[2 * e], sacc[2 * e + 1]} + nm;
    }
#pragma unroll
    for (int e = 0; e < 8; ++e) { sacc[2 * e] = __builtin_amdgcn_exp2f(t2[e].x); sacc[2 * e + 1] = __builtin_amdgcn_exp2f(t2[e].y); }
    float ps;
    { float s4[4];
#pragma unroll
      for (int e = 0; e < 4; ++e) s4[e] = (sacc[4 * e] + sacc[4 * e + 1]) + (sacc[4 * e + 2] + sacc[4 * e + 3]);
      ps = (s4[0] + s4[1]) + (s4[2] + s4[3]); }
    { const auto rr = __builtin_amdgcn_permlane32_swap(__float_as_uint(ps), __float_as_uint(ps), false, false); ps = __uint_as_float(rr[0]) + __uint_as_float(rr[1]); }
    l += ps;
    s16x8 pf[2];
#pragma unroll
    for (int s2 = 0; s2 < 2; ++s2) { u32x4 w; w.x = cvt_pk_bf16(sacc[8 * s2 + 0], sacc[8 * s2 + 1]); w.y = cvt_pk_bf16(sacc[8 * s2 + 2], sacc[8 * s2 + 3]);
        w.z = cvt_pk_bf16(sacc[8 * s2 + 4], sacc[8 * s2 + 5]); w.w = cvt_pk_bf16(sacc[8 * s2 + 6], sacc[8 * s2 + 7]); pf[s2] = __builtin_bit_cast(s16x8, w); }
    s16x4 t00, t01, t02, t03, t10, t11, t12, t13;
    asm volatile("ds_read_b64_tr_b16 %0, %8 offset:0\n\tds_read_b64_tr_b16 %1, %8 offset:1536\n\tds_read_b64_tr_b16 %2, %8 offset:3072\n\tds_read_b64_tr_b16 %3, %8 offset:4608\n\t"
                 "ds_read_b64_tr_b16 %4, %8 offset:64\n\tds_read_b64_tr_b16 %5, %8 offset:1600\n\tds_read_b64_tr_b16 %6, %8 offset:3136\n\tds_read_b64_tr_b16 %7, %8 offset:4672\n\ts_waitcnt lgkmcnt(0)"
                 : "=&v"(t00), "=&v"(t01), "=&v"(t02), "=&v"(t03), "=&v"(t10), "=&v"(t11), "=&v"(t12), "=&v"(t13) : "v"(tr_base) : "memory");
    oacc[0] = __builtin_amdgcn_mfma_f32_32x32x16_bf16(__builtin_shufflevector(t00, t01, 0, 1, 2, 3, 4, 5, 6, 7), pf[0], oacc[0], 0, 0, 0);
    oacc[1] = __builtin_amdgcn_mfma_f32_32x32x16_bf16(__builtin_shufflevector(t10, t11, 0, 1, 2, 3, 4, 5, 6, 7), pf[0], oacc[1], 0, 0, 0);
    oacc[0] = __builtin_amdgcn_mfma_f32_32x32x16_bf16(__builtin_shufflevector(t02, t03, 0, 1, 2, 3, 4, 5, 6, 7), pf[1], oacc[0], 0, 0, 0);
    oacc[1] = __builtin_amdgcn_mfma_f32_32x32x16_bf16(__builtin_shufflevector(t12, t13, 0, 1, 2, 3, 4, 5, 6, 7), pf[1], oacc[1], 0, 0, 0);
}
__device__ __forceinline__ void dil_attn_mfma(unsigned char* lds, const Params& p, const int dry) {
    unsigned char* wsl = p.ws; asm volatile("" : "+s"(wsl));
    const bf16_t* Qb = (const bf16_t*)p.out; const bf16_t* Kb = (const bf16_t*)(wsl + WS_B1); const bf16_t* Vb = (const bf16_t*)(wsl + WS_B2);
    bf16_t* Ob = (bf16_t*)(wsl + WS_B0);
    const int tid = tid_l(), lane = tid & 63, wid = tid >> 6, q = lane & 31, h = lane >> 5;
    unsigned char* OST = lds;
    float* MST = (float*)(lds + 65536); float* LST = (float*)(lds + 67584);
    unsigned char* Vw = lds + 69632 + wid * 6144;
    const unsigned tr_base = (unsigned)(size_t)Vw + (unsigned)((4 * h + ((lane & 15) >> 2)) * 192 + (16 * ((lane >> 4) & 1) + 4 * (lane & 3)) * 2);
    for (int uu = bid_l(); uu < 512; uu += gridDim.x) {
        const int u = uu & 255, b = u & 7, hd = (u >> 3) & 15, cb_ = u >> 7, c = (uu < 256) ? cb_ : 3 - cb_, rowb = b * SEQ, T0 = 512 * c;
        __syncthreads();
#pragma unroll 1
        for (int stage = 0; stage < 3; ++stage) {
#pragma unroll 1
            for (int g = 0; g < 2; ++g) {
                int dil, r, pos0, kp0, nkt;
                if (stage == 0) { dil = 1; r = 0; pos0 = T0 + 64 * wid + 32 * g; kp0 = pos0 - 128; nkt = 5; }
                else if (stage == 1) { dil = 4; r = wid >> 1; pos0 = 128 * c + 64 * (wid & 1) + 32 * g; kp0 = pos0 - 128; nkt = 5; }
                else { dil = 16; r = 2 * wid + g; pos0 = 32 * c; kp0 = 0; nkt = c + 1; }
                const int qpos = pos0 + q, qtok = dil * qpos + r, tau = qtok - T0;
                const int fsw = ((tau >> 2) ^ (tau >> 4)) & 15;
                s16x8 qf[4];
                { const bf16_t* qp = Qb + ((size_t)(b * 16 + hd) * 2048 + qtok) * 64 + 8 * h;
#pragma unroll
                  for (int ks = 0; ks < 4; ++ks) qf[ks] = gld<s16x8>(qp + 16 * ks); }
                f32x16 oacc[2]; float m = -1.0e30f, l = 0.f;
                if (stage == 0) {
#pragma unroll
                    for (int dt = 0; dt < 2; ++dt)
#pragma unroll
                        for (int e = 0; e < 16; ++e) oacc[dt][e] = 0.f;
                } else {
                    m = MST[tau]; l = LST[tau];
#pragma unroll
                    for (int dt = 0; dt < 2; ++dt)
#pragma unroll
                        for (int gg = 0; gg < 4; ++gg) { const u32x2 w = *(const u32x2*)(OST + tau * 128 + (((8 * dt + 2 * gg + h) ^ fsw) * 8));
                            oacc[dt][4 * gg + 0] = bflo(w.x); oacc[dt][4 * gg + 1] = bfhi(w.x); oacc[dt][4 * gg + 2] = bflo(w.y); oacc[dt][4 * gg + 3] = bfhi(w.y); }
                }
#define DIL_LOAD(KT, KK, VV) do { const int kpb_ = kp0 + 32 * (KT); \
                    _Pragma("unroll") for (int i2 = 0; i2 < 4; ++i2) { int kpos_ = kpb_ + (lane >> 3) + 8 * i2; if (kpos_ < 0) kpos_ = 0; \
                        const unsigned ro_ = (unsigned)(dil * kpos_ + r) * 64u; KK[i2] = gld<u32x4>(kbase + ro_); VV[i2] = gld<u32x4>(vbase + ro_); } } while (0)
                const bf16_t* kbase = Kb + (size_t)(b * 16 + hd) * 2048 * 64 + 8 * (lane & 7); const bf16_t* vbase = Vb + (size_t)(b * 16 + hd) * 2048 * 64 + 8 * (lane & 7);
                u32x4 kA[4], vA[4], kB[4], vB[4];
                DIL_LOAD(0, kA, vA);
#pragma unroll 1
                for (int kt = 0; kt < nkt; kt += 2) {
                    if (kt + 1 < nkt) DIL_LOAD(kt + 1, kB, vB);
                    dil_tile(oacc, m, l, qf, kA, vA, Vw, tr_base, lane, q, h, qpos, kp0 + 32 * kt, kt == 0 || kt == nkt - 1 || kp0 + 32 * kt < 0);
                    if (kt + 1 < nkt) {
                        if (kt + 2 < nkt) DIL_LOAD(kt + 2, kA, vA);
                        dil_tile(oacc, m, l, qf, kB, vB, Vw, tr_base, lane, q, h, qpos, kp0 + 32 * (kt + 1), kt + 1 == nkt - 1 || kp0 + 32 * (kt + 1) < 0);
                    }
                }
                if (stage < 2) {
                    if (h == 0) { MST[tau] = m; LST[tau] = l; }
#pragma unroll
                    for (int dt = 0; dt < 2; ++dt)
#pragma unroll
                        for (int gg = 0; gg < 4; ++gg) { u32x2 w; w.x = cvt_pk_bf16(oacc[dt][4 * gg + 0], oacc[dt][4 * gg + 1]); w.y = cvt_pk_bf16(oacc[dt][4 * gg + 2], oacc[dt][4 * gg + 3]);
                            *(u32x2*)(OST + tau * 128 + (((8 * dt + 2 * gg + h) ^ fsw) * 8)) = w; }
                } else if (!dry) {
                    const float inv = 1.0f / l;
                    bf16_t* op = Ob + (size_t)(rowb + qtok) * 1024 + hd * 64 + 4 * h;
#pragma unroll
                    for (int dt = 0; dt < 2; ++dt)
#pragma unroll
                        for (int gg = 0; gg < 4; ++gg) { u32x2 w; w.x = cvt_pk_bf16(oacc[dt][4 * gg + 0] * inv, oacc[dt][4 * gg + 1] * inv); w.y = cvt_pk_bf16(oacc[dt][4 * gg + 2] * inv, oacc[dt][4 * gg + 3] * inv);
                            gst<u32x2>(op + 32 * dt + 8 * gg, w); }
                }
            }
            __syncthreads();
        }
    }
}

__device__ __forceinline__ void xattn_naive(unsigned char* lds, const Params& p, int l) {
    unsigned char* wsl = p.ws; asm volatile("" : "+s"(wsl));
    const bf16_t* Qb = (const bf16_t*)(wsl + WS_B2); bf16_t* O = (bf16_t*)(wsl + WS_B3); const bf16_t* KV = (const bf16_t*)(wsl + WS_KVX) + (size_t)l * MM * 2048;
    const int tidl = tid_l(), lane = tidl & 63, wid = tidl >> 6, gw = blockIdx.x * (NT / 64) + wid, ngw = gridDim.x * (NT / 64);
    float* qs = (float*)lds + wid * 256;
    for (int item = gw; item < M * 4; item += ngw) {
        const int row = item >> 2, h = item & 3, b = row >> 11;
        { const u32x2 w = *((const u32x2*)(Qb + (size_t)row * 1024 + h * 256) + lane);
          qs[4 * lane + 0] = __uint_as_float(w.x << 16); qs[4 * lane + 1] = __uint_as_float(w.x & 0xffff0000u); qs[4 * lane + 2] = __uint_as_float(w.y << 16); qs[4 * lane + 3] = __uint_as_float(w.y & 0xffff0000u); }
        __builtin_amdgcn_wave_barrier();
        float sc[4]; float mx = -3.0e38f;
#pragma unroll
        for (int i = 0; i < 4; ++i) { const int key = lane + 64 * i; const u32x4* kp = (const u32x4*)(KV + (size_t)(b * MEML + key) * 2048 + h * 256); float d = 0.f;
#pragma unroll 4
            for (int c = 0; c < 32; ++c) { const u32x4 w = kp[c]; const float* qq = qs + 8 * c;
                d += qq[0] * __uint_as_float(w.x << 16) + qq[1] * __uint_as_float(w.x & 0xffff0000u) + qq[2] * __uint_as_float(w.y << 16) + qq[3] * __uint_as_float(w.y & 0xffff0000u)
                   + qq[4] * __uint_as_float(w.z << 16) + qq[5] * __uint_as_float(w.z & 0xffff0000u) + qq[6] * __uint_as_float(w.w << 16) + qq[7] * __uint_as_float(w.w & 0xffff0000u); }
            sc[i] = d; mx = fmaxf(mx, d); }
        mx = wave_max(mx);
        float lsum = 0.f;
#pragma unroll
        for (int i = 0; i < 4; ++i) { sc[i] = expf(sc[i] - mx); lsum += sc[i]; }
        lsum = wave_sum(lsum);
        float o[4] = {0.f, 0.f, 0.f, 0.f};
#pragma unroll
        for (int i = 0; i < 4; ++i)
            for (int j = 0; j < 64; ++j) { const int key = 64 * i + j; const float pj = __shfl(sc[i], j); const bf16_t* vp = KV + (size_t)(b * MEML + key) * 2048 + 1024 + h * 256 + lane;
                o[0] += pj * bf2f(vp[0]); o[1] += pj * bf2f(vp[64]); o[2] += pj * bf2f(vp[128]); o[3] += pj * bf2f(vp[192]); }
        const float inv = 1.0f / lsum;
#pragma unroll
        for (int jj = 0; jj < 4; ++jj) O[(size_t)row * 1024 + h * 256 + lane + 64 * jj] = f2bf(o[jj] * inv);
        __builtin_amdgcn_wave_barrier();
    }
}

__device__ __forceinline__ void xattn_units(unsigned char* lds, const Params& p, int l, int unit0, int unit_step) {
    unsigned char* wsl = p.ws; asm volatile("" : "+s"(wsl));
    const bf16_t* Qb = (const bf16_t*)(wsl + WS_B2); bf16_t* O = (bf16_t*)(wsl + WS_B3);
    const bf16_t* KX = (const bf16_t*)(wsl + WS_KVX) + (size_t)l * MM * 1024; const bf16_t* VT = (const bf16_t*)(wsl + WS_VTX) + (size_t)l * 1024 * MM;
    const int tid = tid_l(), lane = tid & 63, wid = tid >> 6, q = lane & 31, h = lane >> 5;
#ifndef XREP_A
#define XREP_A 1
#endif
#ifndef XREP_B
#define XREP_B 1
#endif
#ifndef XREP_S
#define XREP_S 1
#endif
    for (int unit = unit0; unit < 256; unit += unit_step) {
        const int pm = unit >> 2, hd = unit & 3, b = pm >> 3;
        const int row = pm * 256 + wid * 32 + q;
        const bf16_t* qp = Qb + (size_t)row * 1024 + hd * 256 + 8 * h;
#pragma unroll 4
        for (int i = 0; i < 16; ++i) { const int id = tid + 512 * i, key = id >> 5, ch = id & 31;
            const u32x4 w = gld<u32x4>(KX + (size_t)(b * MEML + key) * 1024 + hd * 256 + ch * 8);
            *(u32x4*)(lds + key * 528 + ch * 16) = w; }
        __syncthreads();
        f32x16 sacc[8];
        {
#pragma unroll
        for (int kt = 0; kt < 8; ++kt)
#pragma unroll
            for (int r = 0; r < 16; ++r) sacc[kt][r] = 0.f;
#pragma unroll 4
        for (int ks = 0; ks < 16; ++ks) {
            const s16x8 qf = gld<s16x8>(qp + 16 * ks);
#pragma unroll
            for (int kt = 0; kt < 8; ++kt) { const s16x8 kf = *(const s16x8*)(lds + (32 * kt + q) * 528 + (16 * ks + 8 * h) * 2);
                sacc[kt] = __builtin_amdgcn_mfma_f32_32x32x16_bf16(kf, qf, sacc[kt], 0, 0, 0); }
        }
        }
        float mx = -3.0e38f;
#pragma unroll
        for (int kt = 0; kt < 8; ++kt)
#pragma unroll
            for (int r = 0; r < 16; ++r) mx = fmaxf(mx, sacc[kt][r]);
        mx = fmaxf(mx, __shfl_xor(mx, 32));
        float ls = 0.f;
        s16x8 pf[8][2];
#pragma unroll
        for (int kt = 0; kt < 8; ++kt) {
#pragma unroll
            for (int r = 0; r < 16; ++r) { const float e = __builtin_amdgcn_exp2f(sacc[kt][r] - mx); sacc[kt][r] = e; ls += e; }
#pragma unroll
            for (int s2 = 0; s2 < 2; ++s2) { u32x4 w;
                w.x = cvt_pk_bf16(sacc[kt][8 * s2 + 0], sacc[kt][8 * s2 + 1]); w.y = cvt_pk_bf16(sacc[kt][8 * s2 + 2], sacc[kt][8 * s2 + 3]);
                w.z = cvt_pk_bf16(sacc[kt][8 * s2 + 4], sacc[kt][8 * s2 + 5]); w.w = cvt_pk_bf16(sacc[kt][8 * s2 + 6], sacc[kt][8 * s2 + 7]);
                pf[kt][s2] = __builtin_bit_cast(s16x8, w); }
        }
        ls += __shfl_xor(ls, 32);
        const float inv = 1.0f / ls;
        __syncthreads();
#pragma unroll 8
        for (int i = 0; i < 16; ++i) { const int id = tid + 512 * i, d = id >> 5, ch = id & 31; const u32x4 w = gld<u32x4>(VT + (size_t)(hd * 256 + d) * MM + b * MEML + ch * 8);
            unsigned char* gp_ = lds + d * 528 + (ch >> 1) * 32 + (ch & 1) * 8;
            *(u32x2*)gp_ = (u32x2){w.x, w.y}; *(u32x2*)(gp_ + 16) = (u32x2){w.z, w.w}; }
        __syncthreads();
#pragma unroll 1
        for (int dt = 0; dt < 8; ++dt) {
            f32x16 oacc;
#pragma unroll
            for (int r = 0; r < 16; ++r) oacc[r] = 0.f;
            const unsigned char* vb = lds + (32 * dt + q) * 528 + 16 * h;
#pragma unroll
            for (int kt = 0; kt < 8; ++kt)
#pragma unroll
                for (int s2 = 0; s2 < 2; ++s2) {
                    const s16x8 vf = *(const s16x8*)(vb + (32 * kt + 16 * s2) * 2);
                    oacc = __builtin_amdgcn_mfma_f32_32x32x16_bf16(vf, pf[kt][s2], oacc, 0, 0, 0);
                }
            __syncthreads();
            unsigned char* ow = lds + (32 * dt) * 528 + wid * 2048 + q * 64 + 8 * h;
#pragma unroll
            for (int g = 0; g < 4; ++g) { u32x2 w; w.x = cvt_pk_bf16(oacc[4 * g + 0] * inv, oacc[4 * g + 1] * inv); w.y = cvt_pk_bf16(oacc[4 * g + 2] * inv, oacc[4 * g + 3] * inv);
                *(u32x2*)(ow + 16 * g) = w; }
        }
        __builtin_amdgcn_wave_barrier();
        {
          const unsigned char* orow = lds + ((lane & 31) >> 2) * (32 * 528) + wid * 2048 + (lane & 3) * 16;
          bf16_t* obase = O + (size_t)(pm * 256 + wid * 32) * 1024 + hd * 256 + 8 * (lane & 31);
#pragma unroll
          for (int i = 0; i < 16; ++i) { const int r = (lane >> 5) + 2 * i; gst<u32x4>(obase + (size_t)r * 1024, *(const u32x4*)(orow + r * 64)); }
        }
        __syncthreads();
    }
}

__device__ __forceinline__ void sgu_naive(unsigned char* lds, const Params& p, int i) {
    unsigned char* wsl = p.ws; asm volatile("" : "+s"(wsl));
    bf16_t* U = (bf16_t*)(wsl + WS_B0); const bf16_t* V = (const bf16_t*)(wsl + WS_B1); const bf16_t* G = (const bf16_t*)(wsl + WS_B2); const float* LNS = (const float*)(wsl + WS_LNS);
    const float* lng = p.in[9] + i * 1024; const float* lnb = p.in[10] + i * 1024; const float* Ws = p.in[11] + (size_t)i * 4 * 128 * 128; const float* bs = p.in[12] + i * 4 * 128;
    float* vn = (float*)lds;
    float* mu = vn + 128 * 256;
    float* rsd = mu + 128;
    const int tid = tid_l();
    for (int item = bid_l(); item < 128 * 4; item += gridDim.x) {
        const int chunk = item >> 2, g = item & 3, row0 = chunk * 128;
        if (tid < 128) { float s = 0.f, q = 0.f;
            for (int k = 0; k < 4; ++k) { s += LNS[(size_t)k * M + row0 + tid]; q += LNS[(size_t)(4 + k) * M + row0 + tid]; }
            const float m = s * (1.0f / 1024.f); const float var = q * (1.0f / 1024.f) - m * m; mu[tid] = m; rsd[tid] = rsqrtf(fmaxf(var, 0.f) + EPS); }
        __syncthreads();
#pragma unroll 2
        for (int e = tid; e < 128 * 256; e += NT) { const int j = e >> 8, c = e & 255, col = g * 256 + c;
            vn[e] = (bf2f(V[(size_t)(row0 + j) * 1024 + col]) - mu[j]) * rsd[j] * lng[col] + lnb[col]; }
        __syncthreads();
#pragma unroll 1
        for (int e = tid; e < 128 * 256; e += NT) { const int ii = e >> 8, c = e & 255, col = g * 256 + c; const float* wr = Ws + (size_t)g * 128 * 128 + (size_t)ii * 128;
            float acc = 0.f;
#pragma unroll 4
            for (int j = 0; j <= ii; ++j) acc += wr[j] * vn[j * 256 + c];
            acc += bs[g * 128 + ii];
            const size_t off = (size_t)(row0 + ii) * 1024 + col;
            U[off] = f2bf(bf2f(U[off]) * acc * bf2f(G[off])); }
        __syncthreads();
    }
}

constexpr size_t WS_WP = WS_B2, WS_VP = WS_B2 + 16 * MiB;
__device__ __forceinline__ void xattn_prep(unsigned char* lds, const Params& p, int l) {
    unsigned char* wsl = p.ws; asm volatile("" : "+s"(wsl));
    const bf16_t* KX = (const bf16_t*)(wsl + WS_KVX) + (size_t)l * MM * 1024; const bf16_t* VX = (const bf16_t*)(wsl + WS_VTX) + (size_t)l * MM * 1024;
    const bf16_t* WQ = (const bf16_t*)(wsl + WS_WXQ) + (size_t)l * 1024 * 1024; const bf16_t* WO = (const bf16_t*)(wsl + WS_WXO) + (size_t)l * 1024 * 1024;
    for (int j = bid_l(); j < 256; j += gridDim.x) {
        const int jj = j & 127, b = jj >> 4, hd = (jj >> 2) & 3, t4 = jj & 3;
        const bf16_t* A; const bf16_t* Bt; bf16_t* dst;
        if (j < 128) { A = KX + (size_t)(b * MEML) * 1024 + hd * 256; Bt = WQ + (size_t)(t4 * 256) * 1024 + hd * 256; dst = (bf16_t*)(wsl + WS_WP) + (size_t)(b * 1024 + hd * 256) * 1024 + t4 * 256; }
        else         { A = WO + (size_t)(t4 * 256) * 1024 + hd * 256; Bt = VX + (size_t)(b * MEML) * 1024 + hd * 256; dst = (bf16_t*)(wsl + WS_VP) + (size_t)(b * 1024 + t4 * 256) * 1024 + hd * 256; }
        EpiTile E{dst};
        run_gemm<1>(lds, A, A, 256, Bt, 256, 256, 256, E, 1 << 20, 0, 1 << 20, 0, 1, 0, 1024, 1024);
    }
}
__device__ __forceinline__ void xattn_s(unsigned char* lds, const Params& p) {
    unsigned char* wsl = p.ws; asm volatile("" : "+s"(wsl));
    for (int i = 0;; ++i) {
        const int pu = pg8::static_unit(M, 1024, (int)gridDim.x, bid_l(), i); if (pu < 0) break;
        const int pm = __builtin_amdgcn_readfirstlane(pu >> 16), hd = __builtin_amdgcn_readfirstlane(pu & 65535), b = pm >> 3;
        const bf16_t* A = (const bf16_t*)(wsl + WS_XB) + (size_t)(pm * 256) * 1024;
        EpiSoftmaxP E{(bf16_t*)(wsl + WS_B0) + (size_t)(pm * 256) * 1024 + hd * 256, (const float*)(wsl + WS_RS) + pm * 256, lds + 131072};
        run_gemm<1>(lds, A, A, 1024, (const bf16_t*)(wsl + WS_WP) + (size_t)(b * 1024 + hd * 256) * 1024, 256, 256, 1024, E, 1 << 20, 0, 1 << 20, 0, 1, 0, 1024, 1024);
    }
}
__device__ __forceinline__ void xattn_o(unsigned char* lds, const Params& p, const int dry) {
    unsigned char* wsl = p.ws; asm volatile("" : "+s"(wsl));
    for (int i = 0;; ++i) {
        const int pu = pg8::static_unit(M, 1024, (int)gridDim.x, bid_l(), i); if (pu < 0) break;
        const int pm = __builtin_amdgcn_readfirstlane(pu >> 16), pn = __builtin_amdgcn_readfirstlane(pu & 65535), b = pm >> 3;
        const bf16_t* A = (const bf16_t*)(wsl + WS_B0) + (size_t)(pm * 256) * 1024;
        EpiResid E{(bf16_t*)(wsl + WS_XB) + (size_t)(pm * 256) * 1024 + pn * 256, (float*)(wsl + WS_RS) + (size_t)pn * M + pm * 256, lds + 131072, dry};
        run_gemm<1>(lds, A, A, 1024, (const bf16_t*)(wsl + WS_VP) + (size_t)(b * 1024 + pn * 256) * 1024, 256, 256, 1024, E, 1 << 20, 0, 1 << 20, 0, 1, 0, 1024, 1024);
    }
}

__device__ __forceinline__ void sgu_mfma(unsigned char* lds, const Params& p, int i, const int dry) {
    unsigned char* wsl = p.ws; asm volatile("" : "+s"(wsl));
    bf16_t* U = (bf16_t*)(wsl + WS_B0); const bf16_t* V = (const bf16_t*)(wsl + WS_B1); const bf16_t* G = (const bf16_t*)(wsl + WS_B2); const float* LNS = (const float*)(wsl + WS_LNS);
    const bf16_t* SW = (const bf16_t*)(wsl + WS_SGUW) + (size_t)i * 4 * 128 * 128;
    const float* lng = p.in[9] + i * 1024; const float* lnb = p.in[10] + i * 1024; const float* bs = p.in[12] + i * 4 * 128;
    const int tid = tid_l(), lane = tid & 63, wid = tid >> 6, q = lane & 31, h = lane >> 5;
    float* mu = (float*)(lds + 73728); float* rsd = mu + 128;
    const unsigned tr_base = (unsigned)(size_t)lds + (unsigned)((8 * h + ((lane & 15) >> 2)) * 576 + (32 * wid + 16 * ((lane >> 4) & 1) + 4 * (lane & 3)) * 2);
    for (int item = bid_l(); item < 128 * 4; item += gridDim.x) {
        const int chunk = item >> 2, g = item & 3, row0 = chunk * 128;
        __syncthreads();
        if (tid < 128) { float sm = 0.f, qq = 0.f;
#pragma unroll
            for (int k = 0; k < 4; ++k) { sm += LNS[(size_t)k * M + row0 + tid]; qq += LNS[(size_t)(4 + k) * M + row0 + tid]; }
            const float mm = sm * (1.0f / 1024.f); const float var = qq * (1.0f / 1024.f) - mm * mm; mu[tid] = mm; rsd[tid] = rsqrtf(fmaxf(var, 0.f) + EPS); }
        __syncthreads();
#pragma unroll 2
        for (int k = 0; k < 8; ++k) { const int id = tid + 512 * k, j = id >> 5, c8 = id & 31, col = g * 256 + 8 * c8;
            const u32x4 w = gld<u32x4>(V + (size_t)(row0 + j) * 1024 + col);
            const f32x4 g0 = gld<f32x4>(lng + col), g1 = gld<f32x4>(lng + col + 4), b0 = gld<f32x4>(lnb + col), b1 = gld<f32x4>(lnb + col + 4);
            const float m_ = mu[j], r_ = rsd[j];
            const f32x4 v0 = (f32x4){(bflo(w.x) - m_) * r_ * g0.x + b0.x, (bfhi(w.x) - m_) * r_ * g0.y + b0.y, (bflo(w.y) - m_) * r_ * g0.z + b0.z, (bfhi(w.y) - m_) * r_ * g0.w + b0.w};
            const f32x4 v1 = (f32x4){(bflo(w.z) - m_) * r_ * g1.x + b1.x, (bfhi(w.z) - m_) * r_ * g1.y + b1.y, (bflo(w.w) - m_) * r_ * g1.z + b1.z, (bfhi(w.w) - m_) * r_ * g1.w + b1.w};
            *(u32x4*)(lds + j * 576 + c8 * 16) = pack8(v0, v1); }
        __syncthreads();
        f32x16 acc[4];
#pragma unroll
        for (int it = 0; it < 4; ++it)
#pragma unroll
            for (int e = 0; e < 16; ++e) acc[it][e] = 0.f;
        const bf16_t* wp = SW + (size_t)g * 128 * 128 + (size_t)q * 128 + 8 * h;
#pragma unroll
        for (int ks = 0; ks < 8; ++ks) {
            s16x4 t0, t1; const unsigned a = tr_base + ks * 9216;
            asm volatile("ds_read_b64_tr_b16 %0, %2 offset:0\n\tds_read_b64_tr_b16 %1, %2 offset:2304\n\ts_waitcnt lgkmcnt(0)" : "=&v"(t0), "=&v"(t1) : "v"(a) : "memory");
            const s16x8 vf = __builtin_shufflevector(t0, t1, 0, 1, 2, 3, 4, 5, 6, 7);
#pragma unroll
            for (int it = ks >> 1; it < 4; ++it) { const s16x8 wf = gld<s16x8>(wp + (size_t)(32 * it) * 128 + 16 * ks);
                acc[it] = __builtin_amdgcn_mfma_f32_32x32x16_bf16(vf, wf, acc[it], 0, 0, 0); }
        }
        __syncthreads();
#pragma unroll
        for (int it = 0; it < 4; ++it)
#pragma unroll
            for (int gg = 0; gg < 4; ++gg)
                *(f32x4*)(lds + (32 * it + q) * 1040 + (32 * wid + 8 * gg + 4 * h) * 4) = (f32x4){acc[it][4 * gg + 0], acc[it][4 * gg + 1], acc[it][4 * gg + 2], acc[it][4 * gg + 3]};
        __syncthreads();
#pragma unroll 2
        for (int k = 0; k < 8; ++k) { const int id = tid + 512 * k, ii = id >> 5, c8 = id & 31;
            const size_t off = (size_t)(row0 + ii) * 1024 + g * 256 + 8 * c8;
            const u32x4 uu = gld<u32x4>(U + off), gv = gld<u32x4>(G + off);
            const f32x4 d0 = *(const f32x4*)(lds + ii * 1040 + c8 * 32), d1 = *(const f32x4*)(lds + ii * 1040 + c8 * 32 + 16);
            const float bias = gld<float>(bs + g * 128 + ii);
            const f32x4 o0 = (f32x4){(d0.x + bias) * bflo(uu.x) * bflo(gv.x), (d0.y + bias) * bfhi(uu.x) * bfhi(gv.x), (d0.z + bias) * bflo(uu.y) * bflo(gv.y), (d0.w + bias) * bfhi(uu.y) * bfhi(gv.y)};
            const f32x4 o1 = (f32x4){(d1.x + bias) * bflo(uu.z) * bflo(gv.z), (d1.y + bias) * bfhi(uu.z) * bfhi(gv.z), (d1.z + bias) * bflo(uu.w) * bflo(gv.w), (d1.w + bias) * bfhi(uu.w) * bfhi(gv.w)};
            if (!dry) wst16(U, off * 2, pack8(o0, o1)); }
    }
}
__device__ __forceinline__ void conv_sguw(const Params& p) {
    unsigned char* wsl = p.ws; asm volatile("" : "+s"(wsl));
    bf16_t* SW = (bf16_t*)(wsl + WS_SGUW);
    for (int e = blockIdx.x * NT + tid_l(); e < 2 * 4 * 128 * 128; e += gridDim.x * NT) { const int ii = (e >> 7) & 127, j = e & 127; SW[e] = f2bf(j <= ii ? p.in[11][e] : 0.f); }
}

__device__ __forceinline__ void s5_naive(const Params& p, int i) {
    unsigned char* wsl = p.ws; asm volatile("" : "+s"(wsl));
    bf16_t* XD = (bf16_t*)(wsl + WS_B3);
    const int tidl = tid_l(), lane = tidl & 63, wid = tidl >> 6;
    if (wid != 0) return;
    for (int item = bid_l(); item < BATCH * 32; item += gridDim.x) {
        const int b = item >> 5, g = item & 31;
        const float dt = expf(p.in[15][i * 32 + g]);
        const float ar = p.in[13][(i * 32 + g) * 64 + lane], ai = p.in[14][(i * 32 + g) * 64 + lane];
        const float mag = expf(dt * ar), abr = mag * cosf(dt * ai), abi = mag * sinf(dt * ai);
        const float nr = abr - 1.0f, ni = abi, inv = 1.0f / (ar * ar + ai * ai);
        const float cr = (nr * ar + ni * ai) * inv, ci = (ni * ar - nr * ai) * inv;
        float bbr[16], bbi[16], cre[16], cim[16];
#pragma unroll
        for (int h = 0; h < 16; ++h) {
            const float br = p.in[16][((size_t)(i * 32 + g) * 64 + lane) * 16 + h], bi = p.in[17][((size_t)(i * 32 + g) * 64 + lane) * 16 + h];
            bbr[h] = cr * br - ci * bi; bbi[h] = cr * bi + ci * br;
            cre[h] = p.in[18][((size_t)(i * 32 + g) * 16 + h) * 64 + lane]; cim[h] = p.in[19][((size_t)(i * 32 + g) * 16 + h) * 64 + lane];
        }
        const float dsk = (lane < 16) ? p.in[20][i * 512 + g * 16 + lane] : 0.f;
        float hr = 0.f, hi = 0.f;
#pragma unroll 1
        for (int t = 0; t < SEQ; ++t) {
            bf16_t* up = XD + (size_t)(b * SEQ + t) * 1024 + g * 16;
            const u32x4 w0 = *(const u32x4*)up, w1 = *(const u32x4*)(up + 8);
            float u[16];
            u[0] = __uint_as_float(w0.x << 16); u[1] = __uint_as_float(w0.x & 0xffff0000u); u[2] = __uint_as_float(w0.y << 16); u[3] = __uint_as_float(w0.y & 0xffff0000u);
            u[4] = __uint_as_float(w0.z << 16); u[5] = __uint_as_float(w0.z & 0xffff0000u); u[6] = __uint_as_float(w0.w << 16); u[7] = __uint_as_float(w0.w & 0xffff0000u);
            u[8] = __uint_as_float(w1.x << 16); u[9] = __uint_as_float(w1.x & 0xffff0000u); u[10] = __uint_as_float(w1.y << 16); u[11] = __uint_as_float(w1.y & 0xffff0000u);
            u[12] = __uint_as_float(w1.z << 16); u[13] = __uint_as_float(w1.z & 0xffff0000u); u[14] = __uint_as_float(w1.w << 16); u[15] = __uint_as_float(w1.w & 0xffff0000u);
            float bur = 0.f, bui = 0.f;
#pragma unroll
            for (int h = 0; h < 16; ++h) { bur += u[h] * bbr[h]; bui += u[h] * bbi[h]; }
            const float nhr = abr * hr - abi * hi + bur, nhi = abr * hi + abi * hr + bui; hr = nhr; hi = nhi;
            float mine = 0.f, umine = 0.f;
#pragma unroll
            for (int h = 0; h < 16; ++h) { const float r = wave_sum(hr * cre[h] - hi * cim[h]); if (lane == h) { mine = r; umine = u[h]; } }
            if (lane < 16) up[lane] = f2bf(gelu_tanh_f(mine + dsk * umine));
        }
    }
}

typedef float f32x4v __attribute__((ext_vector_type(4)));
typedef float f32x2v_ __attribute__((ext_vector_type(2)));
template <int PASS>
__device__ __forceinline__ void s5_pass(float& hr, float& hi, const float (&pwr)[4], const float (&pwi)[4], const pg8::bf16x8 (&bfrag)[8], const pg8::bf16x8 (&cfrag)[4], const f32x4v dsk,
                                        bf16_t* XD, unsigned char* BUw, unsigned char* Hw, int b, int g, int wid, int lane, int tl, int kq, const int dry) {
            bf16_t* ubase = XD + (size_t)(b * SEQ + wid * 256 + tl) * 1024 + g * 16;
            pg8::bf16x8 ufn[2]; u32x2 uen[2];
#pragma unroll
            for (int k2 = 0; k2 < 2; ++k2) { ufn[k2] = (pg8::bf16x8){0, 0, 0, 0, 0, 0, 0, 0}; uen[k2] = (u32x2){0u, 0u};
                if (kq < 2) ufn[k2] = gld<pg8::bf16x8>(ubase + (size_t)(16 * k2) * 1024 + 8 * kq);
                if constexpr (PASS == 1) uen[k2] = gld<u32x2>(ubase + (size_t)(16 * k2) * 1024 + 4 * kq); }
#pragma unroll 1
            for (int tt = 0; tt < 16; ++tt) {
                bf16_t* urow = ubase + (size_t)(16 * tt) * 1024;
                const pg8::bf16x8 ufrag = ufn[0]; const u32x2 ue = uen[0];
                ufn[0] = ufn[1]; uen[0] = uen[1];
                if (tt + 2 < 16) { if (kq < 2) ufn[1] = gld<pg8::bf16x8>(urow + (size_t)32 * 1024 + 8 * kq); if constexpr (PASS == 1) uen[1] = gld<u32x2>(urow + (size_t)32 * 1024 + 4 * kq); }
#pragma unroll
                for (int rt = 0; rt < 8; ++rt) {
                    const f32x4 d = __builtin_amdgcn_mfma_f32_16x16x32_bf16(bfrag[rt], ufrag, (f32x4){0.f, 0.f, 0.f, 0.f}, 0, 0, 0);
                    *(u32x2*)(BUw + tl * 272 + (8 * rt + 2 * kq) * 4) = (u32x2){cvt_pk_bf16(d.x, d.y), cvt_pk_bf16(d.z, d.w)};
                }
                __builtin_amdgcn_wave_barrier();
                float bur[16], bui[16];
#pragma unroll
                for (int t = 0; t < 16; ++t) { const unsigned bw = *(const unsigned*)(BUw + t * 272 + lane * 4); bur[t] = bflo(bw); bui[t] = bfhi(bw); }
#pragma unroll
                for (int j = 0; j < 4; ++j)
#pragma unroll
                    for (int i2 = 1; i2 < 4; ++i2) { const int t = 4 * j + i2;
                        const float lr = fmaf(pwr[0], bur[t - 1], fmaf(-pwi[0], bui[t - 1], bur[t])), li = fmaf(pwr[0], bui[t - 1], fmaf(pwi[0], bur[t - 1], bui[t])); bur[t] = lr; bui[t] = li; }
#pragma unroll
                for (int j = 0; j < 4; ++j) {
                    const float cr = hr, ci = hi;
#pragma unroll
                    for (int i2 = 0; i2 < 4; ++i2) { const int t = 4 * j + i2;
                        const float xr = fmaf(pwr[i2], cr, fmaf(-pwi[i2], ci, bur[t])), xi = fmaf(pwr[i2], ci, fmaf(pwi[i2], cr, bui[t]));
                        if constexpr (PASS == 1) *(unsigned*)(Hw + t * 272 + lane * 4) = cvt_pk_bf16(xr, xi);
                        if (i2 == 3) { hr = xr; hi = xi; } }
                }
                if constexpr (PASS == 1) {
                    __builtin_amdgcn_wave_barrier();
                    f32x4 y = (f32x4){0.f, 0.f, 0.f, 0.f};
#pragma unroll
                    for (int kk = 0; kk < 4; ++kk) { const pg8::bf16x8 hf = *(const pg8::bf16x8*)(Hw + tl * 272 + (32 * kk + 8 * kq) * 2);
                        y = __builtin_amdgcn_mfma_f32_16x16x32_bf16(cfrag[kk], hf, y, 0, 0, 0); }
                    float yy[4] = {y.x + dsk.x * bflo(ue.x), y.y + dsk.y * bfhi(ue.x), y.z + dsk.z * bflo(ue.y), y.w + dsk.w * bfhi(ue.y)};
#pragma unroll
                    for (int r = 0; r < 4; ++r) { const float x = yy[r]; yy[r] = x * fsigmoid(1.5957691216057308f * (x + 0.044715f * x * x * x)); }
                    u32x2 w; w.x = cvt_pk_bf16(yy[0], yy[1]); w.y = cvt_pk_bf16(yy[2], yy[3]);
                    if (!dry) gst<u32x2>(urow + 4 * kq, w);
                }
                __builtin_amdgcn_wave_barrier();
            }
}
__device__ __forceinline__ void s5_mfma(unsigned char* lds, const Params& p, int i, const int dry) {
    unsigned char* wsl = p.ws; asm volatile("" : "+s"(wsl));
    bf16_t* XD = (bf16_t*)(wsl + WS_B3);
    const int tid = tid_l(), lane = tid & 63, wid = tid >> 6, tl = lane & 15, kq = lane >> 4;
    bf16_t* TB = (bf16_t*)lds;
    bf16_t* TC = (bf16_t*)(lds + 4096);
    float* AB = (float*)(lds + 8192);
    float* A256 = (float*)(lds + 8704);
    float* HE = (float*)(lds + 9216);
    unsigned char* BUw = lds + 16384 + wid * 12800;
    unsigned char* Hw = BUw + 8448;
    for (int item = bid_l(); item < BATCH * 32; item += gridDim.x) {
        const int b = item >> 5, g = item & 31;
        __syncthreads();
        if (tid < 64) {
            const int pp = tid;
            const float dt = expf(p.in[15][i * 32 + g]);
            const float ar = p.in[13][(i * 32 + g) * 64 + pp], ai = p.in[14][(i * 32 + g) * 64 + pp];
            const float mag = expf(dt * ar), abr = mag * cosf(dt * ai), abi = mag * sinf(dt * ai);
            const float nr = abr - 1.0f, ni = abi, inv = 1.0f / (ar * ar + ai * ai);
            const float cr = (nr * ar + ni * ai) * inv, ci = (ni * ar - nr * ai) * inv;
#pragma unroll
            for (int h = 0; h < 16; ++h) {
                const float br = p.in[16][((size_t)(i * 32 + g) * 64 + pp) * 16 + h], bi = p.in[17][((size_t)(i * 32 + g) * 64 + pp) * 16 + h];
                TB[(2 * pp) * 16 + h] = f2bf(cr * br - ci * bi); TB[(2 * pp + 1) * 16 + h] = f2bf(cr * bi + ci * br);
                TC[h * 128 + 2 * pp] = f2bf(p.in[18][((size_t)(i * 32 + g) * 16 + h) * 64 + pp]); TC[h * 128 + 2 * pp + 1] = f2bf(-p.in[19][((size_t)(i * 32 + g) * 16 + h) * 64 + pp]);
            }
            AB[pp] = abr; AB[64 + pp] = abi;
            float xr = abr, xi = abi;
#pragma unroll
            for (int k = 0; k < 8; ++k) { const float t2 = xr * xr - xi * xi; xi = 2.0f * xr * xi; xr = t2; }
            A256[pp] = xr; A256[64 + pp] = xi;
        }
        __syncthreads();
        const float abr = AB[lane], abi = AB[64 + lane];
        float pwr[4], pwi[4]; pwr[0] = abr; pwi[0] = abi;
#pragma unroll
        for (int k = 1; k < 4; ++k) { pwr[k] = pwr[k - 1] * abr - pwi[k - 1] * abi; pwi[k] = pwr[k - 1] * abi + pwi[k - 1] * abr; }
        pg8::bf16x8 bfrag[8], cfrag[4];
#pragma unroll
        for (int rt = 0; rt < 8; ++rt) { if (kq < 2) bfrag[rt] = *(const pg8::bf16x8*)(TB + (16 * rt + tl) * 16 + 8 * kq); else bfrag[rt] = (pg8::bf16x8){0, 0, 0, 0, 0, 0, 0, 0}; }
#pragma unroll
        for (int kk = 0; kk < 4; ++kk) cfrag[kk] = *(const pg8::bf16x8*)(TC + tl * 128 + 32 * kk + 8 * kq);
        const f32x4v dsk = *(const f32x4v*)(p.in[20] + i * 512 + g * 16 + 4 * kq);
        float hr = 0.f, hi = 0.f;
#pragma unroll 1
        for (int pass = 0; pass < 2; ++pass) {
            if (pass == 1) {
                HE[(wid * 2 + 0) * 64 + lane] = hr; HE[(wid * 2 + 1) * 64 + lane] = hi;
                __syncthreads();
                const float a2r = A256[lane], a2i = A256[64 + lane];
                hr = 0.f; hi = 0.f;
                for (int w2 = 0; w2 < wid; ++w2) { const float er = HE[(w2 * 2 + 0) * 64 + lane], ei = HE[(w2 * 2 + 1) * 64 + lane];
                    const float nr2 = a2r * hr - a2i * hi + er, ni2 = a2r * hi + a2i * hr + ei; hr = nr2; hi = ni2; }
            }
            if (pass == 0) s5_pass<0>(hr, hi, pwr, pwi, bfrag, cfrag, dsk, XD, BUw, Hw, b, g, wid, lane, tl, kq, dry);
            else s5_pass<1>(hr, hi, pwr, pwi, bfrag, cfrag, dsk, XD, BUw, Hw, b, g, wid, lane, tl, kq, dry);
        }
    }
}

__device__ __forceinline__ void final_norm(const Params& p) {
    unsigned char* wsl = p.ws; asm volatile("" : "+s"(wsl));
    const bf16_t* XB = (const bf16_t*)(wsl + WS_XB);
    const int tidl = tid_l(), lane = tidl & 63, gw = blockIdx.x * (NT / 64) + (tidl >> 6), ngw = gridDim.x * (NT / 64);
    for (int row = gw; row < M; row += ngw) {
        const u32x4 a = gld<u32x4>(XB + (size_t)row * DM + 8 * lane), c = gld<u32x4>(XB + (size_t)row * DM + 512 + 8 * lane);
        float v[16] = {bflo(a.x), bfhi(a.x), bflo(a.y), bfhi(a.y), bflo(a.z), bfhi(a.z), bflo(a.w), bfhi(a.w), bflo(c.x), bfhi(c.x), bflo(c.y), bfhi(c.y), bflo(c.z), bfhi(c.z), bflo(c.w), bfhi(c.w)};
        float s = 0.f;
#pragma unroll
        for (int j = 0; j < 16; ++j) s += v[j] * v[j];
        s = wave_sum(s); const float r = rsqrtf(s * (1.0f / DM) + EPS);
        const float* gp = p.in[29] + 8 * lane; float* op = p.out + (size_t)row * DM + 8 * lane;
#pragma unroll
        for (int hh = 0; hh < 2; ++hh) { const f32x4 g0 = gld<f32x4>(gp + 512 * hh), g1 = gld<f32x4>(gp + 512 * hh + 4);
            gst<f32x4>(op + 512 * hh, (f32x4){v[8 * hh + 0] * r * g0.x, v[8 * hh + 1] * r * g0.y, v[8 * hh + 2] * r * g0.z, v[8 * hh + 3] * r * g0.w});
            gst<f32x4>(op + 512 * hh + 4, (f32x4){v[8 * hh + 4] * r * g1.x, v[8 * hh + 5] * r * g1.y, v[8 * hh + 6] * r * g1.z, v[8 * hh + 7] * r * g1.w}); }
    }
}

#define WSL(name) unsigned char* name = p.ws; asm volatile("" : "+s"(name))
#define PBF(ws_, off) ((bf16_t*)((ws_) + (off)))
#define PF32(ws_, off) ((float*)((ws_) + (off)))
#ifndef F_KV
#define F_KV 1
#endif
#ifndef F_G1
#define F_G1 1
#endif
#ifndef F_G1U
#define F_G1U 1
#endif
#ifndef F_GG
#define F_GG 1
#endif
#ifndef F_G2
#define F_G2 1
#endif
#ifndef F_G1O
#define F_G1O 1
#endif
#ifndef F_GLU
#define F_GLU 1
#endif
#ifndef F_G2O
#define F_G2O 1
#endif
#ifndef F_G3
#define F_G3 1
#endif
#ifndef F_G4
#define F_G4 1
#endif
#define XB_TMO      128
#define XB_XCNT(j)  (256  + 64 * (j))
#define XB_XSUB(j)  (1280 + 64 * (j))
#define XB_XGEN(j)  (2304 + 64 * (j))
#define XB_TOP      3328
#define XB_TOPGEN   3392
#define XCD_BAR_WORDS 3456
#define XB_SPIN_CAP (1u << 22)
__device__ __forceinline__ unsigned xb_ld(unsigned* p)              { return __hip_atomic_load(p, __ATOMIC_RELAXED, __HIP_MEMORY_SCOPE_AGENT); }
__device__ __forceinline__ unsigned xb_add(unsigned* p, unsigned v) { return __hip_atomic_fetch_add(p, v, __ATOMIC_RELAXED, __HIP_MEMORY_SCOPE_AGENT); }
__device__ __forceinline__ unsigned xb_xcc_id() { return (unsigned)__builtin_amdgcn_s_getreg((3 << 11) | 20) & 0xFu; }
#define XB_SPIN(cond, bar) do { unsigned _sp = 0; while (cond) { __builtin_amdgcn_s_sleep(1); \
    if ((++_sp & 255u) == 0u) { if (xb_ld(&(bar)[XB_TMO])) break; if (_sp > XB_SPIN_CAP) { atomicAdd(&(bar)[XB_TMO], 1u); break; } } } } while (0)
struct XcdBarrier { unsigned* bar; unsigned x; volatile PG8_LAS unsigned* st; };
__device__ __forceinline__ XcdBarrier xcd_barrier_post(unsigned* bar, volatile PG8_LAS unsigned* st) {
    XcdBarrier b; b.bar = bar; b.x = xb_xcc_id(); b.st = st;
    if (threadIdx.x == 0) (void)xb_add(&bar[XB_XCNT(b.x)], 1u);
    return b;
}
__device__ __forceinline__ void xcd_barrier_complete(unsigned* bar, unsigned x, unsigned& nloc, unsigned& nx) {
    const unsigned G = gridDim.x * gridDim.y * gridDim.z;
    unsigned sum, cnt, mine, sp = 0u;
    for (;;) {
        sum = 0u; cnt = 0u; mine = 0u;
#pragma unroll
        for (unsigned j = 0; j < 16; ++j) { const unsigned c = xb_ld(&bar[XB_XCNT(j)]); sum += c; cnt += (c > 0u) ? 1u : 0u; mine = (j == x) ? c : mine; }
        if (sum == G) break;
        __builtin_amdgcn_s_sleep(1);
        if ((++sp & 255u) == 0u) { if (xb_ld(&bar[XB_TMO])) break; if (sp > XB_SPIN_CAP) { atomicAdd(&bar[XB_TMO], 1u); break; } }
    }
    nloc = mine > 0u ? mine : 1u; nx = cnt > 0u ? cnt : 1u;
}
__device__ __forceinline__ void xcd_barrier(const XcdBarrier& b) {
    asm volatile("s_waitcnt vmcnt(0)" ::: "memory");
    __syncthreads();
    if (threadIdx.x == 0) {
        unsigned* bar = b.bar;
        __builtin_amdgcn_s_waitcnt(0);
        unsigned nloc = b.st[0], nx = b.st[1];
        if (nloc == 0u) { xcd_barrier_complete(bar, b.x, nloc, nx); b.st[0] = nloc; b.st[1] = nx; }
        const unsigned old = xb_add(&bar[XB_XSUB(b.x)], 1u);
        const unsigned gen = old / nloc;
        if (old + 1u == (gen + 1u) * nloc) {
            __builtin_amdgcn_fence(__ATOMIC_RELEASE, "agent");
            asm volatile("s_waitcnt vmcnt(0)" ::: "memory");
            const unsigned og = xb_add(&bar[XB_TOP], 1u);
            const unsigned tg = og / nx;
            if (og + 1u != (tg + 1u) * nx) XB_SPIN(xb_ld(&bar[XB_TOP]) < (tg + 1u) * nx, bar);
            __builtin_amdgcn_fence(__ATOMIC_ACQUIRE, "agent");
            xb_add(&bar[XB_XGEN(b.x)], 1u);
            asm volatile("s_waitcnt vmcnt(0)" ::: "memory");
        } else {
            XB_SPIN(xb_ld(&bar[XB_XGEN(b.x)]) == gen, bar);
            __builtin_amdgcn_fence(__ATOMIC_ACQUIRE, "agent");
            asm volatile("s_waitcnt vmcnt(0)" ::: "memory");
        }
    }
    __syncthreads();
}

#ifndef REPEAT_MASK
#define REPEAT_MASK 0
#endif
#ifndef SYNC_REP
#define SYNC_REP 1
#endif
#define REPN(ty) (((REPEAT_MASK >> (ty)) & 1) ? 2 : 1)
#define RUN(ty, ...) do { for (int rep_ = 0; rep_ < REPN(ty); ++rep_) { int dry = rep_; asm volatile("" : "+s"(dry)); __VA_ARGS__ } } while (0)
#define GSYNC() do { for (int sr_ = 0; sr_ < SYNC_REP; ++sr_) xcd_barrier(xbar); } while (0)
__global__ void __launch_bounds__(NT) mega(Params p) {
    extern __shared__ __attribute__((aligned(16))) unsigned char lds[];
    if (threadIdx.x < 2) ((volatile PG8_LAS unsigned*)((PG8_LAS unsigned char*)lds + 143360))[threadIdx.x] = 0u;
    __syncthreads();
    const XcdBarrier xbar = xcd_barrier_post((unsigned*)p.ws, (volatile PG8_LAS unsigned*)((PG8_LAS unsigned char*)lds + 143360));
    constexpr size_t SEG = (size_t)(WS_B1 - WS_B0) / 2;

    RUN(0, {
        WSL(ws);
#ifndef PREP
#define PREP 0
#endif
        init_rows(p); if (PREP & 1) init_rows(p);
        cvt_wvb(p);
        cvt_wxqn(p);
        conv_sguw(p);
        for (int pr_ = 0; pr_ < ((PREP & 4) ? 2 : 1); ++pr_) {
        int tc = 0;
        for (int l = 0; l < 4; ++l) conv_job(lds, p.in[26] + (size_t)l * 1024 * 2048, 2048, 0, 2048, 1024, PBF(ws, WS_WKVT) + (size_t)l * 2048 * 1024, nullptr, 1.0f, tc);
        conv_inproj(lds, p, 0, tc);
        for (int ig = 0; ig < 8; ++ig) conv_job(lds, p.in[4] + (size_t)ig * 256 * 256, 256, 0, 256, 256, PBF(ws, WS_PWT) + (size_t)ig * 256 * 256, nullptr, 1.0f, tc);
        for (int i = 0; i < 2; ++i) conv_job(lds, p.in[6] + (size_t)i * 2048 * 1024, 1024, 0, 1024, 2048, PBF(ws, WS_WOAB) + (size_t)i * 1024 * 2048, nullptr, 1.0f, tc);
        for (int i = 0; i < 2; ++i) conv_job(lds, p.in[23] + (size_t)i * 1536 * 1024, 1024, 0, 1024, 1536, PBF(ws, WS_WOCD) + (size_t)i * 1024 * 1536, nullptr, 1.0f, tc);
        for (int l = 0; l < 4; ++l) conv_job(lds, p.in[27] + (size_t)l * 1024 * 1024, 1024, 0, 1024, 1024, PBF(ws, WS_WXO) + (size_t)l * 1024 * 1024, nullptr, 1.0f, tc);
        for (int i = 0; i < 2; ++i)
            for (int j = 0; j < 4; ++j) {
                conv_job(lds, p.in[21] + (size_t)i * 512 * 512, 512, 128 * j, 128, 512, PBF(ws, WS_GLU) + (size_t)i * 1024 * 512 + (size_t)(256 * j) * 512, nullptr, 1.0f, tc);
                conv_job(lds, p.in[22] + (size_t)i * 512 * 512, 512, 128 * j, 128, 512, PBF(ws, WS_GLU) + (size_t)i * 1024 * 512 + (size_t)(256 * j + 128) * 512, nullptr, 1.0f, tc);
            }
        }
        (void)dry;
    });
    GSYNC();
    RUN(1, {
        WSL(ws);
        for (int ig = 0; ig < 8; ++ig) { const int vcf = (int)blockIdx.x - 4 * ig;
            EpiFold E{PBF(ws, WS_WUT) + (size_t)(ig >> 2) * 1024 * WIN_LD + (size_t)(ig & 3) * 256 * WIN_LD, p.in[5] + (ig >> 2) * 1024 + (ig & 3) * 256};
            run_gemm<1>(lds, PBF(ws, WS_PWT) + (size_t)ig * 256 * 256, PBF(ws, WS_PWT) + (size_t)ig * 256 * 256, 256, PBF(ws, WS_WVB) + (size_t)ig * 1024 * 256, 256, 1024, 256, E, 1 << 20, 0, 1 << 20, 0, 4, (vcf >= 0 && vcf < 4) ? vcf : -1, 256); }
        const int hg = (int)gridDim.x >> 1;
        { EpiProj E{PBF(ws, WS_KVX), (size_t)MM * 1024, nullptr, 0u, nullptr, -1, 0, 1024, nullptr}; run_gemm<F_KV>(lds, PBF(ws, WS_MEMNB), PBF(ws, WS_MEMNB), 1024, PBF(ws, WS_WKVT), MM, 4096, 1024, E, 1 << 20, 0, 4, 4, hg, (int)blockIdx.x < hg ? (int)blockIdx.x : -1); }
        { EpiProj E{PBF(ws, WS_VTX), (size_t)MM * 1024, nullptr, 0u, nullptr, -1, 0, 1024, nullptr}; run_gemm<F_KV>(lds, PBF(ws, WS_MEMNB), PBF(ws, WS_MEMNB), 1024, PBF(ws, WS_WKVT) + (size_t)1024 * 1024, MM, 4096, 1024, E, 1 << 20, 0, 4, 4, hg, (int)blockIdx.x >= hg ? (int)blockIdx.x - hg : -1); }
        (void)dry;
    });
    GSYNC();

#pragma unroll 1
    for (int l = 0; l < 4; ++l) {
        const int i = l >> 1;
        if ((l & 1) == 0) {
            RUN(2, {
            { WSL(ws); EpiProj E{PBF(ws, WS_B0), SEG, PF32(ws, WS_RS), 0u, nullptr, -1, 1, 1024, nullptr, 7u, (bf16_t*)p.out};
              run_gemm<F_G1, EpiProj, false>(lds, PBF(ws, WS_XB), PBF(ws, WS_XB), 1024, PBF(ws, WS_WIN), M, 4096, 1024, E, 1 << 20, 0, 1 << 20, 0, 0, 0, 1024, WIN_LD, PBF(ws, WS_WUT) + (size_t)i * 1024 * WIN_LD, 12); }
            (void)dry; });
            GSYNC();
            RUN(3, { dil_attn_mfma(lds, p, dry); });
            GSYNC();
            RUN(4, { WSL(ws); EpiGates E{EpiGateA{PBF(ws, WS_B0), PF32(ws, WS_RS), dry}, EpiGateB{PBF(ws, WS_B1), PBF(ws, WS_B3), PF32(ws, WS_RS), dry}};
                     run_gemm<F_GG>(lds, PBF(ws, WS_XB), PBF(ws, WS_XB), 1024, PBF(ws, WS_WIN) + (size_t)3072 * WIN_LD, M, 2048, 1024, E, 1 << 20, 0, 1 << 20, 0, 0, 0, 1024, WIN_LD); });
            GSYNC();
            RUN(5, { WSL(ws); EpiResid E{PBF(ws, WS_XB), PF32(ws, WS_RS), lds + 131072, dry}; run_gemm<F_G2>(lds, PBF(ws, WS_B0), PBF(ws, WS_B1), 1024, PBF(ws, WS_WOAB) + (size_t)i * 1024 * 2048, M, 1024, 2048, E); });
        } else {
            RUN(6, { WSL(ws); EpiProj E{PBF(ws, WS_B0), SEG, PF32(ws, WS_RS), (3u << 4) | (2u << 6), PF32(ws, WS_LNS), 1, 1, 1024, lds + 131072}; run_gemm<F_G1O, EpiProj, false>(lds, PBF(ws, WS_XB), PBF(ws, WS_XB), 1024, PBF(ws, WS_WIN), M, 4096, 1024, E, 1 << 20, 0, 1 << 20, 0, 0, 0, 1024, WIN_LD); (void)dry; });
            GSYNC();
            RUN(7, { s5_mfma(lds, p, i, dry); __syncthreads(); });
            RUN(13, { sgu_mfma(lds, p, i, dry); __syncthreads(); });
            GSYNC();
            RUN(8, { WSL(ws); EpiGlu E{PBF(ws, WS_B3) + 512, dry}; run_gemm<F_GLU>(lds, PBF(ws, WS_B3), PBF(ws, WS_B3), 512, PBF(ws, WS_GLU) + (size_t)i * 1024 * 512, M, 1024, 512, E); });
            GSYNC();
            RUN(9, { WSL(ws); EpiResid E{PBF(ws, WS_XB), PF32(ws, WS_RS), lds + 131072, dry}; run_gemm<F_G2O>(lds, PBF(ws, WS_B0), PBF(ws, WS_B3) + 512, 1024, PBF(ws, WS_WOCD) + (size_t)i * 1024 * 1536, M, 1024, 1536, E); });
        }
        RUN(10, { xattn_prep(lds, p, l); (void)dry; });
        GSYNC();
        RUN(11, {
            { int tc = 0; if (l < 3) conv_inproj(lds, p, l + 1, tc); }
            __syncthreads();
            xattn_s(lds, p);
            (void)dry; });
        GSYNC();
        RUN(12, { xattn_o(lds, p, dry); });
        GSYNC();
    }
    final_norm(p);
}

extern "C" void kernel_launch(void* const* d_in, const int* in_sizes, int n_in, void* d_out, int out_size, void* d_ws, size_t ws_size, hipStream_t stream) {
    static int grid = 0;
    if (grid == 0) {
        if (n_in != 30 || out_size != M * DM || ws_size < WS_END) { fprintf(stderr, "kernel_launch: unexpected shapes n_in %d out %d ws %zu\n", n_in, out_size, ws_size); grid = -1; return; }
        int dev = 0, cus = 0, per_cu = 0;
        (void)hipGetDevice(&dev);
        (void)hipDeviceGetAttribute(&cus, hipDeviceAttributeMultiprocessorCount, dev);
        (void)hipFuncSetAttribute((const void*)mega, hipFuncAttributeMaxDynamicSharedMemorySize, LDS_BYTES);
        (void)hipOccupancyMaxActiveBlocksPerMultiprocessor(&per_cu, (const void*)mega, NT, LDS_BYTES);
        if (per_cu < 1) per_cu = 1;
        grid = cus * per_cu;
    }
    if (grid < 0) return;
    Params p{};
    for (int i = 0; i < 30; ++i) p.in[i] = (const float*)d_in[i];
    p.out = (float*)d_out; p.ws = (unsigned char*)d_ws;
    (void)hipMemsetAsync(d_ws, 0, 16384, stream);
    void* args[] = {&p};
    hipError_t e = hipLaunchCooperativeKernel((void*)mega, dim3(grid), dim3(NT), args, LDS_BYTES, stream);
    if (e != hipSuccess) fprintf(stderr, "cooperative launch failed: %s (grid %d)\n", hipGetErrorString(e), grid);
}
```

```cpp
#include <hip/hip_runtime.h>
#include <hip/hip_cooperative_groups.h>
#include <cstdio>
#include <cstdint>
namespace cg = cooperative_groups;

typedef unsigned short bf16_t;
typedef float f32x4 __attribute__((ext_vector_type(4)));
typedef unsigned u32x4 __attribute__((ext_vector_type(4)));
typedef unsigned u32x2 __attribute__((ext_vector_type(2)));

constexpr int BATCH = 8, SEQ = 2048, DM = 1024, M = BATCH * SEQ, MEML = 256, MM = BATCH * MEML;
constexpr float EPS = 1e-6f;
constexpr int NT = 512;
constexpr int LDS_BYTES = 147456;

constexpr size_t MiB = 1u << 20;
constexpr size_t WS_RS = 1 * MiB;
constexpr size_t WS_LNS = 2 * MiB;
constexpr size_t WS_SGUW = 3 * MiB;
constexpr size_t WS_XB = 8 * MiB;
constexpr size_t WS_B0 = 40 * MiB, WS_B1 = 72 * MiB, WS_B2 = 104 * MiB, WS_B3 = 136 * MiB;
constexpr size_t WS_KVX = 168 * MiB;
constexpr size_t WS_VTX = 184 * MiB;
constexpr int WIN_LD = 1088;
constexpr size_t WS_WIN = 200 * MiB;
constexpr size_t WS_WUT = 248 * MiB;
constexpr size_t WS_WOAB = 216 * MiB;
constexpr size_t WS_WOCD = 224 * MiB;
constexpr size_t WS_WXQ = 230 * MiB;
constexpr size_t WS_WXO = 238 * MiB;
constexpr size_t WS_GLU = 246 * MiB;
constexpr size_t WS_END = 253 * MiB;
constexpr size_t WS_WKVT = WS_B0;
constexpr size_t WS_MEMNB = WS_B1;
constexpr size_t WS_PWT = WS_B2;
constexpr size_t WS_WVB = WS_B2 + 2 * MiB;

struct Params { const float* in[30]; float* out; unsigned char* ws; };

#define GAS __attribute__((address_space(1)))
template <class T> __device__ __forceinline__ T gld(const void* p) { return *(const GAS T*)p; }
template <class T> __device__ __forceinline__ void gst(void* p, T v) { *(GAS T*)p = v; }
#ifndef WT_STORES
#define WT_STORES 1
#endif
__device__ __forceinline__ void wst8(void* base, size_t off, u32x2 v) {
#if WT_STORES
    const __amdgpu_buffer_rsrc_t r = __builtin_amdgcn_make_buffer_rsrc(base, (short)0, 0x7fffffff, 0x00020000);
    __builtin_amdgcn_raw_buffer_store_b64(v, r, (unsigned)off, 0, 16);
#else
    *(GAS u32x2*)((unsigned char*)base + off) = v;
#endif
}
__device__ __forceinline__ void wst4(void* base, size_t off, float v) {
    const __amdgpu_buffer_rsrc_t r = __builtin_amdgcn_make_buffer_rsrc(base, (short)0, 0x7fffffff, 0x00020000);
    __builtin_amdgcn_raw_buffer_store_b32(__float_as_uint(v), r, (unsigned)off, 0, 16);
}
__device__ __forceinline__ void wst16(void* base, size_t off, u32x4 v) {
#if WT_STORES
    const __amdgpu_buffer_rsrc_t r = __builtin_amdgcn_make_buffer_rsrc(base, (short)0, 0x7fffffff, 0x00020000);
    __builtin_amdgcn_raw_buffer_store_b128(v, r, (unsigned)off, 0, 16);
#else
    *(GAS u32x4*)((unsigned char*)base + off) = v;
#endif
}
__device__ __forceinline__ void st16(void* base, size_t off, u32x4 v, const bool wt) { if (wt) wst16(base, off, v); else *(GAS u32x4*)((unsigned char*)base + off) = v; }
__device__ __forceinline__ int tid_l() { int t = threadIdx.x; asm volatile("" : "+v"(t)); return t; }
__device__ __forceinline__ int bid_l() { int b = blockIdx.x; asm volatile("" : "+s"(b)); return b; }
__device__ __forceinline__ float quad_rows_sum(float v) {
    { const auto r = __builtin_amdgcn_permlane16_swap(__float_as_uint(v), __float_as_uint(v), false, false); v = __uint_as_float(r[0]) + __uint_as_float(r[1]); }
    { const auto r = __builtin_amdgcn_permlane32_swap(__float_as_uint(v), __float_as_uint(v), false, false); v = __uint_as_float(r[0]) + __uint_as_float(r[1]); }
    return v;
}
__device__ __forceinline__ float quad_rows_max(float v) {
    { const auto r = __builtin_amdgcn_permlane16_swap(__float_as_uint(v), __float_as_uint(v), false, false); v = fmaxf(__uint_as_float(r[0]), __uint_as_float(r[1])); }
    { const auto r = __builtin_amdgcn_permlane32_swap(__float_as_uint(v), __float_as_uint(v), false, false); v = fmaxf(__uint_as_float(r[0]), __uint_as_float(r[1])); }
    return v;
}
__device__ __forceinline__ float bf2f(bf16_t v) { return __uint_as_float(((unsigned)v) << 16); }
__device__ __forceinline__ bf16_t f2bf(float f) { unsigned u = __float_as_uint(f); u += 0x7fffu + ((u >> 16) & 1u); return (bf16_t)(u >> 16); }
__device__ __forceinline__ float wave_sum(float v) {
#pragma unroll
    for (int o = 1; o < 64; o <<= 1) v += __shfl_xor(v, o);
    return v;
}
__device__ __forceinline__ float wave_max(float v) {
#pragma unroll
    for (int o = 1; o < 64; o <<= 1) v = fmaxf(v, __shfl_xor(v, o));
    return v;
}
__device__ __forceinline__ float half_sum32(float v) {
#pragma unroll
    for (int o = 1; o < 32; o <<= 1) v += __shfl_xor(v, o);
    return v;
}
__device__ __forceinline__ float silu_f(float x) { return x / (1.0f + expf(-x)); }
__device__ __forceinline__ float sigmoid_f(float x) { return 1.0f / (1.0f + expf(-x)); }
__device__ __forceinline__ float gelu_tanh_f(float x) { return 0.5f * x * (1.0f + tanhf(0.7978845608028654f * (x + 0.044715f * x * x * x))); }
__device__ __forceinline__ float rstd_of(const float* RS, int row) { return rsqrtf(((gld<float>(RS + row) + gld<float>(RS + M + row)) + (gld<float>(RS + 2 * M + row) + gld<float>(RS + 3 * M + row))) * (1.0f / DM) + EPS); }
__device__ __forceinline__ float fsilu(float x) { return x * __builtin_amdgcn_rcpf(1.0f + __builtin_amdgcn_exp2f(-1.4426950408889634f * x)); }
__device__ __forceinline__ float fsigmoid(float x) { return __builtin_amdgcn_rcpf(1.0f + __builtin_amdgcn_exp2f(-1.4426950408889634f * x)); }
typedef float cvt_f32x2 __attribute__((ext_vector_type(2)));
typedef __bf16 cvt_bf16x2 __attribute__((ext_vector_type(2)));
__device__ __forceinline__ unsigned cvt_pk_bf16(float lo, float hi) { const cvt_f32x2 v = {lo, hi}; return __builtin_bit_cast(unsigned, __builtin_convertvector(v, cvt_bf16x2)); }
__device__ __forceinline__ float bflo(unsigned w) { return __uint_as_float(w << 16); }
__device__ __forceinline__ float bfhi(unsigned w) { return __uint_as_float(w & 0xffff0000u); }

__device__ __forceinline__ void conv_job(unsigned char* lds, const float* src, int ldn, int n0, int Nrows, int K, bf16_t* dst, const float* rs, float scale, int& tc, int ldd = 0, const bool wt = true) {
    if (ldd == 0) ldd = K;
    const int tid = tid_l(), lane = tid & 63, wid = tid >> 6;
    float* T = (float*)lds + wid * (64 * 65);
    const int nnt = Nrows / 64, ntile = (K / 64) * nnt, gw = blockIdx.x * (NT / 64) + wid, ngw = gridDim.x * (NT / 64);
    const int r4 = lane >> 4, c16 = lane & 15;
    for (int t = ((gw - tc) % ngw + ngw) % ngw; t < ntile; t += ngw) {
        const int kt = t / nnt, nt = t % nnt, k0 = kt * 64, nn0 = nt * 64;
        f32x4 v[16];
#pragma unroll
        for (int i = 0; i < 16; ++i) v[i] = gld<f32x4>(src + (size_t)(k0 + r4 + 4 * i) * ldn + n0 + nn0 + 4 * c16);
#pragma unroll
        for (int i = 0; i < 16; ++i) { const int kk = r4 + 4 * i; const float sc = rs ? scale * gld<float>(rs + k0 + kk) : scale; float* tp = T + kk * 65 + 4 * c16;
            tp[0] = v[i].x * sc; tp[1] = v[i].y * sc; tp[2] = v[i].z * sc; tp[3] = v[i].w * sc; }
        __builtin_amdgcn_wave_barrier();
#pragma unroll
        for (int j = 0; j < 8; ++j) { const int nn = (lane >> 3) + 8 * j, kc = (lane & 7) * 8; const float* tp = T + kc * 65 + nn; u32x4 o;
            o.x = cvt_pk_bf16(tp[0], tp[65]); o.y = cvt_pk_bf16(tp[2 * 65], tp[3 * 65]); o.z = cvt_pk_bf16(tp[4 * 65], tp[5 * 65]); o.w = cvt_pk_bf16(tp[6 * 65], tp[7 * 65]);
            st16(dst, ((size_t)(nn0 + nn) * ldd + k0 + kc) * 2, o, wt); }
        __builtin_amdgcn_wave_barrier();
    }
    tc += ntile;
}

__device__ __forceinline__ void conv_inproj(unsigned char* lds, const Params& p, int l, int& tc, const bool wt = true) {
    unsigned char* wsl = p.ws; asm volatile("" : "+s"(wsl));
    bf16_t* W = (bf16_t*)(wsl + WS_WIN);
    const int i = l >> 1;
    if ((l & 1) == 0) {
        const float* src = p.in[3] + (size_t)i * 1024 * 6144; const float* g = p.in[2] + i * 1024;
        conv_job(lds, src, 6144, 0, 1024, 1024, W, g, 0.125f * 1.4426950408889634f, tc, WIN_LD, wt);
        conv_job(lds, src, 6144, 1024, 3072, 1024, W + (size_t)1024 * WIN_LD, g, 1.0f, tc, WIN_LD, wt);
        conv_job(lds, src, 6144, 5120, 1024, 1024, W + (size_t)4096 * WIN_LD, g, 1.0f, tc, WIN_LD, wt);
    } else {
        const float* src = p.in[8] + (size_t)i * 1024 * 4096; const float* g = p.in[7] + i * 1024;
        conv_job(lds, src, 4096, 0, 4096, 1024, W, g, 1.0f, tc, WIN_LD, wt);
    }
}

template <class Epi>
__device__ __forceinline__ void ngemm(unsigned char* lds, const bf16_t* A1, const bf16_t* A2, int K1, int lda, const bf16_t* Bt, int Mrows, int N, int K, const Epi& E) {
    float* As = (float*)lds;
    float* Bs = As + 32 * 68;
    const int tid = tid_l(), tx = tid & 31, ty = tid >> 5;
    const int ntm = Mrows / 64, ntn = N / 256;
    for (int tile = blockIdx.x; tile < ntm * ntn; tile += gridDim.x) {
        const int tm = tile % ntm, tn = tile / ntm;
        float acc[4][8];
#pragma unroll
        for (int r = 0; r < 4; ++r)
#pragma unroll
            for (int j = 0; j < 8; ++j) acc[r][j] = 0.f;
        for (int k0 = 0; k0 < K; k0 += 32) {
            { const int r = tid >> 3, kc = (tid & 7) * 4;
              const bf16_t* ap = (k0 < K1) ? (A1 + (size_t)(tm * 64 + r) * lda + k0 + kc) : (A2 + (size_t)(tm * 64 + r) * lda + (k0 - K1) + kc);
              const u32x2 w = *(const u32x2*)ap;
              As[(kc + 0) * 68 + r] = __uint_as_float(w.x << 16); As[(kc + 1) * 68 + r] = __uint_as_float(w.x & 0xffff0000u);
              As[(kc + 2) * 68 + r] = __uint_as_float(w.y << 16); As[(kc + 3) * 68 + r] = __uint_as_float(w.y & 0xffff0000u); }
            { const int n = tid >> 1, kc = (tid & 1) * 16;
              const bf16_t* bp = Bt + (size_t)(tn * 256 + n) * K + k0 + kc;
#pragma unroll
              for (int h = 0; h < 2; ++h) { const u32x4 w = *(const u32x4*)(bp + 8 * h); const int kk = kc + 8 * h;
                  Bs[(kk + 0) * 260 + n] = __uint_as_float(w.x << 16); Bs[(kk + 1) * 260 + n] = __uint_as_float(w.x & 0xffff0000u);
                  Bs[(kk + 2) * 260 + n] = __uint_as_float(w.y << 16); Bs[(kk + 3) * 260 + n] = __uint_as_float(w.y & 0xffff0000u);
                  Bs[(kk + 4) * 260 + n] = __uint_as_float(w.z << 16); Bs[(kk + 5) * 260 + n] = __uint_as_float(w.z & 0xffff0000u);
                  Bs[(kk + 6) * 260 + n] = __uint_as_float(w.w << 16); Bs[(kk + 7) * 260 + n] = __uint_as_float(w.w & 0xffff0000u); } }
            __syncthreads();
#pragma unroll 8
            for (int k = 0; k < 32; ++k) {
                const f32x4 a = *(const f32x4*)(As + k * 68 + ty * 4);
                float b[8];
#pragma unroll
                for (int j = 0; j < 8; ++j) b[j] = Bs[k * 260 + tx + 32 * j];
#pragma unroll
                for (int j = 0; j < 8; ++j) { acc[0][j] += a.x * b[j]; acc[1][j] += a.y * b[j]; acc[2][j] += a.z * b[j]; acc[3][j] += a.w * b[j]; }
            }
            __syncthreads();
        }
#pragma unroll
        for (int r = 0; r < 4; ++r) E.row(tm * 64 + ty * 4 + r, tn * 256 + tx, acc[r]);
    }
}

namespace pg8 {
#define PG8_LAS __attribute__((address_space(3)))
typedef short bf16x8 __attribute__((ext_vector_type(8)));
constexpr int BM = 256, BK = 64, HALF = 128, HTB = HALF * BK * 2, STAGE_BYTES = 8 * HTB, NXCD = 8, WGM = 8;
__host__ __device__ __forceinline__ int lds_byte(int r, int c) { const int st = (r >> 4) * 2 + (c >> 5), rr = r & 15, cc = c & 31, ob = rr * 64 + cc * 2; return st * 1024 + (ob ^ (((ob >> 9) & 1) << 5)); }
__host__ __device__ __forceinline__ void stage_rc(int b, int& R, int& C) { const int st = b / 1024, sb = b % 1024, swz = sb ^ (((sb >> 9) & 1) << 5); R = (st >> 1) * 16 + swz / 64; C = (st & 1) * 32 + (swz % 64) / 2; }
__host__ __device__ __forceinline__ int perm32(int rho) { const int n = rho >> 4, i = rho & 15; return 8 * (i >> 2) + 4 * n + (i & 3); }
struct Unit { int pm, pn; };
struct Gemm { const bf16_t* A1; const bf16_t* A2; int nt1; int lda; const bf16_t* Bt; int M, N, K; int a_grp, a_skip, b_grp, b_skip; int vG, vc; int ldb; const bf16_t* Bt2; int nsplit; };
struct StaticOrder {
    int nM, nN, nwg, G, c;
    __device__ void init(int M_, int N_, int G_, int c_) { nM = M_ / BM; nN = N_ / BM; nwg = nM * nN; G = G_; c = c_; }
    __device__ bool next(int i, Unit& u) const {
        const long L = (long)i * G + c; if (L >= nwg) return false;
        int wgid = (int)L; { const int q = nwg / NXCD, r = nwg % NXCD, xcd = wgid % NXCD, off = wgid / NXCD; wgid = (xcd < r ? xcd * (q + 1) : r * (q + 1) + (xcd - r) * q) + off; }
        const int nig = WGM * nN, gid = wgid / nig, fm = gid * WGM, gsz = (nM - fm) < WGM ? (nM - fm) : WGM;
        u.pm = fm + ((wgid % nig) % gsz); u.pn = (wgid % nig) / gsz; return true;
    }
};
__device__ __forceinline__ int static_unit(int M_, int N_, int G, int c, int i) {
    const int nM = M_ / BM, nN = N_ / BM, nwg = nM * nN; const long L = (long)i * G + c; if (L >= nwg) return -1;
    int wgid = (int)L; { const int q = nwg / NXCD, r = nwg % NXCD, xcd = wgid % NXCD, off = wgid / NXCD; wgid = (xcd < r ? xcd * (q + 1) : r * (q + 1) + (xcd - r) * q) + off; }
    const int nig = WGM * nN, gid = wgid / nig, fm = gid * WGM, gsz = (nM - fm) < WGM ? (nM - fm) : WGM;
    return (fm + ((wgid % nig) % gsz)) * 65536 + (wgid % nig) / gsz;
}
template <class Epi, bool TAIL = true>
__device__ __forceinline__ void gemm_phase(PG8_LAS unsigned char* lds, const Gemm g, const Epi& E) {
    const int tid = tid_l(), wid = __builtin_amdgcn_readfirstlane(tid >> 6), lane = tid & 63, wr = wid >> 2, wc = wid & 3, fr = lane & 15, fq = lane >> 4;
    if (g.vG > 0 && g.vc < 0) return;
    StaticOrder S; S.init(g.M, g.N, g.vG > 0 ? g.vG : (int)gridDim.x, g.vG > 0 ? g.vc : bid_l());
    const int K = g.K, nt = K / BK, nt1 = g.nt1;
    unsigned voffA[2], voffB[2];
#pragma unroll
    for (int i = 0; i < 2; ++i) { int R, C; stage_rc(tid * 16 + i * 8192, R, C); const int Rb = (R & ~31) + perm32(R & 31);
        voffA[i] = (unsigned)(R * g.lda + C) * 2u; voffB[i] = (unsigned)(Rb * g.ldb + C) * 2u; }
    const size_t kstep = (size_t)(BK * 2);
    const size_t hstepA = (size_t)HALF * g.lda * 2, tstepA = 2 * hstepA;
    const size_t hstepB = (size_t)HALF * g.ldb * 2, tstepB = 2 * hstepB;
    const unsigned ldsw = (unsigned)wid * 1024u;
    const int aoff = lds_byte(wr * 64 + fr, fq * 8), boff = lds_byte(wc * 32 + fr, fq * 8);
#define PG8_SA(b, h) (((b) * 2 + (h)) * HTB)
#define PG8_SB(b, h) ((4 + (b) * 2 + (h)) * HTB)
#define PG8_STAGE(bufoff, gbase, voff) do { _Pragma("unroll") for (int _i = 0; _i < 2; ++_i) \
        __builtin_amdgcn_global_load_lds((const unsigned*)((const char*)(gbase) + (voff)[_i]), (PG8_LAS unsigned*)(lds + (bufoff) + ldsw + _i * 8192), 16, 0, 0); } while (0)
#define PG8_LDA(dst, b, h) do { _Pragma("unroll") for (int m = 0; m < 4; ++m) _Pragma("unroll") for (int k = 0; k < 2; ++k) dst[m][k] = *(const PG8_LAS bf16x8*)(lds + PG8_SA(b, h) + aoff + m * 2048 + k * 1024); } while (0)
#define PG8_LDB(dst, b, h) do { _Pragma("unroll") for (int n = 0; n < 2; ++n) _Pragma("unroll") for (int k = 0; k < 2; ++k) dst[n][k] = *(const PG8_LAS bf16x8*)(lds + PG8_SB(b, h) + boff + n * 2048 + k * 1024); } while (0)
#define PG8_MMA(ai, bj, At, Bt) do { __builtin_amdgcn_s_setprio(1); _Pragma("unroll") for (int m = 0; m < 4; ++m) _Pragma("unroll") for (int n = 0; n < 2; ++n) _Pragma("unroll") for (int k = 0; k < 2; ++k) \
        acc[ai][bj][m][n] = __builtin_amdgcn_mfma_f32_16x16x32_bf16(Bt[n][k], At[m][k], acc[ai][bj][m][n], 0, 0, 0); __builtin_amdgcn_s_setprio(0); } while (0)
#define PG8_WAIT_V(n) asm volatile("s_waitcnt vmcnt(" #n ")" ::: "memory")
#define PG8_WAIT_L(n) asm volatile("s_waitcnt lgkmcnt(" #n ")" ::: "memory")
#define PG8_BAR __builtin_amdgcn_s_barrier()
#define PG8_SCHED __builtin_amdgcn_sched_barrier(0)
    Unit cur, nxt; int ui = 0;
    if (!S.next(0, cur)) return;
    PG8_LAS float* rtab = (PG8_LAS float*)(lds + 139264);
    if constexpr (Epi::HAS_ROWSCALE) {
        Unit tu;
        for (int i = 0; i < 4 && S.next(i, tu); ++i) if (tid < 256) rtab[i * 256 + tid] = E.row_scale(tu.pm * 256 + tid);
        asm volatile("s_waitcnt vmcnt(0) lgkmcnt(0)" ::: "memory"); __builtin_amdgcn_s_barrier();
    }
    f32x4 acc[2][2][4][2];
#pragma unroll
    for (int a = 0; a < 2; ++a)
#pragma unroll
        for (int b = 0; b < 2; ++b)
#pragma unroll
            for (int m = 0; m < 4; ++m)
#pragma unroll
                for (int n = 0; n < 2; ++n) acc[a][b][m][n] = (f32x4){0.f, 0.f, 0.f, 0.f};
    bf16x8 At[4][2], B0[2][2], B1[2][2];
#define PG8_TA(pm_) ((size_t)((pm_) + ((pm_) / g.a_grp) * g.a_skip) * tstepA)
#define PG8_TB(pn_) ((size_t)((pn_) + ((pn_) / g.b_grp) * g.b_skip) * tstepB)
#define PG8_BP(pn_) ((pn_) < g.nsplit ? (const char*)g.Bt + PG8_TB(pn_) : (const char*)g.Bt2 + PG8_TB((pn_) - g.nsplit))
    const char* cA1 = (const char*)g.A1 + PG8_TA(cur.pm); const char* cA2 = (const char*)g.A2 + PG8_TA(cur.pm) - (size_t)nt1 * kstep; const char* cB = PG8_BP(cur.pn);
    PG8_STAGE(PG8_SB(0, 0), cB, voffB); PG8_STAGE(PG8_SB(0, 1), cB + hstepB, voffB); PG8_STAGE(PG8_SA(0, 0), cA1, voffA); PG8_STAGE(PG8_SA(0, 1), cA1 + hstepA, voffA);
    if (wr == 1) PG8_BAR;
    PG8_WAIT_V(2); PG8_BAR;
    PG8_STAGE(PG8_SB(1, 0), cB + kstep, voffB); PG8_STAGE(PG8_SA(1, 0), cA1 + kstep, voffA); PG8_STAGE(PG8_SB(1, 1), cB + hstepB + kstep, voffB);
    PG8_WAIT_V(6); PG8_BAR;
    for (;;) {
        const bool has_next = S.next(ui + 1, nxt);
        const char* nA1 = has_next ? (const char*)g.A1 + PG8_TA(nxt.pm) : cA1; const char* nA2 = has_next ? (const char*)g.A2 + PG8_TA(nxt.pm) - (size_t)nt1 * kstep : cA2;
        const char* nB = has_next ? PG8_BP(nxt.pn) : cB;
        for (int t = 0; t < nt; t += 2) {
            const bool last = (t == nt - 2);
            const char* a1 = ((t + 1 < nt1) ? cA1 : cA2) + (size_t)(t + 1) * kstep;
            const char* a2 = last ? nA1 : ((t + 2 < nt1) ? cA1 : cA2) + (size_t)(t + 2) * kstep; const char* b2 = last ? nB : cB + (size_t)(t + 2) * kstep;
            const char* a3 = a2 + kstep; const char* b3 = b2 + kstep;
            const bool tail = TAIL && last && !has_next;
            PG8_LDB(B0, 0, 0); PG8_LDB(B1, 0, 1); PG8_SCHED; PG8_LDA(At, 0, 0); PG8_STAGE(PG8_SA(1, 1), a1 + hstepA, voffA);
            PG8_WAIT_V(8); PG8_WAIT_L(0); PG8_BAR; PG8_MMA(0, 0, At, B0); PG8_MMA(0, 1, At, B1); PG8_BAR; PG8_SCHED;
            PG8_LDA(At, 0, 1);
            if (!tail) { PG8_STAGE(PG8_SB(0, 0), b2, voffB); PG8_STAGE(PG8_SB(0, 1), b2 + hstepB, voffB); PG8_STAGE(PG8_SA(0, 0), a2, voffA); PG8_WAIT_V(8); } else { PG8_WAIT_V(2); }
            PG8_WAIT_L(0); PG8_BAR; PG8_MMA(1, 0, At, B0); PG8_MMA(1, 1, At, B1); PG8_BAR; PG8_SCHED;
            PG8_LDB(B0, 1, 0); PG8_LDB(B1, 1, 1); PG8_SCHED; PG8_LDA(At, 1, 0);
            if (!tail) { PG8_STAGE(PG8_SA(0, 1), a2 + hstepA, voffA); PG8_WAIT_V(8); } else { PG8_WAIT_V(0); }
            PG8_WAIT_L(0); PG8_BAR; PG8_MMA(0, 0, At, B0); PG8_MMA(0, 1, At, B1); PG8_BAR; PG8_SCHED;
            PG8_LDA(At, 1, 1);
            if (!tail) { PG8_STAGE(PG8_SB(1, 0), b3, voffB); PG8_STAGE(PG8_SB(1, 1), b3 + hstepB, voffB); PG8_STAGE(PG8_SA(1, 0), a3, voffA); PG8_WAIT_V(8); }
            PG8_WAIT_L(0); PG8_BAR; PG8_MMA(1, 0, At, B0); PG8_MMA(1, 1, At, B1); PG8_BAR; PG8_SCHED;
        }
        if (wr == 0) PG8_BAR;
#ifndef EPI_REP
#define EPI_REP 1
#endif
        if constexpr (Epi::MUTATES) { E.mut(acc, cur, wr, wc, fr, fq); }
        else if constexpr (Epi::HAS_ROWSCALE) { E.scaled(acc, cur, wr, wc, fr, fq, ui < 4 ? rtab + ui * 256 : (PG8_LAS float*)nullptr, !has_next); }
        else if constexpr (Epi::HAS_FUSED) { if (has_next) E(acc, cur, wr, wc, fr, fq); } else { E(acc, cur, wr, wc, fr, fq); if constexpr (Epi::IDEMPOTENT && EPI_REP > 1) { int er_ = 1; asm volatile("" : "+s"(er_)); if (er_) E(acc, cur, wr, wc, fr, fq); } }
        if (!has_next) break;
#pragma unroll
        for (int a = 0; a < 2; ++a)
#pragma unroll
            for (int b = 0; b < 2; ++b)
#pragma unroll
                for (int m = 0; m < 4; ++m)
#pragma unroll
                    for (int n = 0; n < 2; ++n) acc[a][b][m][n] = (f32x4){0.f, 0.f, 0.f, 0.f};
        cur = nxt; cA1 = nA1; cA2 = nA2; cB = nB; ++ui;
        if (wr == 1) PG8_BAR;
    }
    PG8_WAIT_V(0);
    PG8_BAR;
    if constexpr (Epi::HAS_FUSED) E.fused(acc, cur, wr, wc, fr, fq, lds);
#undef PG8_TA
#undef PG8_TB
#undef PG8_BP
#undef PG8_SA
#undef PG8_SB
#undef PG8_STAGE
#undef PG8_LDA
#undef PG8_LDB
#undef PG8_MMA
#undef PG8_WAIT_V
#undef PG8_WAIT_L
#undef PG8_BAR
#undef PG8_SCHED
}
}
typedef f32x4 AccT[2][2][4][2];

__device__ __forceinline__ u32x4 pack8(const f32x4 a, const f32x4 b) { u32x4 w; w.x = cvt_pk_bf16(a.x, a.y); w.y = cvt_pk_bf16(a.z, a.w); w.z = cvt_pk_bf16(b.x, b.y); w.w = cvt_pk_bf16(b.z, b.w); return w; }
struct EpiProj {
    static constexpr bool MUTATES = false;
    static constexpr bool HAS_ROWSCALE = true;
    static constexpr bool IDEMPOTENT = true;
    static constexpr bool HAS_FUSED = false;
    bf16_t* dst0; size_t seg_stride; const float* RS; unsigned silu_bits; float* LNS; int lns_seg; int use_rstd; int pitch; unsigned char* scr; unsigned hm_bits = 0u; bf16_t* seg0 = nullptr;
    __device__ __forceinline__ void row(int row, int colbase, float (&v)[8]) const {
        const float rs = use_rstd ? rstd_of(RS, row) : 1.0f;
        float s0 = 0.f, q0 = 0.f;
#pragma unroll
        for (int j = 0; j < 8; ++j) {
            const int col = colbase + 32 * j, seg = col >> 10, c = col & 1023;
            float x = v[j] * rs;
            s0 += x; q0 += x * x;
            if ((silu_bits >> (2 * seg + (c >> 9))) & 1u) x = silu_f(x);
            dst0[(size_t)seg * seg_stride + (((hm_bits >> seg) & 1u) ? ((size_t)(((row >> 11) * 16 + (c >> 6)) * 2048 + (row & 2047)) * 64 + (c & 63)) : ((size_t)row * pitch + c))] = f2bf(x);
        }
        if (LNS) {
            const int seg = colbase >> 10;
            if (seg == lns_seg) {
                s0 = half_sum32(s0); q0 = half_sum32(q0);
                if ((threadIdx.x & 31) == 0) { const int slot = (colbase & 1023) >> 8; LNS[(size_t)slot * M + row] = s0; LNS[(size_t)(4 + slot) * M + row] = q0; }
            }
        }
    }
    __device__ __forceinline__ float row_scale(int row) const { return use_rstd ? rstd_of(RS, row) : 1.0f; }
    __device__ __forceinline__ void operator()(const AccT& acc, const pg8::Unit& u, int wr, int wc, int fr, int fq) const { scaled(acc, u, wr, wc, fr, fq, (PG8_LAS float*)nullptr, true); }
    __device__ __forceinline__ void scaled(const AccT& acc, const pg8::Unit& u, int wr, int wc, int fr, int fq, PG8_LAS float* rtab, const bool wt) const {
        const int colt = u.pn * 256, seg = colt >> 10, cb = (colt & 1023) + wc * 32 + 8 * fq, row0 = u.pm * 256 + wr * 64 + fr;
        bf16_t* base = (seg == 0 && seg0) ? seg0 : dst0 + (size_t)seg * seg_stride;
        const bool st = (LNS != nullptr) && (seg == lns_seg);
        const bool act = (silu_bits >> (2 * seg + ((colt & 1023) >> 9))) & 1u;
        const bool hm = (hm_bits >> seg) & 1u;
        PG8_LAS float* P = (PG8_LAS float*)scr;
#pragma unroll
        for (int ai = 0; ai < 2; ++ai)
#pragma unroll
            for (int m = 0; m < 4; ++m) {
                const int row = row0 + ai * 128 + m * 16; const float rs = rtab ? rtab[ai * 128 + wr * 64 + m * 16 + fr] : row_scale(row);
                float s = 0.f, q = 0.f;
#pragma unroll
                for (int bj = 0; bj < 2; ++bj) {
                    f32x4 v0 = acc[ai][bj][m][0] * rs, v1 = acc[ai][bj][m][1] * rs;
                    if (st) { s += (v0.x + v0.y) + (v0.z + v0.w) + (v1.x + v1.y) + (v1.z + v1.w);
                              q += (v0.x * v0.x + v0.y * v0.y) + (v0.z * v0.z + v0.w * v0.w) + (v1.x * v1.x + v1.y * v1.y) + (v1.z * v1.z + v1.w * v1.w); }
                    if (act) { v0.x = fsilu(v0.x); v0.y = fsilu(v0.y); v0.z = fsilu(v0.z); v0.w = fsilu(v0.w); v1.x = fsilu(v1.x); v1.y = fsilu(v1.y); v1.z = fsilu(v1.z); v1.w = fsilu(v1.w); }
                    { const int c_ = cb + 128 * bj; const size_t off_ = hm ? ((size_t)(((row >> 11) * 16 + (c_ >> 6)) * 2048 + (row & 2047)) * 64 + (c_ & 63)) : ((size_t)row * pitch + c_);
                      if (wt) wst16(base, off_ * 2, pack8(v0, v1)); else gst<u32x4>((unsigned char*)base + off_ * 2, pack8(v0, v1)); }
                }
                if (st) { s = quad_rows_sum(s); q = quad_rows_sum(q);
                          if (fq == 0) { const int rl = ai * 128 + wr * 64 + m * 16 + fr; P[(rl * 4 + wc) * 2] = s; P[(rl * 4 + wc) * 2 + 1] = q; } }
            }
        if (st) {
            asm volatile("s_waitcnt lgkmcnt(0)" ::: "memory"); __builtin_amdgcn_s_barrier(); asm volatile("" ::: "memory");
            const int t = (wr * 4 + wc) * 64 + fr + 16 * fq;
            if (t < 256) { const float s = (P[(t * 4 + 0) * 2] + P[(t * 4 + 1) * 2]) + (P[(t * 4 + 2) * 2] + P[(t * 4 + 3) * 2]);
                           const float q = (P[(t * 4 + 0) * 2 + 1] + P[(t * 4 + 1) * 2 + 1]) + (P[(t * 4 + 2) * 2 + 1] + P[(t * 4 + 3) * 2 + 1]);
                           const int slot = (colt & 1023) >> 8; gst<float>(LNS + (size_t)slot * M + u.pm * 256 + t, s); gst<float>(LNS + (size_t)(4 + slot) * M + u.pm * 256 + t, q); }
        }
    }
};
struct EpiKV {
    static constexpr bool MUTATES = false;
    static constexpr bool HAS_ROWSCALE = false;
    static constexpr bool IDEMPOTENT = true;
    static constexpr bool HAS_FUSED = false;
    bf16_t* dst;
    __device__ __forceinline__ void row(int row, int colbase, float (&v)[8]) const {
#pragma unroll
        for (int j = 0; j < 8; ++j) { const int col = colbase + 32 * j; dst[(size_t)(col >> 11) * MM * 2048 + (size_t)row * 2048 + (col & 2047)] = f2bf(v[j]); }
    }
    __device__ __forceinline__ void operator()(const AccT& acc, const pg8::Unit& u, int wr, int wc, int fr, int fq) const {
        const int l = u.pn >> 3, cb = (u.pn & 7) * 256 + wc * 32 + 8 * fq, row0 = u.pm * 256 + wr * 64 + fr;
        bf16_t* base = dst + (size_t)l * MM * 2048;
#pragma unroll
        for (int ai = 0; ai < 2; ++ai)
#pragma unroll
            for (int m = 0; m < 4; ++m) { const int row = row0 + ai * 128 + m * 16;
#pragma unroll
                for (int bj = 0; bj < 2; ++bj) *(u32x4*)(base + (size_t)row * 2048 + cb + 128 * bj) = pack8(acc[ai][bj][m][0], acc[ai][bj][m][1]); }
    }
};
struct EpiGateA {
    static constexpr bool MUTATES = false;
    static constexpr bool HAS_ROWSCALE = false;
    static constexpr bool IDEMPOTENT = false;
    static constexpr bool HAS_FUSED = false;
    bf16_t* A0; const float* RS; int dry; bool wt = true;
    __device__ __forceinline__ void row(int row, int colbase, float (&v)[8]) const {
        const float rs = rstd_of(RS, row);
#pragma unroll
        for (int j = 0; j < 8; ++j) { bf16_t* q = A0 + (size_t)row * 1024 + colbase + 32 * j; *q = f2bf(bf2f(*q) * silu_f(v[j] * rs)); }
    }
    __device__ __forceinline__ void operator()(const AccT& acc, const pg8::Unit& u, int wr, int wc, int fr, int fq) const {
        const int cb = u.pn * 256 + wc * 32 + 8 * fq, row0 = u.pm * 256 + wr * 64 + fr;
#pragma unroll
        for (int ai = 0; ai < 2; ++ai) {
            float rsv[4]; u32x4 av[4][2];
#pragma unroll
            for (int m = 0; m < 4; ++m) { const int row = row0 + ai * 128 + m * 16; rsv[m] = rstd_of(RS, row);
#pragma unroll
                for (int bj = 0; bj < 2; ++bj) av[m][bj] = gld<u32x4>(A0 + (size_t)row * 1024 + cb + 128 * bj); }
#pragma unroll
            for (int m = 0; m < 4; ++m) {
                const int row = row0 + ai * 128 + m * 16; const float rs = rsv[m];
#pragma unroll
                for (int bj = 0; bj < 2; ++bj) {
                    f32x4 g0 = acc[ai][bj][m][0] * rs, g1 = acc[ai][bj][m][1] * rs;
                    g0.x = fsilu(g0.x); g0.y = fsilu(g0.y); g0.z = fsilu(g0.z); g0.w = fsilu(g0.w); g1.x = fsilu(g1.x); g1.y = fsilu(g1.y); g1.z = fsilu(g1.z); g1.w = fsilu(g1.w);
                    const size_t off = (size_t)row * 1024 + cb + 128 * bj;
                    const u32x4 a = av[m][bj];
                    const f32x4 o0 = (f32x4){bflo(a.x) * g0.x, bfhi(a.x) * g0.y, bflo(a.y) * g0.z, bfhi(a.y) * g0.w}, o1 = (f32x4){bflo(a.z) * g1.x, bfhi(a.z) * g1.y, bflo(a.w) * g1.z, bfhi(a.w) * g1.w};
                    if (!dry) st16(A0, off * 2, pack8(o0, o1), wt);
                }
            }
        }
    }
};
__device__ __forceinline__ float poolop(const bf16_t* U, int row, int c) {
    const int w = 2 << (c >> 8), t = row & (SEQ - 1), n = (t + 1 < w) ? (t + 1) : w;
    float s = 0.f;
    for (int i = 0; i < n; ++i) s += bf2f(U[(size_t)(row - i) * 1024 + c]);
    return s / (float)n - bf2f(U[(size_t)row * 1024 + c]);
}
struct EpiGateB {
    static constexpr bool MUTATES = false;
    static constexpr bool HAS_ROWSCALE = false;
    static constexpr bool IDEMPOTENT = false;
    static constexpr bool HAS_FUSED = true;
    bf16_t* A1; const bf16_t* U; const float* RS; int dry;
    __device__ __forceinline__ void row(int row, int colbase, float (&v)[8]) const {
        const float rs = rstd_of(RS, row);
#pragma unroll
        for (int j = 0; j < 8; ++j) { const int c = colbase + 32 * j; A1[(size_t)row * 1024 + c] = f2bf(poolop(U, row, c) * silu_f(v[j] * rs)); }
    }
    __device__ __forceinline__ void operator()(const AccT& acc, const pg8::Unit& u, int wr, int wc, int fr, int fq) const {
        const int cb = u.pn * 256 + wc * 32 + 8 * fq, row0 = u.pm * 256 + wr * 64 + fr, w = 2 << u.pn;
#pragma unroll
        for (int ai = 0; ai < 2; ++ai)
#pragma unroll
            for (int m = 0; m < 4; ++m) {
                const int row = row0 + ai * 128 + m * 16; const float rs = rstd_of(RS, row);
#pragma unroll
                for (int bj = 0; bj < 2; ++bj) {
                    f32x4 g0 = acc[ai][bj][m][0] * rs, g1 = acc[ai][bj][m][1] * rs;
                    g0.x = fsilu(g0.x); g0.y = fsilu(g0.y); g0.z = fsilu(g0.z); g0.w = fsilu(g0.w); g1.x = fsilu(g1.x); g1.y = fsilu(g1.y); g1.z = fsilu(g1.z); g1.w = fsilu(g1.w);
                    const size_t off = (size_t)row * 1024 + cb + 128 * bj;
                    const int t = row & (SEQ - 1), n = (t + 1 < w) ? (t + 1) : w;
                    const u32x4 c = gld<u32x4>(U + off);
                    f32x4 s0 = (f32x4){bflo(c.x), bfhi(c.x), bflo(c.y), bfhi(c.y)}, s1 = (f32x4){bflo(c.z), bfhi(c.z), bflo(c.w), bfhi(c.w)};
                    const f32x4 c0 = s0, c1 = s1;
                    for (int i = 1; i < w; ++i) if (i <= t) { const u32x4 a = gld<u32x4>(U + off - (size_t)i * 1024);
                        s0 += (f32x4){bflo(a.x), bfhi(a.x), bflo(a.y), bfhi(a.y)}; s1 += (f32x4){bflo(a.z), bfhi(a.z), bflo(a.w), bfhi(a.w)}; }
                    const float inv = 1.0f / (float)n;
                    if (!dry) wst16(A1, off * 2, pack8((s0 * inv - c0) * g0, (s1 * inv - c1) * g1));
                }
            }
    }
    __device__ __forceinline__ void fused(const AccT& acc, const pg8::Unit& u, int wr, int wc, int fr, int fq, PG8_LAS unsigned char* lds) const {
        const int R0 = u.pm * 256, C0 = u.pn * 256, w = 2 << u.pn, tid = (wr * 4 + wc) * 64 + fr + 16 * fq;
        const int tb = R0 & (SEQ - 1);
        float rsv[2][4];
#pragma unroll
        for (int ai = 0; ai < 2; ++ai)
#pragma unroll
            for (int m = 0; m < 4; ++m) rsv[ai][m] = rstd_of(RS, R0 + ai * 128 + wr * 64 + m * 16 + fr);
        for (int id = tid; id < 271 * 32; id += NT) { const int rl = id >> 5, ch = id & 31;
            if (rl >= 15 || tb != 0) *(PG8_LAS u32x4*)(lds + rl * 528 + ch * 16) = gld<u32x4>(U + (size_t)(R0 - 15 + rl) * 1024 + C0 + ch * 8); }
        asm volatile("s_waitcnt vmcnt(0) lgkmcnt(0)" ::: "memory"); __builtin_amdgcn_s_barrier(); asm volatile("" ::: "memory");
#pragma unroll
        for (int ai = 0; ai < 2; ++ai)
#pragma unroll
            for (int m = 0; m < 4; ++m) {
                const int rloc = ai * 128 + wr * 64 + m * 16 + fr, row = R0 + rloc; const float rs = rsv[ai][m];
                const int t = row & (SEQ - 1), n = (t + 1 < w) ? (t + 1) : w;
                const float inv = 1.0f / (float)n;
#pragma unroll
                for (int bj = 0; bj < 2; ++bj) {
                    f32x4 g0 = acc[ai][bj][m][0] * rs, g1 = acc[ai][bj][m][1] * rs;
                    g0.x = fsilu(g0.x); g0.y = fsilu(g0.y); g0.z = fsilu(g0.z); g0.w = fsilu(g0.w); g1.x = fsilu(g1.x); g1.y = fsilu(g1.y); g1.z = fsilu(g1.z); g1.w = fsilu(g1.w);
                    const PG8_LAS unsigned char* lp = lds + (15 + rloc) * 528 + (128 * bj + wc * 32 + 8 * fq) * 2;
                    const u32x4 c = *(const PG8_LAS u32x4*)lp;
                    f32x4 s0 = (f32x4){bflo(c.x), bfhi(c.x), bflo(c.y), bfhi(c.y)}, s1 = (f32x4){bflo(c.z), bfhi(c.z), bflo(c.w), bfhi(c.w)};
                    const f32x4 c0 = s0, c1 = s1;
                    for (int i = 1; i < n; ++i) { const u32x4 a = *(const PG8_LAS u32x4*)(lp - i * 528);
                        s0 += (f32x4){bflo(a.x), bfhi(a.x), bflo(a.y), bfhi(a.y)}; s1 += (f32x4){bflo(a.z), bfhi(a.z), bflo(a.w), bfhi(a.w)}; }
                    if (!dry) wst16(A1, ((size_t)row * 1024 + C0 + 128 * bj + wc * 32 + 8 * fq) * 2, pack8((s0 * inv - c0) * g0, (s1 * inv - c1) * g1));
                }
            }
    }
};
struct EpiGates {
    static constexpr bool MUTATES = false;
    static constexpr bool HAS_ROWSCALE = false;
    static constexpr bool IDEMPOTENT = false;
    static constexpr bool HAS_FUSED = true;
    EpiGateA ga; EpiGateB gb;
    __device__ __forceinline__ void row(int row, int colbase, float (&v)[8]) const { if (colbase < 1024) ga.row(row, colbase, v); else gb.row(row, colbase - 1024, v); }
    __device__ __forceinline__ void operator()(const AccT& acc, const pg8::Unit& u, int wr, int wc, int fr, int fq) const {
        if (u.pn < 4) { EpiGateA g2 = ga; g2.wt = false; g2(acc, u, wr, wc, fr, fq); }
        else { pg8::Unit v; v.pm = u.pm; v.pn = u.pn - 4; gb(acc, v, wr, wc, fr, fq); }
    }
    __device__ __forceinline__ void fused(const AccT& acc, const pg8::Unit& u, int wr, int wc, int fr, int fq, PG8_LAS unsigned char* lds) const {
        if (u.pn < 4) ga(acc, u, wr, wc, fr, fq);
        else { pg8::Unit v; v.pm = u.pm; v.pn = u.pn - 4; gb.fused(acc, v, wr, wc, fr, fq, lds); }
    }
};
struct EpiResid {
    static constexpr bool MUTATES = false;
    static constexpr bool HAS_ROWSCALE = false;
    static constexpr bool IDEMPOTENT = false;
    static constexpr bool HAS_FUSED = false;
    bf16_t* XB; float* RSn; unsigned char* scr; int dry; bool wt = true;
    __device__ __forceinline__ void row(int row, int colbase, float (&v)[8]) const {
        float q0 = 0.f;
#pragma unroll
        for (int j = 0; j < 8; ++j) { const int col = colbase + 32 * j; bf16_t* xp = XB + (size_t)row * 1024 + col; const float x = bf2f(*xp) + v[j]; *xp = f2bf(x); q0 += x * x; }
        q0 = half_sum32(q0);
        if ((threadIdx.x & 31) == 0) RSn[(size_t)(colbase >> 8) * M + row] = q0;
    }
    __device__ __forceinline__ void operator()(const AccT& acc, const pg8::Unit& u, int wr, int wc, int fr, int fq) const {
        const int cb = u.pn * 256 + wc * 32 + 8 * fq, row0 = u.pm * 256 + wr * 64 + fr;
        PG8_LAS float* P = (PG8_LAS float*)scr;
        u32x4 ov[2][4][2];
#pragma unroll
        for (int ai = 0; ai < 2; ++ai)
#pragma unroll
            for (int m = 0; m < 4; ++m)
#pragma unroll
                for (int bj = 0; bj < 2; ++bj) ov[ai][m][bj] = gld<u32x4>(XB + (size_t)(row0 + ai * 128 + m * 16) * 1024 + cb + 128 * bj);
#pragma unroll
        for (int ai = 0; ai < 2; ++ai)
#pragma unroll
            for (int m = 0; m < 4; ++m) {
                const int row = row0 + ai * 128 + m * 16; float q = 0.f;
#pragma unroll
                for (int bj = 0; bj < 2; ++bj) {
                    const u32x4 o = ov[ai][m][bj];
                    const f32x4 x0 = (f32x4){bflo(o.x), bfhi(o.x), bflo(o.y), bfhi(o.y)} + acc[ai][bj][m][0], x1 = (f32x4){bflo(o.z), bfhi(o.z), bflo(o.w), bfhi(o.w)} + acc[ai][bj][m][1];
                    if (!dry) st16(XB, ((size_t)row * 1024 + cb + 128 * bj) * 2, pack8(x0, x1), wt);
                    q += (x0.x * x0.x + x0.y * x0.y) + (x0.z * x0.z + x0.w * x0.w) + (x1.x * x1.x + x1.y * x1.y) + (x1.z * x1.z + x1.w * x1.w);
                }
                q = quad_rows_sum(q);
                if (fq == 0) P[(ai * 128 + wr * 64 + m * 16 + fr) * 4 + wc] = q;
            }
        asm volatile("s_waitcnt lgkmcnt(0)" ::: "memory"); __builtin_amdgcn_s_barrier(); asm volatile("" ::: "memory");
        const int t = (wr * 4 + wc) * 64 + fr + 16 * fq;
        if (t < 256 && !dry) wst4(RSn, ((size_t)u.pn * M + u.pm * 256 + t) * 4, (P[t * 4 + 0] + P[t * 4 + 1]) + (P[t * 4 + 2] + P[t * 4 + 3]));
    }
};
struct EpiGlu {
    static constexpr bool MUTATES = false;
    static constexpr bool HAS_ROWSCALE = false;
    static constexpr bool IDEMPOTENT = false;
    static constexpr bool HAS_FUSED = false;
    bf16_t* D; int dry;
    __device__ __forceinline__ void row(int row, int colbase, float (&v)[8]) const {
#pragma unroll
        for (int j = 0; j < 4; ++j) { const int c = (colbase >> 8) * 128 + (colbase & 255) + 32 * j; bf16_t* d = D + (size_t)row * 1024 + c;
            *d = f2bf(v[j] * sigmoid_f(v[j + 4]) * bf2f(*d)); }
    }
    __device__ __forceinline__ void operator()(const AccT& acc, const pg8::Unit& u, int wr, int wc, int fr, int fq) const {
        const int cb = u.pn * 128 + wc * 32 + 8 * fq, row0 = u.pm * 256 + wr * 64 + fr;
        u32x4 gv[2][4];
#pragma unroll
        for (int ai = 0; ai < 2; ++ai)
#pragma unroll
            for (int m = 0; m < 4; ++m) gv[ai][m] = gld<u32x4>(D + (size_t)(row0 + ai * 128 + m * 16) * 1024 + cb);
#pragma unroll
        for (int ai = 0; ai < 2; ++ai)
#pragma unroll
            for (int m = 0; m < 4; ++m) {
                const int row = row0 + ai * 128 + m * 16;
                const u32x4 g = gv[ai][m]; const f32x4 a0 = acc[ai][0][m][0], a1 = acc[ai][0][m][1], b0 = acc[ai][1][m][0], b1 = acc[ai][1][m][1];
                const f32x4 o0 = (f32x4){a0.x * fsigmoid(b0.x) * bflo(g.x), a0.y * fsigmoid(b0.y) * bfhi(g.x), a0.z * fsigmoid(b0.z) * bflo(g.y), a0.w * fsigmoid(b0.w) * bfhi(g.y)};
                const f32x4 o1 = (f32x4){a1.x * fsigmoid(b1.x) * bflo(g.z), a1.y * fsigmoid(b1.y) * bfhi(g.z), a1.z * fsigmoid(b1.z) * bflo(g.w), a1.w * fsigmoid(b1.w) * bfhi(g.w)};
                if (!dry) wst16(D, ((size_t)row * 1024 + cb) * 2, pack8(o0, o1));
            }
    }
};
struct EpiFold {
    static constexpr bool MUTATES = false;
    static constexpr bool HAS_ROWSCALE = false;
    static constexpr bool IDEMPOTENT = true;
    static constexpr bool HAS_FUSED = false;
    bf16_t* dst; const float* scale;
    __device__ __forceinline__ void row(int row, int colbase, float (&v)[8]) const {
#pragma unroll
        for (int j = 0; j < 8; ++j) dst[(size_t)row * WIN_LD + colbase + 32 * j] = f2bf(v[j] * scale[row]);
    }
    __device__ __forceinline__ void operator()(const AccT& acc, const pg8::Unit& u, int wr, int wc, int fr, int fq) const {
        const int cb = u.pn * 256 + wc * 32 + 8 * fq, row0 = u.pm * 256 + wr * 64 + fr;
#pragma unroll
        for (int ai = 0; ai < 2; ++ai)
#pragma unroll
            for (int m = 0; m < 4; ++m) { const int row = row0 + ai * 128 + m * 16; const float sc = gld<float>(scale + row);
#pragma unroll
                for (int bj = 0; bj < 2; ++bj) gst<u32x4>(dst + (size_t)row * WIN_LD + cb + 128 * bj, pack8(acc[ai][bj][m][0] * sc, acc[ai][bj][m][1] * sc)); }
    }
};
struct EpiSoftmaxP {
    static constexpr bool MUTATES = true;
    static constexpr bool HAS_ROWSCALE = false;
    static constexpr bool IDEMPOTENT = false;
    static constexpr bool HAS_FUSED = false;
    bf16_t* Pdst; const float* RSu; unsigned char* scr;
    __device__ __forceinline__ void row(int row, int colbase, float (&v)[8]) const { (void)row; (void)colbase; (void)v; }
    __device__ __forceinline__ void operator()(const AccT& acc, const pg8::Unit& u, int wr, int wc, int fr, int fq) const { (void)acc; (void)u; (void)wr; (void)wc; (void)fr; (void)fq; }
    __device__ __forceinline__ void mut(AccT& acc, const pg8::Unit& u, int wr, int wc, int fr, int fq) const {
        PG8_LAS float* P1 = (PG8_LAS float*)scr; PG8_LAS float* P2 = P1 + 1024; PG8_LAS float* R = P2 + 1024;
        { const int t = (wr * 4 + wc) * 64 + fr + 16 * fq;
          if (t < 256) R[t] = rsqrtf(((gld<float>(RSu + t) + gld<float>(RSu + (size_t)M + t)) + (gld<float>(RSu + (size_t)2 * M + t) + gld<float>(RSu + (size_t)3 * M + t))) * (1.0f / 1024.f) + EPS); }
#pragma unroll
        for (int ai = 0; ai < 2; ++ai)
#pragma unroll
            for (int m = 0; m < 4; ++m) { float mx = -3.0e38f;
#pragma unroll
                for (int bj = 0; bj < 2; ++bj)
#pragma unroll
                    for (int n = 0; n < 2; ++n) { const f32x4 x = acc[ai][bj][m][n]; mx = fmaxf(mx, fmaxf(fmaxf(x.x, x.y), fmaxf(x.z, x.w))); }
                mx = quad_rows_max(mx);
                if (fq == 0) P1[(ai * 128 + wr * 64 + m * 16 + fr) * 4 + wc] = mx; }
        asm volatile("s_waitcnt lgkmcnt(0)" ::: "memory"); __builtin_amdgcn_s_barrier(); asm volatile("" ::: "memory");
#pragma unroll
        for (int ai = 0; ai < 2; ++ai)
#pragma unroll
            for (int m = 0; m < 4; ++m) { const int rl = ai * 128 + wr * 64 + m * 16 + fr; const float rs = R[rl];
                const float mx = fmaxf(fmaxf(P1[rl * 4 + 0], P1[rl * 4 + 1]), fmaxf(P1[rl * 4 + 2], P1[rl * 4 + 3])); float sm = 0.f;
#pragma unroll
                for (int bj = 0; bj < 2; ++bj)
#pragma unroll
                    for (int n = 0; n < 2; ++n) { f32x4 x = acc[ai][bj][m][n];
                        x.x = __builtin_amdgcn_exp2f((x.x - mx) * rs); x.y = __builtin_amdgcn_exp2f((x.y - mx) * rs); x.z = __builtin_amdgcn_exp2f((x.z - mx) * rs); x.w = __builtin_amdgcn_exp2f((x.w - mx) * rs);
                        sm += (x.x + x.y) + (x.z + x.w); acc[ai][bj][m][n] = x; }
                sm = quad_rows_sum(sm);
                if (fq == 0) P2[rl * 4 + wc] = sm; }
        asm volatile("s_waitcnt lgkmcnt(0)" ::: "memory"); __builtin_amdgcn_s_barrier(); asm volatile("" ::: "memory");
        const int cb = u.pn * 256 + wc * 32 + 8 * fq;
#pragma unroll
        for (int ai = 0; ai < 2; ++ai)
#pragma unroll
            for (int m = 0; m < 4; ++m) { const int rl = ai * 128 + wr * 64 + m * 16 + fr;
                const float inv = 1.0f / ((P2[rl * 4 + 0] + P2[rl * 4 + 1]) + (P2[rl * 4 + 2] + P2[rl * 4 + 3]));
#pragma unroll
                for (int bj = 0; bj < 2; ++bj) wst16(Pdst, ((size_t)(u.pm * 256 + rl) * 1024 + cb + 128 * bj) * 2, pack8(acc[ai][bj][m][0] * inv, acc[ai][bj][m][1] * inv)); }
    }
};
struct EpiTile {
    static constexpr bool MUTATES = false;
    static constexpr bool HAS_ROWSCALE = false;
    static constexpr bool IDEMPOTENT = true;
    static constexpr bool HAS_FUSED = false;
    bf16_t* dst;
    __device__ __forceinline__ void row(int row, int colbase, float (&v)[8]) const {
#pragma unroll
        for (int j = 0; j < 8; ++j) dst[(size_t)row * 1024 + colbase + 32 * j] = f2bf(v[j]);
    }
    __device__ __forceinline__ void operator()(const AccT& acc, const pg8::Unit& u, int wr, int wc, int fr, int fq) const {
        const int cb = u.pn * 256 + wc * 32 + 8 * fq, row0 = u.pm * 256 + wr * 64 + fr;
#pragma unroll
        for (int ai = 0; ai < 2; ++ai)
#pragma unroll
            for (int m = 0; m < 4; ++m) { const int row = row0 + ai * 128 + m * 16;
#pragma unroll
                for (int bj = 0; bj < 2; ++bj) wst16(dst, ((size_t)row * 1024 + cb + 128 * bj) * 2, pack8(acc[ai][bj][m][0], acc[ai][bj][m][1])); }
    }
};
template <int FAST, class Epi, bool TAIL = true>
__device__ __forceinline__ void run_gemm(unsigned char* lds, const bf16_t* A1, const bf16_t* A2, int K1, const bf16_t* Bt, int Mrows, int N, int K, const Epi& E, int a_grp = 1 << 20, int a_skip = 0, int b_grp = 1 << 20, int b_skip = 0, int vG = 0, int vc = 0, int lda = 1024, int ldb = 0, const bf16_t* Bt2 = nullptr, int nsplit = 1 << 20) {
    if constexpr (FAST) { pg8::Gemm g{A1, A2, K1 / 64, lda, Bt, Mrows, N, K, a_grp, a_skip, b_grp, b_skip, vG, vc, ldb ? ldb : K, Bt2, nsplit}; pg8::gemm_phase<Epi, TAIL>((PG8_LAS unsigned char*)lds, g, E); }
    else ngemm(lds, A1, A2, K1, lda, Bt, Mrows, N, K, E);
}
__device__ __forceinline__ void zero_f32(float* p, int n) { for (int i = blockIdx.x * NT + tid_l(); i < n; i += gridDim.x * NT) p[i] = 0.f; }

__device__ __forceinline__ void init_rows(const Params& p) {
    unsigned char* wsl = p.ws; asm volatile("" : "+s"(wsl));
    const int tidl = tid_l(), lane = tidl & 63, gw = blockIdx.x * (NT / 64) + (tidl >> 6), ngw = gridDim.x * (NT / 64);
    float* RS = (float*)(wsl + WS_RS); bf16_t* XB = (bf16_t*)(wsl + WS_XB); bf16_t* MB = (bf16_t*)(wsl + WS_MEMNB);
    for (int row = gw; row < M; row += ngw) {
        const f32x4* xr = (const f32x4*)(p.in[0] + (size_t)row * DM) + lane; u32x2* xb = (u32x2*)(XB + (size_t)row * DM) + lane;
        float s = 0.f;
#pragma unroll
        for (int j = 0; j < 4; ++j) { const f32x4 v = gld<f32x4>(xr + 64 * j); s += v.x * v.x + v.y * v.y + v.z * v.z + v.w * v.w;
            u32x2 w; w.x = cvt_pk_bf16(v.x, v.y); w.y = cvt_pk_bf16(v.z, v.w); gst<u32x2>(XB + (size_t)row * DM + 4 * (lane + 64 * j), w); }
        s = wave_sum(s);
        if (lane < 4) RS[(size_t)lane * M + row] = (lane == 0) ? s : 0.f;
    }
    for (int row = gw; row < MM; row += ngw) {
        const f32x4* xr = (const f32x4*)(p.in[1] + (size_t)row * DM) + lane; const f32x4* gr = (const f32x4*)(p.in[28]) + lane; u32x2* xb = (u32x2*)(MB + (size_t)row * DM) + lane;
        f32x4 v[4]; float s = 0.f;
#pragma unroll
        for (int j = 0; j < 4; ++j) { v[j] = xr[64 * j]; s += v[j].x * v[j].x + v[j].y * v[j].y + v[j].z * v[j].z + v[j].w * v[j].w; }
        s = wave_sum(s); const float r = rsqrtf(s * (1.0f / DM) + EPS);
#pragma unroll
        for (int j = 0; j < 4; ++j) { const f32x4 g = gr[64 * j]; u32x2 w; w.x = (unsigned)f2bf(v[j].x * r * g.x) | ((unsigned)f2bf(v[j].y * r * g.y) << 16);
            w.y = (unsigned)f2bf(v[j].z * r * g.z) | ((unsigned)f2bf(v[j].w * r * g.w) << 16); xb[64 * j] = w; }
    }
}
__device__ __forceinline__ void cvt_wvb(const Params& p) {
    unsigned char* wsl = p.ws; asm volatile("" : "+s"(wsl));
    bf16_t* WVB = (bf16_t*)(wsl + WS_WVB);
    for (int e8 = blockIdx.x * NT + tid_l(); e8 < 2 * 4 * 1024 * 32; e8 += gridDim.x * NT) {
        const int c8 = e8 & 31, k = (e8 >> 5) & 1023, g = (e8 >> 15) & 3, i = e8 >> 17;
        const float* src = p.in[3] + (size_t)i * 1024 * 6144 + (size_t)k * 6144 + 4096 + g * 256 + 8 * c8; const float gn = p.in[2][i * 1024 + k];
        const f32x4 a = gld<f32x4>(src) * gn, c = gld<f32x4>(src + 4) * gn;
        wst16(WVB, (size_t)e8 * 16, pack8(a, c));
    }
}

__device__ __forceinline__ void cvt_wxqn(const Params& p) {
    unsigned char* wsl = p.ws; asm volatile("" : "+s"(wsl));
    bf16_t* W = (bf16_t*)(wsl + WS_WXQ);
    for (int e8 = blockIdx.x * NT + tid_l(); e8 < 4 * 1024 * 128; e8 += gridDim.x * NT) {
        const int i = (e8 >> 7) & 1023, l = e8 >> 17;
        const float* src = p.in[25] + (size_t)e8 * 8; const float gn = p.in[24][l * 1024 + i] * (0.0625f * 1.4426950408889634f);
        const f32x4 a = gld<f32x4>(src) * gn, c = gld<f32x4>(src + 4) * gn;
        wst16(W, (size_t)e8 * 16, pack8(a, c));
    }
}

__device__ __forceinline__ int dil_pos(int t, int s) { return (s < 129) ? (t - s) : (s < 258) ? (t - 4 * (s - 129)) : (t - 16 * (s - 258)); }
__device__ __forceinline__ void dil_attn_naive(const Params& p) {
    unsigned char* wsl = p.ws; asm volatile("" : "+s"(wsl));
    bf16_t* Q = (bf16_t*)(wsl + WS_B0); const bf16_t* Kb = (const bf16_t*)(wsl + WS_B1); const bf16_t* Vb = (const bf16_t*)(wsl + WS_B2);
    const int tidl = tid_l(), lane = tidl & 63, gw = blockIdx.x * (NT / 64) + (tidl >> 6), ngw = gridDim.x * (NT / 64);
    for (int item = gw; item < M * 16; item += ngw) {
        const int row = item >> 4, h = item & 15, t = row & (SEQ - 1), rowb = row - t;
        float q[64];
        { const u32x4* qp = (const u32x4*)(Q + (size_t)row * 1024 + h * 64);
#pragma unroll
          for (int i = 0; i < 8; ++i) { const u32x4 w = qp[i];
              q[8 * i + 0] = __uint_as_float(w.x << 16); q[8 * i + 1] = __uint_as_float(w.x & 0xffff0000u); q[8 * i + 2] = __uint_as_float(w.y << 16); q[8 * i + 3] = __uint_as_float(w.y & 0xffff0000u);
              q[8 * i + 4] = __uint_as_float(w.z << 16); q[8 * i + 5] = __uint_as_float(w.z & 0xffff0000u); q[8 * i + 6] = __uint_as_float(w.w << 16); q[8 * i + 7] = __uint_as_float(w.w & 0xffff0000u); } }
        float sc[7]; float mx = -3.0e38f;
#pragma unroll
        for (int i = 0; i < 7; ++i) {
            const int s = lane + 64 * i, pos = dil_pos(t, s); const bool valid = (s < 386) && (pos >= 0);
            float d = -3.0e38f;
            if (valid) { const u32x4* kp = (const u32x4*)(Kb + (size_t)(rowb + pos) * 1024 + h * 64); d = 0.f;
#pragma unroll
                for (int c = 0; c < 8; ++c) { const u32x4 w = kp[c];
                    d += q[8 * c + 0] * __uint_as_float(w.x << 16) + q[8 * c + 1] * __uint_as_float(w.x & 0xffff0000u) + q[8 * c + 2] * __uint_as_float(w.y << 16) + q[8 * c + 3] * __uint_as_float(w.y & 0xffff0000u)
                       + q[8 * c + 4] * __uint_as_float(w.z << 16) + q[8 * c + 5] * __uint_as_float(w.z & 0xffff0000u) + q[8 * c + 6] * __uint_as_float(w.w << 16) + q[8 * c + 7] * __uint_as_float(w.w & 0xffff0000u); } }
            sc[i] = d; mx = fmaxf(mx, d);
        }
        mx = wave_max(mx);
        float l = 0.f;
#pragma unroll
        for (int i = 0; i < 7; ++i) { const int s = lane + 64 * i, pos = dil_pos(t, s); const bool valid = (s < 386) && (pos >= 0); sc[i] = valid ? expf(sc[i] - mx) : 0.f; l += sc[i]; }
        l = wave_sum(l);
        float o = 0.f;
#pragma unroll
        for (int i = 0; i < 7; ++i) {
            for (int j = 0; j < 64; ++j) { const int s = 64 * i + j; if (s >= 386) break; const int pos = dil_pos(t, s); const float pj = __shfl(sc[i], j);
                if (pos >= 0) o += pj * bf2f(Vb[(size_t)(rowb + pos) * 1024 + h * 64 + lane]); }
        }
        Q[(size_t)row * 1024 + h * 64 + lane] = f2bf(o / l);
    }
}

typedef float f32x16 __attribute__((ext_vector_type(16)));
typedef short s16x8 __attribute__((ext_vector_type(8)));
typedef short s16x4 __attribute__((ext_vector_type(4)));
__device__ __forceinline__ void dil_tile(f32x16 (&oacc)[2], float& m, float& l, const s16x8 (&qf)[4], const u32x4 (&kk)[4], const u32x4 (&vv)[4], unsigned char* Vw, unsigned tr_base,
                                         int lane, int q, int h, int qpos, int kpb, bool need_mask) {
#pragma unroll
    for (int i2 = 0; i2 < 4; ++i2) *(u32x4*)(Vw + ((lane >> 3) + 8 * i2) * 144 + (lane & 7) * 16) = kk[i2];
    s16x8 kf[4];
#pragma unroll
    for (int ks = 0; ks < 4; ++ks) kf[ks] = *(const s16x8*)(Vw + q * 144 + (16 * ks + 8 * h) * 2);
    asm volatile("s_waitcnt lgkmcnt(0)" ::: "memory");
#pragma unroll
    for (int i2 = 0; i2 < 4; ++i2) *(u32x4*)(Vw + ((lane >> 3) + 8 * i2) * 192 + (lane & 7) * 16) = vv[i2];
    f32x16 sacc;
#pragma unroll
    for (int e = 0; e < 16; ++e) sacc[e] = 0.f;
#pragma unroll
    for (int ks = 0; ks < 4; ++ks) sacc = __builtin_amdgcn_mfma_f32_32x32x16_bf16(kf[ks], qf[ks], sacc, 0, 0, 0);
    if (need_mask) {
        const int hi = qpos - kpb - 4 * h, l1 = hi - 128, l2 = -(kpb + 4 * h), lo = l1 > l2 ? l1 : l2;
        const unsigned mhi = hi < 0 ? 0u : (hi >= 31 ? 0xffffffffu : ((2u << hi) - 1u));
        const unsigned mlo = lo <= 0 ? 0xffffffffu : (lo >= 32 ? 0u : (0xffffffffu << lo));
        const unsigned mk = mhi & mlo;
#pragma unroll
        for (int e = 0; e < 16; ++e) { const int c = (e & 3) + 8 * (e >> 2); const unsigned mm = (unsigned)(((int)(mk << (31 - c))) >> 31);
            sacc[e] = __uint_as_float((__float_as_uint(sacc[e]) & mm) | (0xff800000u & ~mm)); }
    }
    typedef float f32x2_ __attribute__((ext_vector_type(2)));
    f32x2_ t2[8];
    { const f32x2_ nm = (f32x2_){-m, -m};
#pragma unroll
      for (int e = 0; e < 8; ++e) t2[e] = (f32x2_){sacc[2 * e], sacc[2 * e + 1]} + nm; }
    float mt;
    { const float r0 = fmaxf(fmaxf(t2[0].x, t2[0].y), t2[1].x), r1 = fmaxf(fmaxf(t2[1].y, t2[2].x), t2[2].y), r2 = fmaxf(fmaxf(t2[3].x, t2[3].y), t2[4].x),
                  r3 = fmaxf(fmaxf(t2[4].y, t2[5].x), t2[5].y), r4 = fmaxf(fmaxf(t2[6].x, t2[6].y), t2[7].x);
      mt = fmaxf(fmaxf(fmaxf(r0, r1), r2), fmaxf(fmaxf(r3, r4), t2[7].y)); }
    { const auto rr = __builtin_amdgcn_permlane32_swap(__float_as_uint(mt), __float_as_uint(mt), false, false); mt = __builtin_amdgcn_fmed3f(__uint_as_float(rr[0]), __uint_as_float(rr[1]), INFINITY); }
    if (!__all(mt <= 8.0f)) {
        float ms;
        { float m4[4];
#pragma unroll
          for (int e = 0; e < 4; ++e) m4[e] = fmaxf(fmaxf(sacc[4 * e], sacc[4 * e + 1]), fmaxf(sacc[4 * e + 2], sacc[4 * e + 3]));
          ms = fmaxf(fmaxf(m4[0], m4[1]), fmaxf(m4[2], m4[3])); }
        { const auto rr = __builtin_amdgcn_permlane32_swap(__float_as_uint(ms), __float_as_uint(ms), false, false); ms = fmaxf(__uint_as_float(rr[0]), __uint_as_float(rr[1])); }
        const float mnew = fmaxf(m, ms), alpha = __builtin_amdgcn_exp2f(m - mnew); m = mnew; l *= alpha;
#pragma unroll
        for (int dt = 0; dt < 2; ++dt)
#pragma unroll
            for (int e = 0; e < 16; ++e) oacc[dt][e] *= alpha;
        const f32x2_ nm = (f32x2_){-m, -m};
#pragma unroll
        for (int e = 0; e < 8; ++e) t2[e] = (f32x2_){sacc[2 * e], sacc[2 * e + 1]} + nm;
    }
#pragma unroll
    for (int e = 0; e < 8; ++e) { sacc[2 * e] = __builtin_amdgcn_exp2f(t2[e].x); sacc[2 * e + 1] = __builtin_amdgcn_exp2f(t2[e].y); }
    float ps;
    { float s4[4];
#pragma unroll
      for (int e = 0; e < 4; ++e) s4[e] = (sacc[4 * e] + sacc[4 * e + 1]) + (sacc[4 * e + 2] + sacc[4 * e + 3]);
      ps = (s4[0] + s4[1]) + (s4[2] + s4[3]); }
    { const auto rr = __builtin_amdgcn_permlane32_swap(__float_as_uint(ps), __float_as_uint(ps), false, false); ps = __uint_as_float(rr[0]) + __uint_as_float(rr[1]); }
    l += ps;
    s16x8 pf[2];
#pragma unroll
    for (int s2 = 0; s2 < 2; ++s2) { u32x4 w; w.x = cvt_pk_bf16(sacc[8 * s2 + 0], sacc[8 * s2 + 1]); w.y = cvt_pk_bf16(sacc[8 * s2 + 2], sacc[8 * s2 + 3]);
        w.z = cvt_pk_bf16(sacc[8 * s2 + 4], sacc[8 * s2 + 5]); w.w = cvt_pk_bf16(sacc[8 * s2 + 6], sacc[8 * s2 + 7]); pf[s2] = __builtin_bit_cast(s16x8, w); }
    s16x4 t00, t01, t02, t03, t10, t11, t12, t13;
    asm volatile("ds_read_b64_tr_b16 %0, %8 offset:0\n\tds_read_b64_tr_b16 %1, %8 offset:1536\n\tds_read_b64_tr_b16 %2, %8 offset:3072\n\tds_read_b64_tr_b16 %3, %8 offset:4608\n\t"
                 "ds_read_b64_tr_b16 %4, %8 offset:64\n\tds_read_b64_tr_b16 %5, %8 offset:1600\n\tds_read_b64_tr_b16 %6, %8 offset:3136\n\tds_read_b64_tr_b16 %7, %8 offset:4672\n\ts_waitcnt lgkmcnt(0)"
                 : "=&v"(t00), "=&v"(t01), "=&v"(t02), "=&v"(t03), "=&v"(t10), "=&v"(t11), "=&v"(t12), "=&v"(t13) : "v"(tr_base) : "memory");
    oacc[0] = __builtin_amdgcn_mfma_f32_32x32x16_bf16(__builtin_shufflevector(t00, t01, 0, 1, 2, 3, 4, 5, 6, 7), pf[0], oacc[0], 0, 0, 0);
    oacc[1] = __builtin_amdgcn_mfma_f32_32x32x16_bf16(__builtin_shufflevector(t10, t11, 0, 1, 2, 3, 4, 5, 6, 7), pf[0], oacc[1], 0, 0, 0);
    oacc[0] = __builtin_amdgcn_mfma_f32_32x32x16_bf16(__builtin_shufflevector(t02, t03, 0, 1, 2, 3, 4, 5, 6, 7), pf[1], oacc[0], 0, 0, 0);
    oacc[1] = __builtin_amdgcn_mfma_f32_32x32x16_bf16(__builtin_shufflevector(t12, t13, 0, 1, 2, 3, 4, 5, 6, 7), pf[1], oacc[1], 0, 0, 0);
}
__device__ __forceinline__ void dil_attn_mfma(unsigned char* lds, const Params& p, const int dry) {
    unsigned char* wsl = p.ws; asm volatile("" : "+s"(wsl));
    const bf16_t* Qb = (const bf16_t*)p.out; const bf16_t* Kb = (const bf16_t*)(wsl + WS_B1); const bf16_t* Vb = (const bf16_t*)(wsl + WS_B2);
    bf16_t* Ob = (bf16_t*)(wsl + WS_B0);
    const int tid = tid_l(), lane = tid & 63, wid = tid >> 6, q = lane & 31, h = lane >> 5;
    unsigned char* OST = lds;
    float* MST = (float*)(lds + 65536); float* LST = (float*)(lds + 67584);
    unsigned char* Vw = lds + 69632 + wid * 6144;
    const unsigned tr_base = (unsigned)(size_t)Vw + (unsigned)((4 * h + ((lane & 15) >> 2)) * 192 + (16 * ((lane >> 4) & 1) + 4 * (lane & 3)) * 2);
    for (int uu = bid_l(); uu < 512; uu += gridDim.x) {
        const int u = uu & 255, b = u & 7, hd = (u >> 3) & 15, cb_ = u >> 7, c = (uu < 256) ? cb_ : 3 - cb_, rowb = b * SEQ, T0 = 512 * c;
        __syncthreads();
#pragma unroll 1
        for (int stage = 0; stage < 3; ++stage) {
#pragma unroll 1
            for (int g = 0; g < 2; ++g) {
                int dil, r, pos0, kp0, nkt;
                if (stage == 0) { dil = 1; r = 0; pos0 = T0 + 64 * wid + 32 * g; kp0 = pos0 - 128; nkt = 5; }
                else if (stage == 1) { dil = 4; r = wid >> 1; pos0 = 128 * c + 64 * (wid & 1) + 32 * g; kp0 = pos0 - 128; nkt = 5; }
                else { dil = 16; r = 2 * wid + g; pos0 = 32 * c; kp0 = 0; nkt = c + 1; }
                const int qpos = pos0 + q, qtok = dil * qpos + r, tau = qtok - T0;
                const int fsw = ((tau >> 2) ^ (tau >> 4)) & 15;
                s16x8 qf[4];
                { const bf16_t* qp = Qb + ((size_t)(b * 16 + hd) * 2048 + qtok) * 64 + 8 * h;
#pragma unroll
                  for (int ks = 0; ks < 4; ++ks) qf[ks] = gld<s16x8>(qp + 16 * ks); }
                f32x16 oacc[2]; float m = -1.0e30f, l = 0.f;
                if (stage == 0) {
#pragma unroll
                    for (int dt = 0; dt < 2; ++dt)
#pragma unroll
                        for (int e = 0; e < 16; ++e) oacc[dt][e] = 0.f;
                } else {
                    m = MST[tau]; l = LST[tau];
#pragma unroll
                    for (int dt = 0; dt < 2; ++dt)
#pragma unroll
                        for (int gg = 0; gg < 4; ++gg) { const u32x2 w = *(const u32x2*)(OST + tau * 128 + (((8 * dt + 2 * gg + h) ^ fsw) * 8));
                            oacc[dt][4 * gg + 0] = bflo(w.x); oacc[dt][4 * gg + 1] = bfhi(w.x); oacc[dt][4 * gg + 2] = bflo(w.y); oacc[dt][4 * gg + 3] = bfhi(w.y); }
                }
#define DIL_LOAD(KT, KK, VV) do { const int kpb_ = kp0 + 32 * (KT); \
                    _Pragma("unroll") for (int i2 = 0; i2 < 4; ++i2) { int kpos_ = kpb_ + (lane >> 3) + 8 * i2; if (kpos_ < 0) kpos_ = 0; \
                        const unsigned ro_ = (unsigned)(dil * kpos_ + r) * 64u; KK[i2] = gld<u32x4>(kbase + ro_); VV[i2] = gld<u32x4>(vbase + ro_); } } while (0)
                const bf16_t* kbase = Kb + (size_t)(b * 16 + hd) * 2048 * 64 + 8 * (lane & 7); const bf16_t* vbase = Vb + (size_t)(b * 16 + hd) * 2048 * 64 + 8 * (lane & 7);
                u32x4 kA[4], vA[4], kB[4], vB[4];
                DIL_LOAD(0, kA, vA);
#pragma unroll 1
                for (int kt = 0; kt < nkt; kt += 2) {
                    if (kt + 1 < nkt) DIL_LOAD(kt + 1, kB, vB);
                    dil_tile(oacc, m, l, qf, kA, vA, Vw, tr_base, lane, q, h, qpos, kp0 + 32 * kt, kt == 0 || kt == nkt - 1 || kp0 + 32 * kt < 0);
                    if (kt + 1 < nkt) {
                        if (kt + 2 < nkt) DIL_LOAD(kt + 2, kA, vA);
                        dil_tile(oacc, m, l, qf, kB, vB, Vw, tr_base, lane, q, h, qpos, kp0 + 32 * (kt + 1), kt + 1 == nkt - 1 || kp0 + 32 * (kt + 1) < 0);
                    }
                }
                if (stage < 2) {
                    if (h == 0) { MST[tau] = m; LST[tau] = l; }
#pragma unroll
                    for (int dt = 0; dt < 2; ++dt)
#pragma unroll
                        for (int gg = 0; gg < 4; ++gg) { u32x2 w; w.x = cvt_pk_bf16(oacc[dt][4 * gg + 0], oacc[dt][4 * gg + 1]); w.y = cvt_pk_bf16(oacc[dt][4 * gg + 2], oacc[dt][4 * gg + 3]);
                            *(u32x2*)(OST + tau * 128 + (((8 * dt + 2 * gg + h) ^ fsw) * 8)) = w; }
                } else if (!dry) {
                    const float inv = 1.0f / l;
                    bf16_t* op = Ob + (size_t)(rowb + qtok) * 1024 + hd * 64 + 4 * h;
#pragma unroll
                    for (int dt = 0; dt < 2; ++dt)
#pragma unroll
                        for (int gg = 0; gg < 4; ++gg) { u32x2 w; w.x = cvt_pk_bf16(oacc[dt][4 * gg + 0] * inv, oacc[dt][4 * gg + 1] * inv); w.y = cvt_pk_bf16(oacc[dt][4 * gg + 2] * inv, oacc[dt][4 * gg + 3] * inv);
                            gst<u32x2>(op + 32 * dt + 8 * gg, w); }
                }
            }
            __syncthreads();
        }
    }
}

__device__ __forceinline__ void xattn_naive(unsigned char* lds, const Params& p, int l) {
    unsigned char* wsl = p.ws; asm volatile("" : "+s"(wsl));
    const bf16_t* Qb = (const bf16_t*)(wsl + WS_B2); bf16_t* O = (bf16_t*)(wsl + WS_B3); const bf16_t* KV = (const bf16_t*)(wsl + WS_KVX) + (size_t)l * MM * 2048;
    const int tidl = tid_l(), lane = tidl & 63, wid = tidl >> 6, gw = blockIdx.x * (NT / 64) + wid, ngw = gridDim.x * (NT / 64);
    float* qs = (float*)lds + wid * 256;
    for (int item = gw; item < M * 4; item += ngw) {
        const int row = item >> 2, h = item & 3, b = row >> 11;
        { const u32x2 w = *((const u32x2*)(Qb + (size_t)row * 1024 + h * 256) + lane);
          qs[4 * lane + 0] = __uint_as_float(w.x << 16); qs[4 * lane + 1] = __uint_as_float(w.x & 0xffff0000u); qs[4 * lane + 2] = __uint_as_float(w.y << 16); qs[4 * lane + 3] = __uint_as_float(w.y & 0xffff0000u); }
        __builtin_amdgcn_wave_barrier();
        float sc[4]; float mx = -3.0e38f;
#pragma unroll
        for (int i = 0; i < 4; ++i) { const int key = lane + 64 * i; const u32x4* kp = (const u32x4*)(KV + (size_t)(b * MEML + key) * 2048 + h * 256); float d = 0.f;
#pragma unroll 4
            for (int c = 0; c < 32; ++c) { const u32x4 w = kp[c]; const float* qq = qs + 8 * c;
                d += qq[0] * __uint_as_float(w.x << 16) + qq[1] * __uint_as_float(w.x & 0xffff0000u) + qq[2] * __uint_as_float(w.y << 16) + qq[3] * __uint_as_float(w.y & 0xffff0000u)
                   + qq[4] * __uint_as_float(w.z << 16) + qq[5] * __uint_as_float(w.z & 0xffff0000u) + qq[6] * __uint_as_float(w.w << 16) + qq[7] * __uint_as_float(w.w & 0xffff0000u); }
            sc[i] = d; mx = fmaxf(mx, d); }
        mx = wave_max(mx);
        float lsum = 0.f;
#pragma unroll
        for (int i = 0; i < 4; ++i) { sc[i] = expf(sc[i] - mx); lsum += sc[i]; }
        lsum = wave_sum(lsum);
        float o[4] = {0.f, 0.f, 0.f, 0.f};
#pragma unroll
        for (int i = 0; i < 4; ++i)
            for (int j = 0; j < 64; ++j) { const int key = 64 * i + j; const float pj = __shfl(sc[i], j); const bf16_t* vp = KV + (size_t)(b * MEML + key) * 2048 + 1024 + h * 256 + lane;
                o[0] += pj * bf2f(vp[0]); o[1] += pj * bf2f(vp[64]); o[2] += pj * bf2f(vp[128]); o[3] += pj * bf2f(vp[192]); }
        const float inv = 1.0f / lsum;
#pragma unroll
        for (int jj = 0; jj < 4; ++jj) O[(size_t)row * 1024 + h * 256 + lane + 64 * jj] = f2bf(o[jj] * inv);
        __builtin_amdgcn_wave_barrier();
    }
}

__device__ __forceinline__ void xattn_units(unsigned char* lds, const Params& p, int l, int unit0, int unit_step) {
    unsigned char* wsl = p.ws; asm volatile("" : "+s"(wsl));
    const bf16_t* Qb = (const bf16_t*)(wsl + WS_B2); bf16_t* O = (bf16_t*)(wsl + WS_B3);
    const bf16_t* KX = (const bf16_t*)(wsl + WS_KVX) + (size_t)l * MM * 1024; const bf16_t* VT = (const bf16_t*)(wsl + WS_VTX) + (size_t)l * 1024 * MM;
    const int tid = tid_l(), lane = tid & 63, wid = tid >> 6, q = lane & 31, h = lane >> 5;
#ifndef XREP_A
#define XREP_A 1
#endif
#ifndef XREP_B
#define XREP_B 1
#endif
#ifndef XREP_S
#define XREP_S 1
#endif
    for (int unit = unit0; unit < 256; unit += unit_step) {
        const int pm = unit >> 2, hd = unit & 3, b = pm >> 3;
        const int row = pm * 256 + wid * 32 + q;
        const bf16_t* qp = Qb + (size_t)row * 1024 + hd * 256 + 8 * h;
#pragma unroll 4
        for (int i = 0; i < 16; ++i) { const int id = tid + 512 * i, key = id >> 5, ch = id & 31;
            const u32x4 w = gld<u32x4>(KX + (size_t)(b * MEML + key) * 1024 + hd * 256 + ch * 8);
            *(u32x4*)(lds + key * 528 + ch * 16) = w; }
        __syncthreads();
        f32x16 sacc[8];
        {
#pragma unroll
        for (int kt = 0; kt < 8; ++kt)
#pragma unroll
            for (int r = 0; r < 16; ++r) sacc[kt][r] = 0.f;
#pragma unroll 4
        for (int ks = 0; ks < 16; ++ks) {
            const s16x8 qf = gld<s16x8>(qp + 16 * ks);
#pragma unroll
            for (int kt = 0; kt < 8; ++kt) { const s16x8 kf = *(const s16x8*)(lds + (32 * kt + q) * 528 + (16 * ks + 8 * h) * 2);
                sacc[kt] = __builtin_amdgcn_mfma_f32_32x32x16_bf16(kf, qf, sacc[kt], 0, 0, 0); }
        }
        }
        float mx = -3.0e38f;
#pragma unroll
        for (int kt = 0; kt < 8; ++kt)
#pragma unroll
            for (int r = 0; r < 16; ++r) mx = fmaxf(mx, sacc[kt][r]);
        mx = fmaxf(mx, __shfl_xor(mx, 32));
        float ls = 0.f;
        s16x8 pf[8][2];
#pragma unroll
        for (int kt = 0; kt < 8; ++kt) {
#pragma unroll
            for (int r = 0; r < 16; ++r) { const float e = __builtin_amdgcn_exp2f(sacc[kt][r] - mx); sacc[kt][r] = e; ls += e; }
#pragma unroll
            for (int s2 = 0; s2 < 2; ++s2) { u32x4 w;
                w.x = cvt_pk_bf16(sacc[kt][8 * s2 + 0], sacc[kt][8 * s2 + 1]); w.y = cvt_pk_bf16(sacc[kt][8 * s2 + 2], sacc[kt][8 * s2 + 3]);
                w.z = cvt_pk_bf16(sacc[kt][8 * s2 + 4], sacc[kt][8 * s2 + 5]); w.w = cvt_pk_bf16(sacc[kt][8 * s2 + 6], sacc[kt][8 * s2 + 7]);
                pf[kt][s2] = __builtin_bit_cast(s16x8, w); }
        }
        ls += __shfl_xor(ls, 32);
        const float inv = 1.0f / ls;
        __syncthreads();
#pragma unroll 8
        for (int i = 0; i < 16; ++i) { const int id = tid + 512 * i, d = id >> 5, ch = id & 31; const u32x4 w = gld<u32x4>(VT + (size_t)(hd * 256 + d) * MM + b * MEML + ch * 8);
            unsigned char* gp_ = lds + d * 528 + (ch >> 1) * 32 + (ch & 1) * 8;
            *(u32x2*)gp_ = (u32x2){w.x, w.y}; *(u32x2*)(gp_ + 16) = (u32x2){w.z, w.w}; }
        __syncthreads();
#pragma unroll 1
        for (int dt = 0; dt < 8; ++dt) {
            f32x16 oacc;
#pragma unroll
            for (int r = 0; r < 16; ++r) oacc[r] = 0.f;
            const unsigned char* vb = lds + (32 * dt + q) * 528 + 16 * h;
#pragma unroll
            for (int kt = 0; kt < 8; ++kt)
#pragma unroll
                for (int s2 = 0; s2 < 2; ++s2) {
                    const s16x8 vf = *(const s16x8*)(vb + (32 * kt + 16 * s2) * 2);
                    oacc = __builtin_amdgcn_mfma_f32_32x32x16_bf16(vf, pf[kt][s2], oacc, 0, 0, 0);
                }
            __syncthreads();
            unsigned char* ow = lds + (32 * dt) * 528 + wid * 2048 + q * 64 + 8 * h;
#pragma unroll
            for (int g = 0; g < 4; ++g) { u32x2 w; w.x = cvt_pk_bf16(oacc[4 * g + 0] * inv, oacc[4 * g + 1] * inv); w.y = cvt_pk_bf16(oacc[4 * g + 2] * inv, oacc[4 * g + 3] * inv);
                *(u32x2*)(ow + 16 * g) = w; }
        }
        __builtin_amdgcn_wave_barrier();
        {
          const unsigned char* orow = lds + ((lane & 31) >> 2) * (32 * 528) + wid * 2048 + (lane & 3) * 16;
          bf16_t* obase = O + (size_t)(pm * 256 + wid * 32) * 1024 + hd * 256 + 8 * (lane & 31);
#pragma unroll
          for (int i = 0; i < 16; ++i) { const int r = (lane >> 5) + 2 * i; gst<u32x4>(obase + (size_t)r * 1024, *(const u32x4*)(orow + r * 64)); }
        }
        __syncthreads();
    }
}

__device__ __forceinline__ void sgu_naive(unsigned char* lds, const Params& p, int i) {
    unsigned char* wsl = p.ws; asm volatile("" : "+s"(wsl));
    bf16_t* U = (bf16_t*)(wsl + WS_B0); const bf16_t* V = (const bf16_t*)(wsl + WS_B1); const bf16_t* G = (const bf16_t*)(wsl + WS_B2); const float* LNS = (const float*)(wsl + WS_LNS);
    const float* lng = p.in[9] + i * 1024; const float* lnb = p.in[10] + i * 1024; const float* Ws = p.in[11] + (size_t)i * 4 * 128 * 128; const float* bs = p.in[12] + i * 4 * 128;
    float* vn = (float*)lds;
    float* mu = vn + 128 * 256;
    float* rsd = mu + 128;
    const int tid = tid_l();
    for (int item = bid_l(); item < 128 * 4; item += gridDim.x) {
        const int chunk = item >> 2, g = item & 3, row0 = chunk * 128;
        if (tid < 128) { float s = 0.f, q = 0.f;
            for (int k = 0; k < 4; ++k) { s += LNS[(size_t)k * M + row0 + tid]; q += LNS[(size_t)(4 + k) * M + row0 + tid]; }
            const float m = s * (1.0f / 1024.f); const float var = q * (1.0f / 1024.f) - m * m; mu[tid] = m; rsd[tid] = rsqrtf(fmaxf(var, 0.f) + EPS); }
        __syncthreads();
#pragma unroll 2
        for (int e = tid; e < 128 * 256; e += NT) { const int j = e >> 8, c = e & 255, col = g * 256 + c;
            vn[e] = (bf2f(V[(size_t)(row0 + j) * 1024 + col]) - mu[j]) * rsd[j] * lng[col] + lnb[col]; }
        __syncthreads();
#pragma unroll 1
        for (int e = tid; e < 128 * 256; e += NT) { const int ii = e >> 8, c = e & 255, col = g * 256 + c; const float* wr = Ws + (size_t)g * 128 * 128 + (size_t)ii * 128;
            float acc = 0.f;
#pragma unroll 4
            for (int j = 0; j <= ii; ++j) acc += wr[j] * vn[j * 256 + c];
            acc += bs[g * 128 + ii];
            const size_t off = (size_t)(row0 + ii) * 1024 + col;
            U[off] = f2bf(bf2f(U[off]) * acc * bf2f(G[off])); }
        __syncthreads();
    }
}

constexpr size_t WS_WP = WS_B2, WS_VP = WS_B2 + 16 * MiB;
__device__ __forceinline__ void xattn_prep(unsigned char* lds, const Params& p, int l) {
    unsigned char* wsl = p.ws; asm volatile("" : "+s"(wsl));
    const bf16_t* KX = (const bf16_t*)(wsl + WS_KVX) + (size_t)l * MM * 1024; const bf16_t* VX = (const bf16_t*)(wsl + WS_VTX) + (size_t)l * MM * 1024;
    const bf16_t* WQ = (const bf16_t*)(wsl + WS_WXQ) + (size_t)l * 1024 * 1024; const bf16_t* WO = (const bf16_t*)(wsl + WS_WXO) + (size_t)l * 1024 * 1024;
    for (int j = bid_l(); j < 256; j += gridDim.x) {
        const int jj = j & 127, b = jj >> 4, hd = (jj >> 2) & 3, t4 = jj & 3;
        const bf16_t* A; const bf16_t* Bt; bf16_t* dst;
        if (j < 128) { A = KX + (size_t)(b * MEML) * 1024 + hd * 256; Bt = WQ + (size_t)(t4 * 256) * 1024 + hd * 256; dst = (bf16_t*)(wsl + WS_WP) + (size_t)(b * 1024 + hd * 256) * 1024 + t4 * 256; }
        else         { A = WO + (size_t)(t4 * 256) * 1024 + hd * 256; Bt = VX + (size_t)(b * MEML) * 1024 + hd * 256; dst = (bf16_t*)(wsl + WS_VP) + (size_t)(b * 1024 + t4 * 256) * 1024 + hd * 256; }
        EpiTile E{dst};
        run_gemm<1>(lds, A, A, 256, Bt, 256, 256, 256, E, 1 << 20, 0, 1 << 20, 0, 1, 0, 1024, 1024);
    }
}
__device__ __forceinline__ void xattn_s(unsigned char* lds, const Params& p) {
    unsigned char* wsl = p.ws; asm volatile("" : "+s"(wsl));
    for (int i = 0;; ++i) {
        const int pu = pg8::static_unit(M, 1024, (int)gridDim.x, bid_l(), i); if (pu < 0) break;
        const int pm = __builtin_amdgcn_readfirstlane(pu >> 16), hd = __builtin_amdgcn_readfirstlane(pu & 65535), b = pm >> 3;
        const bf16_t* A = (const bf16_t*)(wsl + WS_XB) + (size_t)(pm * 256) * 1024;
        EpiSoftmaxP E{(bf16_t*)(wsl + WS_B0) + (size_t)(pm * 256) * 1024 + hd * 256, (const float*)(wsl + WS_RS) + pm * 256, lds + 131072};
        run_gemm<1>(lds, A, A, 1024, (const bf16_t*)(wsl + WS_WP) + (size_t)(b * 1024 + hd * 256) * 1024, 256, 256, 1024, E, 1 << 20, 0, 1 << 20, 0, 1, 0, 1024, 1024);
    }
}
__device__ __forceinline__ void xattn_o(unsigned char* lds, const Params& p, const int dry) {
    unsigned char* wsl = p.ws; asm volatile("" : "+s"(wsl));
    for (int i = 0;; ++i) {
        const int pu = pg8::static_unit(M, 1024, (int)gridDim.x, bid_l(), i); if (pu < 0) break;
        const int pm = __builtin_amdgcn_readfirstlane(pu >> 16), pn = __builtin_amdgcn_readfirstlane(pu & 65535), b = pm >> 3;
        const bf16_t* A = (const bf16_t*)(wsl + WS_B0) + (size_t)(pm * 256) * 1024;
        EpiResid E{(bf16_t*)(wsl + WS_XB) + (size_t)(pm * 256) * 1024 + pn * 256, (float*)(wsl + WS_RS) + (size_t)pn * M + pm * 256, lds + 131072, dry};
        run_gemm<1>(lds, A, A, 1024, (const bf16_t*)(wsl + WS_VP) + (size_t)(b * 1024 + pn * 256) * 1024, 256, 256, 1024, E, 1 << 20, 0, 1 << 20, 0, 1, 0, 1024, 1024);
    }
}

__device__ __forceinline__ void sgu_mfma(unsigned char* lds, const Params& p, int i, const int dry) {
    unsigned char* wsl = p.ws; asm volatile("" : "+s"(wsl));
    bf16_t* U = (bf16_t*)(wsl + WS_B0); const bf16_t* V = (const bf16_t*)(wsl + WS_B1); const bf16_t* G = (const bf16_t*)(wsl + WS_B2); const float* LNS = (const float*)(wsl + WS_LNS);
    const bf16_t* SW = (const bf16_t*)(wsl + WS_SGUW) + (size_t)i * 4 * 128 * 128;
    const float* lng = p.in[9] + i * 1024; const float* lnb = p.in[10] + i * 1024; const float* bs = p.in[12] + i * 4 * 128;
    const int tid = tid_l(), lane = tid & 63, wid = tid >> 6, q = lane & 31, h = lane >> 5;
    float* mu = (float*)(lds + 73728); float* rsd = mu + 128;
    const unsigned tr_base = (unsigned)(size_t)lds + (unsigned)((8 * h + ((lane & 15) >> 2)) * 576 + (32 * wid + 16 * ((lane >> 4) & 1) + 4 * (lane & 3)) * 2);
    for (int item = bid_l(); item < 128 * 4; item += gridDim.x) {
        const int chunk = item >> 2, g = item & 3, row0 = chunk * 128;
        __syncthreads();
        if (tid < 128) { float sm = 0.f, qq = 0.f;
#pragma unroll
            for (int k = 0; k < 4; ++k) { sm += LNS[(size_t)k * M + row0 + tid]; qq += LNS[(size_t)(4 + k) * M + row0 + tid]; }
            const float mm = sm * (1.0f / 1024.f); const float var = qq * (1.0f / 1024.f) - mm * mm; mu[tid] = mm; rsd[tid] = rsqrtf(fmaxf(var, 0.f) + EPS); }
        __syncthreads();
#pragma unroll 2
        for (int k = 0; k < 8; ++k) { const int id = tid + 512 * k, j = id >> 5, c8 = id & 31, col = g * 256 + 8 * c8;
            const u32x4 w = gld<u32x4>(V + (size_t)(row0 + j) * 1024 + col);
            const f32x4 g0 = gld<f32x4>(lng + col), g1 = gld<f32x4>(lng + col + 4), b0 = gld<f32x4>(lnb + col), b1 = gld<f32x4>(lnb + col + 4);
            const float m_ = mu[j], r_ = rsd[j];
            const f32x4 v0 = (f32x4){(bflo(w.x) - m_) * r_ * g0.x + b0.x, (bfhi(w.x) - m_) * r_ * g0.y + b0.y, (bflo(w.y) - m_) * r_ * g0.z + b0.z, (bfhi(w.y) - m_) * r_ * g0.w + b0.w};
            const f32x4 v1 = (f32x4){(bflo(w.z) - m_) * r_ * g1.x + b1.x, (bfhi(w.z) - m_) * r_ * g1.y + b1.y, (bflo(w.w) - m_) * r_ * g1.z + b1.z, (bfhi(w.w) - m_) * r_ * g1.w + b1.w};
            *(u32x4*)(lds + j * 576 + c8 * 16) = pack8(v0, v1); }
        __syncthreads();
        f32x16 acc[4];
#pragma unroll
        for (int it = 0; it < 4; ++it)
#pragma unroll
            for (int e = 0; e < 16; ++e) acc[it][e] = 0.f;
        const bf16_t* wp = SW + (size_t)g * 128 * 128 + (size_t)q * 128 + 8 * h;
#pragma unroll
        for (int ks = 0; ks < 8; ++ks) {
            s16x4 t0, t1; const unsigned a = tr_base + ks * 9216;
            asm volatile("ds_read_b64_tr_b16 %0, %2 offset:0\n\tds_read_b64_tr_b16 %1, %2 offset:2304\n\ts_waitcnt lgkmcnt(0)" : "=&v"(t0), "=&v"(t1) : "v"(a) : "memory");
            const s16x8 vf = __builtin_shufflevector(t0, t1, 0, 1, 2, 3, 4, 5, 6, 7);
#pragma unroll
            for (int it = ks >> 1; it < 4; ++it) { const s16x8 wf = gld<s16x8>(wp + (size_t)(32 * it) * 128 + 16 * ks);
                acc[it] = __builtin_amdgcn_mfma_f32_32x32x16_bf16(vf, wf, acc[it], 0, 0, 0); }
        }
        __syncthreads();
#pragma unroll
        for (int it = 0; it < 4; ++it)
#pragma unroll
            for (int gg = 0; gg < 4; ++gg)
                *(f32x4*)(lds + (32 * it + q) * 1040 + (32 * wid + 8 * gg + 4 * h) * 4) = (f32x4){acc[it][4 * gg + 0], acc[it][4 * gg + 1], acc[it][4 * gg + 2], acc[it][4 * gg + 3]};
        __syncthreads();
#pragma unroll 2
        for (int k = 0; k < 8; ++k) { const int id = tid + 512 * k, ii = id >> 5, c8 = id & 31;
            const size_t off = (size_t)(row0 + ii) * 1024 + g * 256 + 8 * c8;
            const u32x4 uu = gld<u32x4>(U + off), gv = gld<u32x4>(G + off);
            const f32x4 d0 = *(const f32x4*)(lds + ii * 1040 + c8 * 32), d1 = *(const f32x4*)(lds + ii * 1040 + c8 * 32 + 16);
            const float bias = gld<float>(bs + g * 128 + ii);
            const f32x4 o0 = (f32x4){(d0.x + bias) * bflo(uu.x) * bflo(gv.x), (d0.y + bias) * bfhi(uu.x) * bfhi(gv.x), (d0.z + bias) * bflo(uu.y) * bflo(gv.y), (d0.w + bias) * bfhi(uu.y) * bfhi(gv.y)};
            const f32x4 o1 = (f32x4){(d1.x + bias) * bflo(uu.z) * bflo(gv.z), (d1.y + bias) * bfhi(uu.z) * bfhi(gv.z), (d1.z + bias) * bflo(uu.w) * bflo(gv.w), (d1.w + bias) * bfhi(uu.w) * bfhi(gv.w)};
            if (!dry) wst16(U, off * 2, pack8(o0, o1)); }
    }
}
__device__ __forceinline__ void conv_sguw(const Params& p) {
    unsigned char* wsl = p.ws; asm volatile("" : "+s"(wsl));
    bf16_t* SW = (bf16_t*)(wsl + WS_SGUW);
    for (int e = blockIdx.x * NT + tid_l(); e < 2 * 4 * 128 * 128; e += gridDim.x * NT) { const int ii = (e >> 7) & 127, j = e & 127; SW[e] = f2bf(j <= ii ? p.in[11][e] : 0.f); }
}

__device__ __forceinline__ void s5_naive(const Params& p, int i) {
    unsigned char* wsl = p.ws; asm volatile("" : "+s"(wsl));
    bf16_t* XD = (bf16_t*)(wsl + WS_B3);
    const int tidl = tid_l(), lane = tidl & 63, wid = tidl >> 6;
    if (wid != 0) return;
    for (int item = bid_l(); item < BATCH * 32; item += gridDim.x) {
        const int b = item >> 5, g = item & 31;
        const float dt = expf(p.in[15][i * 32 + g]);
        const float ar = p.in[13][(i * 32 + g) * 64 + lane], ai = p.in[14][(i * 32 + g) * 64 + lane];
        const float mag = expf(dt * ar), abr = mag * cosf(dt * ai), abi = mag * sinf(dt * ai);
        const float nr = abr - 1.0f, ni = abi, inv = 1.0f / (ar * ar + ai * ai);
        const float cr = (nr * ar + ni * ai) * inv, ci = (ni * ar - nr * ai) * inv;
        float bbr[16], bbi[16], cre[16], cim[16];
#pragma unroll
        for (int h = 0; h < 16; ++h) {
            const float br = p.in[16][((size_t)(i * 32 + g) * 64 + lane) * 16 + h], bi = p.in[17][((size_t)(i * 32 + g) * 64 + lane) * 16 + h];
            bbr[h] = cr * br - ci * bi; bbi[h] = cr * bi + ci * br;
            cre[h] = p.in[18][((size_t)(i * 32 + g) * 16 + h) * 64 + lane]; cim[h] = p.in[19][((size_t)(i * 32 + g) * 16 + h) * 64 + lane];
        }
        const float dsk = (lane < 16) ? p.in[20][i * 512 + g * 16 + lane] : 0.f;
        float hr = 0.f, hi = 0.f;
#pragma unroll 1
        for (int t = 0; t < SEQ; ++t) {
            bf16_t* up = XD + (size_t)(b * SEQ + t) * 1024 + g * 16;
            const u32x4 w0 = *(const u32x4*)up, w1 = *(const u32x4*)(up + 8);
            float u[16];
            u[0] = __uint_as_float(w0.x << 16); u[1] = __uint_as_float(w0.x & 0xffff0000u); u[2] = __uint_as_float(w0.y << 16); u[3] = __uint_as_float(w0.y & 0xffff0000u);
            u[4] = __uint_as_float(w0.z << 16); u[5] = __uint_as_float(w0.z & 0xffff0000u); u[6] = __uint_as_float(w0.w << 16); u[7] = __uint_as_float(w0.w & 0xffff0000u);
            u[8] = __uint_as_float(w1.x << 16); u[9] = __uint_as_float(w1.x & 0xffff0000u); u[10] = __uint_as_float(w1.y << 16); u[11] = __uint_as_float(w1.y & 0xffff0000u);
            u[12] = __uint_as_float(w1.z << 16); u[13] = __uint_as_float(w1.z & 0xffff0000u); u[14] = __uint_as_float(w1.w << 16); u[15] = __uint_as_float(w1.w & 0xffff0000u);
            float bur = 0.f, bui = 0.f;
#pragma unroll
            for (int h = 0; h < 16; ++h) { bur += u[h] * bbr[h]; bui += u[h] * bbi[h]; }
            const float nhr = abr * hr - abi * hi + bur, nhi = abr * hi + abi * hr + bui; hr = nhr; hi = nhi;
            float mine = 0.f, umine = 0.f;
#pragma unroll
            for (int h = 0; h < 16; ++h) { const float r = wave_sum(hr * cre[h] - hi * cim[h]); if (lane == h) { mine = r; umine = u[h]; } }
            if (lane < 16) up[lane] = f2bf(gelu_tanh_f(mine + dsk * umine));
        }
    }
}

typedef float f32x4v __attribute__((ext_vector_type(4)));
typedef float f32x2v_ __attribute__((ext_vector_type(2)));
template <int PASS>
__device__ __forceinline__ void s5_pass(float& hr, float& hi, const float (&pwr)[4], const float (&pwi)[4], const pg8::bf16x8 (&bfrag)[8], const pg8::bf16x8 (&cfrag)[4], const f32x4v dsk,
                                        bf16_t* XD, unsigned char* BUw, unsigned char* Hw, int b, int g, int wid, int lane, int tl, int kq, const int dry) {
            bf16_t* ubase = XD + (size_t)(b * SEQ + wid * 256 + tl) * 1024 + g * 16;
            pg8::bf16x8 ufn[2]; u32x2 uen[2];
#pragma unroll
            for (int k2 = 0; k2 < 2; ++k2) { ufn[k2] = (pg8::bf16x8){0, 0, 0, 0, 0, 0, 0, 0}; uen[k2] = (u32x2){0u, 0u};
                if (kq < 2) ufn[k2] = gld<pg8::bf16x8>(ubase + (size_t)(16 * k2) * 1024 + 8 * kq);
                if constexpr (PASS == 1) uen[k2] = gld<u32x2>(ubase + (size_t)(16 * k2) * 1024 + 4 * kq); }
#pragma unroll 1
            for (int tt = 0; tt < 16; ++tt) {
                bf16_t* urow = ubase + (size_t)(16 * tt) * 1024;
                const pg8::bf16x8 ufrag = ufn[0]; const u32x2 ue = uen[0];
                ufn[0] = ufn[1]; uen[0] = uen[1];
                if (tt + 2 < 16) { if (kq < 2) ufn[1] = gld<pg8::bf16x8>(urow + (size_t)32 * 1024 + 8 * kq); if constexpr (PASS == 1) uen[1] = gld<u32x2>(urow + (size_t)32 * 1024 + 4 * kq); }
#pragma unroll
                for (int rt = 0; rt < 8; ++rt) {
                    const f32x4 d = __builtin_amdgcn_mfma_f32_16x16x32_bf16(bfrag[rt], ufrag, (f32x4){0.f, 0.f, 0.f, 0.f}, 0, 0, 0);
                    *(u32x2*)(BUw + tl * 272 + (8 * rt + 2 * kq) * 4) = (u32x2){cvt_pk_bf16(d.x, d.y), cvt_pk_bf16(d.z, d.w)};
                }
                __builtin_amdgcn_wave_barrier();
                float bur[16], bui[16];
#pragma unroll
                for (int t = 0; t < 16; ++t) { const unsigned bw = *(const unsigned*)(BUw + t * 272 + lane * 4); bur[t] = bflo(bw); bui[t] = bfhi(bw); }
#pragma unroll
                for (int j = 0; j < 4; ++j)
#pragma unroll
                    for (int i2 = 1; i2 < 4; ++i2) { const int t = 4 * j + i2;
                        const float lr = fmaf(pwr[0], bur[t - 1], fmaf(-pwi[0], bui[t - 1], bur[t])), li = fmaf(pwr[0], bui[t - 1], fmaf(pwi[0], bur[t - 1], bui[t])); bur[t] = lr; bui[t] = li; }
#pragma unroll
                for (int j = 0; j < 4; ++j) {
                    const float cr = hr, ci = hi;
#pragma unroll
                    for (int i2 = 0; i2 < 4; ++i2) { const int t = 4 * j + i2;
                        const float xr = fmaf(pwr[i2], cr, fmaf(-pwi[i2], ci, bur[t])), xi = fmaf(pwr[i2], ci, fmaf(pwi[i2], cr, bui[t]));
                        if constexpr (PASS == 1) *(unsigned*)(Hw + t * 272 + lane * 4) = cvt_pk_bf16(xr, xi);
                        if (i2 == 3) { hr = xr; hi = xi; } }
                }
                if constexpr (PASS == 1) {
                    __builtin_amdgcn_wave_barrier();
                    f32x4 y = (f32x4){0.f, 0.f, 0.f, 0.f};
#pragma unroll
                    for (int kk = 0; kk < 4; ++kk) { const pg8::bf16x8 hf = *(const pg8::bf16x8*)(Hw + tl * 272 + (32 * kk + 8 * kq) * 2);
                        y = __builtin_amdgcn_mfma_f32_16x16x32_bf16(cfrag[kk], hf, y, 0, 0, 0); }
                    float yy[4] = {y.x + dsk.x * bflo(ue.x), y.y + dsk.y * bfhi(ue.x), y.z + dsk.z * bflo(ue.y), y.w + dsk.w * bfhi(ue.y)};
#pragma unroll
                    for (int r = 0; r < 4; ++r) { const float x = yy[r]; yy[r] = x * fsigmoid(1.5957691216057308f * (x + 0.044715f * x * x * x)); }
                    u32x2 w; w.x = cvt_pk_bf16(yy[0], yy[1]); w.y = cvt_pk_bf16(yy[2], yy[3]);
                    if (!dry) gst<u32x2>(urow + 4 * kq, w);
                }
                __builtin_amdgcn_wave_barrier();
            }
}
__device__ __forceinline__ void s5_mfma(unsigned char* lds, const Params& p, int i, const int dry) {
    unsigned char* wsl = p.ws; asm volatile("" : "+s"(wsl));
    bf16_t* XD = (bf16_t*)(wsl + WS_B3);
    const int tid = tid_l(), lane = tid & 63, wid = tid >> 6, tl = lane & 15, kq = lane >> 4;
    bf16_t* TB = (bf16_t*)lds;
    bf16_t* TC = (bf16_t*)(lds + 4096);
    float* AB = (float*)(lds + 8192);
    float* A256 = (float*)(lds + 8704);
    float* HE = (float*)(lds + 9216);
    unsigned char* BUw = lds + 16384 + wid * 12800;
    unsigned char* Hw = BUw + 8448;
    for (int item = bid_l(); item < BATCH * 32; item += gridDim.x) {
        const int b = item >> 5, g = item & 31;
        __syncthreads();
        if (tid < 64) {
            const int pp = tid;
            const float dt = expf(p.in[15][i * 32 + g]);
            const float ar = p.in[13][(i * 32 + g) * 64 + pp], ai = p.in[14][(i * 32 + g) * 64 + pp];
            const float mag = expf(dt * ar), abr = mag * cosf(dt * ai), abi = mag * sinf(dt * ai);
            const float nr = abr - 1.0f, ni = abi, inv = 1.0f / (ar * ar + ai * ai);
            const float cr = (nr * ar + ni * ai) * inv, ci = (ni * ar - nr * ai) * inv;
#pragma unroll
            for (int h = 0; h < 16; ++h) {
                const float br = p.in[16][((size_t)(i * 32 + g) * 64 + pp) * 16 + h], bi = p.in[17][((size_t)(i * 32 + g) * 64 + pp) * 16 + h];
                TB[(2 * pp) * 16 + h] = f2bf(cr * br - ci * bi); TB[(2 * pp + 1) * 16 + h] = f2bf(cr * bi + ci * br);
                TC[h * 128 + 2 * pp] = f2bf(p.in[18][((size_t)(i * 32 + g) * 16 + h) * 64 + pp]); TC[h * 128 + 2 * pp + 1] = f2bf(-p.in[19][((size_t)(i * 32 + g) * 16 + h) * 64 + pp]);
            }
            AB[pp] = abr; AB[64 + pp] = abi;
            float xr = abr, xi = abi;
#pragma unroll
            for (int k = 0; k < 8; ++k) { const float t2 = xr * xr - xi * xi; xi = 2.0f * xr * xi; xr = t2; }
            A256[pp] = xr; A256[64 + pp] = xi;
        }
        __syncthreads();
        const float abr = AB[lane], abi = AB[64 + lane];
        float pwr[4], pwi[4]; pwr[0] = abr; pwi[0] = abi;
#pragma unroll
        for (int k = 1; k < 4; ++k) { pwr[k] = pwr[k - 1] * abr - pwi[k - 1] * abi; pwi[k] = pwr[k - 1] * abi + pwi[k - 1] * abr; }
        pg8::bf16x8 bfrag[8], cfrag[4];
#pragma unroll
        for (int rt = 0; rt < 8; ++rt) { if (kq < 2) bfrag[rt] = *(const pg8::bf16x8*)(TB + (16 * rt + tl) * 16 + 8 * kq); else bfrag[rt] = (pg8::bf16x8){0, 0, 0, 0, 0, 0, 0, 0}; }
#pragma unroll
        for (int kk = 0; kk < 4; ++kk) cfrag[kk] = *(const pg8::bf16x8*)(TC + tl * 128 + 32 * kk + 8 * kq);
        const f32x4v dsk = *(const f32x4v*)(p.in[20] + i * 512 + g * 16 + 4 * kq);
        float hr = 0.f, hi = 0.f;
#pragma unroll 1
        for (int pass = 0; pass < 2; ++pass) {
            if (pass == 1) {
                HE[(wid * 2 + 0) * 64 + lane] = hr; HE[(wid * 2 + 1) * 64 + lane] = hi;
                __syncthreads();
                const float a2r = A256[lane], a2i = A256[64 + lane];
                hr = 0.f; hi = 0.f;
                for (int w2 = 0; w2 < wid; ++w2) { const float er = HE[(w2 * 2 + 0) * 64 + lane], ei = HE[(w2 * 2 + 1) * 64 + lane];
                    const float nr2 = a2r * hr - a2i * hi + er, ni2 = a2r * hi + a2i * hr + ei; hr = nr2; hi = ni2; }
            }
            if (pass == 0) s5_pass<0>(hr, hi, pwr, pwi, bfrag, cfrag, dsk, XD, BUw, Hw, b, g, wid, lane, tl, kq, dry);
            else s5_pass<1>(hr, hi, pwr, pwi, bfrag, cfrag, dsk, XD, BUw, Hw, b, g, wid, lane, tl, kq, dry);
        }
    }
}

__device__ __forceinline__ void final_norm(const Params& p) {
    unsigned char* wsl = p.ws; asm volatile("" : "+s"(wsl));
    const bf16_t* XB = (const bf16_t*)(wsl + WS_XB);
    const int tidl = tid_l(), lane = tidl & 63, gw = blockIdx.x * (NT / 64) + (tidl >> 6), ngw = gridDim.x * (NT / 64);
    for (int row = gw; row < M; row += ngw) {
        const u32x4 a = gld<u32x4>(XB + (size_t)row * DM + 8 * lane), c = gld<u32x4>(XB + (size_t)row * DM + 512 + 8 * lane);
        float v[16] = {bflo(a.x), bfhi(a.x), bflo(a.y), bfhi(a.y), bflo(a.z), bfhi(a.z), bflo(a.w), bfhi(a.w), bflo(c.x), bfhi(c.x), bflo(c.y), bfhi(c.y), bflo(c.z), bfhi(c.z), bflo(c.w), bfhi(c.w)};
        float s = 0.f;
#pragma unroll
        for (int j = 0; j < 16; ++j) s += v[j] * v[j];
        s = wave_sum(s); const float r = rsqrtf(s * (1.0f / DM) + EPS);
        const float* gp = p.in[29] + 8 * lane; float* op = p.out + (size_t)row * DM + 8 * lane;
#pragma unroll
        for (int hh = 0; hh < 2; ++hh) { const f32x4 g0 = gld<f32x4>(gp + 512 * hh), g1 = gld<f32x4>(gp + 512 * hh + 4);
            gst<f32x4>(op + 512 * hh, (f32x4){v[8 * hh + 0] * r * g0.x, v[8 * hh + 1] * r * g0.y, v[8 * hh + 2] * r * g0.z, v[8 * hh + 3] * r * g0.w});
            gst<f32x4>(op + 512 * hh + 4, (f32x4){v[8 * hh + 4] * r * g1.x, v[8 * hh + 5] * r * g1.y, v[8 * hh + 6] * r * g1.z, v[8 * hh + 7] * r * g1.w}); }
    }
}

#define WSL(name) unsigned char* name = p.ws; asm volatile("" : "+s"(name))
#define PBF(ws_, off) ((bf16_t*)((ws_) + (off)))
#define PF32(ws_, off) ((float*)((ws_) + (off)))
#ifndef F_KV
#define F_KV 1
#endif
#ifndef F_G1
#define F_G1 1
#endif
#ifndef F_G1U
#define F_G1U 1
#endif
#ifndef F_GG
#define F_GG 1
#endif
#ifndef F_G2
#define F_G2 1
#endif
#ifndef F_G1O
#define F_G1O 1
#endif
#ifndef F_GLU
#define F_GLU 1
#endif
#ifndef F_G2O
#define F_G2O 1
#endif
#ifndef F_G3
#define F_G3 1
#endif
#ifndef F_G4
#define F_G4 1
#endif
#define XB_TMO      128
#define XB_XCNT(j)  (256  + 64 * (j))
#define XB_XSUB(j)  (1280 + 64 * (j))
#define XB_XGEN(j)  (2304 + 64 * (j))
#define XB_TOP      3328
#define XB_TOPGEN   3392
#define XCD_BAR_WORDS 3456
#define XB_SPIN_CAP (1u << 22)
__device__ __forceinline__ unsigned xb_ld(unsigned* p)              { return __hip_atomic_load(p, __ATOMIC_RELAXED, __HIP_MEMORY_SCOPE_AGENT); }
__device__ __forceinline__ unsigned xb_add(unsigned* p, unsigned v) { return __hip_atomic_fetch_add(p, v, __ATOMIC_RELAXED, __HIP_MEMORY_SCOPE_AGENT); }
__device__ __forceinline__ unsigned xb_xcc_id() { return (unsigned)__builtin_amdgcn_s_getreg((3 << 11) | 20) & 0xFu; }
#define XB_SPIN(cond, bar) do { unsigned _sp = 0; while (cond) { __builtin_amdgcn_s_sleep(1); \
    if ((++_sp & 255u) == 0u) { if (xb_ld(&(bar)[XB_TMO])) break; if (_sp > XB_SPIN_CAP) { atomicAdd(&(bar)[XB_TMO], 1u); break; } } } } while (0)
struct XcdBarrier { unsigned* bar; unsigned x; volatile PG8_LAS unsigned* st; };
__device__ __forceinline__ XcdBarrier xcd_barrier_post(unsigned* bar, volatile PG8_LAS unsigned* st) {
    XcdBarrier b; b.bar = bar; b.x = xb_xcc_id(); b.st = st;
    if (threadIdx.x == 0) (void)xb_add(&bar[XB_XCNT(b.x)], 1u);
    return b;
}
__device__ __forceinline__ void xcd_barrier_complete(unsigned* bar, unsigned x, unsigned& nloc, unsigned& nx) {
    const unsigned G = gridDim.x * gridDim.y * gridDim.z;
    unsigned sum, cnt, mine, sp = 0u;
    for (;;) {
        sum = 0u; cnt = 0u; mine = 0u;
#pragma unroll
        for (unsigned j = 0; j < 16; ++j) { const unsigned c = xb_ld(&bar[XB_XCNT(j)]); sum += c; cnt += (c > 0u) ? 1u : 0u; mine = (j == x) ? c : mine; }
        if (sum == G) break;
        __builtin_amdgcn_s_sleep(1);
        if ((++sp & 255u) == 0u) { if (xb_ld(&bar[XB_TMO])) break; if (sp > XB_SPIN_CAP) { atomicAdd(&bar[XB_TMO], 1u); break; } }
    }
    nloc = mine > 0u ? mine : 1u; nx = cnt > 0u ? cnt : 1u;
}
__device__ __forceinline__ void xcd_barrier(const XcdBarrier& b, const bool release = true) {
    asm volatile("s_waitcnt vmcnt(0)" ::: "memory");
    __syncthreads();
    if (threadIdx.x == 0) {
        unsigned* bar = b.bar;
        __builtin_amdgcn_s_waitcnt(0);
        unsigned nloc = b.st[0], nx = b.st[1];
        if (nloc == 0u) { xcd_barrier_complete(bar, b.x, nloc, nx); b.st[0] = nloc; b.st[1] = nx; }
        const unsigned old = xb_add(&bar[XB_XSUB(b.x)], 1u);
        const unsigned gen = old / nloc;
        if (old + 1u == (gen + 1u) * nloc) {
            if (release) { __builtin_amdgcn_fence(__ATOMIC_RELEASE, "agent"); asm volatile("s_waitcnt vmcnt(0)" ::: "memory"); }
            const unsigned og = xb_add(&bar[XB_TOP], 1u);
            const unsigned tg = og / nx;
            if (og + 1u != (tg + 1u) * nx) XB_SPIN(xb_ld(&bar[XB_TOP]) < (tg + 1u) * nx, bar);
            __builtin_amdgcn_fence(__ATOMIC_ACQUIRE, "agent");
            xb_add(&bar[XB_XGEN(b.x)], 1u);
            asm volatile("s_waitcnt vmcnt(0)" ::: "memory");
        } else {
            XB_SPIN(xb_ld(&bar[XB_XGEN(b.x)]) == gen, bar);
            __builtin_amdgcn_fence(__ATOMIC_ACQUIRE, "agent");
            asm volatile("s_waitcnt vmcnt(0)" ::: "memory");
        }
    }
    __syncthreads();
}

#ifndef REPEAT_MASK
#define REPEAT_MASK 0
#endif
#ifndef SYNC_REP
#define SYNC_REP 1
#endif
#define REPN(ty) (((REPEAT_MASK >> (ty)) & 1) ? 2 : 1)
#define RUN(ty, ...) do { for (int rep_ = 0; rep_ < REPN(ty); ++rep_) { int dry = rep_; asm volatile("" : "+s"(dry)); __VA_ARGS__ } } while (0)
#define GSYNC() do { for (int sr_ = 0; sr_ < SYNC_REP; ++sr_) xcd_barrier(xbar); } while (0)
#ifndef WT_SYNC
#define WT_SYNC 1
#endif
#define GSYNC_WT() do { for (int sr_ = 0; sr_ < SYNC_REP; ++sr_) xcd_barrier(xbar, !WT_SYNC); } while (0)
__global__ void __launch_bounds__(NT) mega(Params p) {
    extern __shared__ __attribute__((aligned(16))) unsigned char lds[];
    if (threadIdx.x < 2) ((volatile PG8_LAS unsigned*)((PG8_LAS unsigned char*)lds + 143360))[threadIdx.x] = 0u;
    __syncthreads();
    const XcdBarrier xbar = xcd_barrier_post((unsigned*)p.ws, (volatile PG8_LAS unsigned*)((PG8_LAS unsigned char*)lds + 143360));
    constexpr size_t SEG = (size_t)(WS_B1 - WS_B0) / 2;

    RUN(0, {
        WSL(ws);
#ifndef PREP
#define PREP 0
#endif
        init_rows(p); if (PREP & 1) init_rows(p);
        cvt_wvb(p);
        cvt_wxqn(p);
        conv_sguw(p);
        for (int pr_ = 0; pr_ < ((PREP & 4) ? 2 : 1); ++pr_) {
        int tc = 0;
        for (int l = 0; l < 4; ++l) conv_job(lds, p.in[26] + (size_t)l * 1024 * 2048, 2048, 0, 2048, 1024, PBF(ws, WS_WKVT) + (size_t)l * 2048 * 1024, nullptr, 1.0f, tc);
        conv_inproj(lds, p, 0, tc);
        for (int ig = 0; ig < 8; ++ig) conv_job(lds, p.in[4] + (size_t)ig * 256 * 256, 256, 0, 256, 256, PBF(ws, WS_PWT) + (size_t)ig * 256 * 256, nullptr, 1.0f, tc);
        for (int i = 0; i < 2; ++i) conv_job(lds, p.in[6] + (size_t)i * 2048 * 1024, 1024, 0, 1024, 2048, PBF(ws, WS_WOAB) + (size_t)i * 1024 * 2048, nullptr, 1.0f, tc);
        for (int i = 0; i < 2; ++i) conv_job(lds, p.in[23] + (size_t)i * 1536 * 1024, 1024, 0, 1024, 1536, PBF(ws, WS_WOCD) + (size_t)i * 1024 * 1536, nullptr, 1.0f, tc);
        for (int l = 0; l < 4; ++l) conv_job(lds, p.in[27] + (size_t)l * 1024 * 1024, 1024, 0, 1024, 1024, PBF(ws, WS_WXO) + (size_t)l * 1024 * 1024, nullptr, 1.0f, tc);
        for (int i = 0; i < 2; ++i)
            for (int j = 0; j < 4; ++j) {
                conv_job(lds, p.in[21] + (size_t)i * 512 * 512, 512, 128 * j, 128, 512, PBF(ws, WS_GLU) + (size_t)i * 1024 * 512 + (size_t)(256 * j) * 512, nullptr, 1.0f, tc);
                conv_job(lds, p.in[22] + (size_t)i * 512 * 512, 512, 128 * j, 128, 512, PBF(ws, WS_GLU) + (size_t)i * 1024 * 512 + (size_t)(256 * j + 128) * 512, nullptr, 1.0f, tc);
            }
        }
        (void)dry;
    });
    GSYNC();
    RUN(1, {
        WSL(ws);
        for (int ig = 0; ig < 8; ++ig) { const int vcf = (int)blockIdx.x - 4 * ig;
            EpiFold E{PBF(ws, WS_WUT) + (size_t)(ig >> 2) * 1024 * WIN_LD + (size_t)(ig & 3) * 256 * WIN_LD, p.in[5] + (ig >> 2) * 1024 + (ig & 3) * 256};
            run_gemm<1>(lds, PBF(ws, WS_PWT) + (size_t)ig * 256 * 256, PBF(ws, WS_PWT) + (size_t)ig * 256 * 256, 256, PBF(ws, WS_WVB) + (size_t)ig * 1024 * 256, 256, 1024, 256, E, 1 << 20, 0, 1 << 20, 0, 4, (vcf >= 0 && vcf < 4) ? vcf : -1, 256); }
        const int hg = (int)gridDim.x >> 1;
        { EpiProj E{PBF(ws, WS_KVX), (size_t)MM * 1024, nullptr, 0u, nullptr, -1, 0, 1024, nullptr}; run_gemm<F_KV>(lds, PBF(ws, WS_MEMNB), PBF(ws, WS_MEMNB), 1024, PBF(ws, WS_WKVT), MM, 4096, 1024, E, 1 << 20, 0, 4, 4, hg, (int)blockIdx.x < hg ? (int)blockIdx.x : -1); }
        { EpiProj E{PBF(ws, WS_VTX), (size_t)MM * 1024, nullptr, 0u, nullptr, -1, 0, 1024, nullptr}; run_gemm<F_KV>(lds, PBF(ws, WS_MEMNB), PBF(ws, WS_MEMNB), 1024, PBF(ws, WS_WKVT) + (size_t)1024 * 1024, MM, 4096, 1024, E, 1 << 20, 0, 4, 4, hg, (int)blockIdx.x >= hg ? (int)blockIdx.x - hg : -1); }
        (void)dry;
    });
    GSYNC();

#pragma unroll 1
    for (int l = 0; l < 4; ++l) {
        const int i = l >> 1;
        if ((l & 1) == 0) {
            RUN(2, {
            { WSL(ws); EpiProj E{PBF(ws, WS_B0), SEG, PF32(ws, WS_RS), 0u, nullptr, -1, 1, 1024, nullptr, 7u, (bf16_t*)p.out};
              run_gemm<F_G1, EpiProj, false>(lds, PBF(ws, WS_XB), PBF(ws, WS_XB), 1024, PBF(ws, WS_WIN), M, 4096, 1024, E, 1 << 20, 0, 1 << 20, 0, 0, 0, 1024, WIN_LD, PBF(ws, WS_WUT) + (size_t)i * 1024 * WIN_LD, 12); }
            (void)dry; });
            GSYNC();
            RUN(3, { dil_attn_mfma(lds, p, dry); });
            GSYNC();
            RUN(4, { WSL(ws); EpiGates E{EpiGateA{PBF(ws, WS_B0), PF32(ws, WS_RS), dry}, EpiGateB{PBF(ws, WS_B1), PBF(ws, WS_B3), PF32(ws, WS_RS), dry}};
                     run_gemm<F_GG>(lds, PBF(ws, WS_XB), PBF(ws, WS_XB), 1024, PBF(ws, WS_WIN) + (size_t)3072 * WIN_LD, M, 2048, 1024, E, 1 << 20, 0, 1 << 20, 0, 0, 0, 1024, WIN_LD); });
            GSYNC();
            RUN(5, { WSL(ws); EpiResid E{PBF(ws, WS_XB), PF32(ws, WS_RS), lds + 131072, dry}; run_gemm<F_G2>(lds, PBF(ws, WS_B0), PBF(ws, WS_B1), 1024, PBF(ws, WS_WOAB) + (size_t)i * 1024 * 2048, M, 1024, 2048, E); });
        } else {
            RUN(6, { WSL(ws); EpiProj E{PBF(ws, WS_B0), SEG, PF32(ws, WS_RS), (3u << 4) | (2u << 6), PF32(ws, WS_LNS), 1, 1, 1024, lds + 131072}; run_gemm<F_G1O, EpiProj, false>(lds, PBF(ws, WS_XB), PBF(ws, WS_XB), 1024, PBF(ws, WS_WIN), M, 4096, 1024, E, 1 << 20, 0, 1 << 20, 0, 0, 0, 1024, WIN_LD); (void)dry; });
            GSYNC();
            RUN(7, { s5_mfma(lds, p, i, dry); __syncthreads(); });
            RUN(13, { sgu_mfma(lds, p, i, dry); __syncthreads(); });
            GSYNC();
            RUN(8, { WSL(ws); EpiGlu E{PBF(ws, WS_B3) + 512, dry}; run_gemm<F_GLU>(lds, PBF(ws, WS_B3), PBF(ws, WS_B3), 512, PBF(ws, WS_GLU) + (size_t)i * 1024 * 512, M, 1024, 512, E); });
            GSYNC();
            RUN(9, { WSL(ws); EpiResid E{PBF(ws, WS_XB), PF32(ws, WS_RS), lds + 131072, dry}; run_gemm<F_G2O>(lds, PBF(ws, WS_B0), PBF(ws, WS_B3) + 512, 1024, PBF(ws, WS_WOCD) + (size_t)i * 1024 * 1536, M, 1024, 1536, E); });
        }
        RUN(10, { xattn_prep(lds, p, l); (void)dry; });
        GSYNC_WT();
        RUN(11, {
            { int tc = 0; if (l < 3) conv_inproj(lds, p, l + 1, tc); }
            __syncthreads();
            xattn_s(lds, p);
            (void)dry; });
        GSYNC_WT();
        RUN(12, { xattn_o(lds, p, dry); });
        GSYNC_WT();
    }
    final_norm(p);
}

extern "C" void kernel_launch(void* const* d_in, const int* in_sizes, int n_in, void* d_out, int out_size, void* d_ws, size_t ws_size, hipStream_t stream) {
    static int grid = 0;
    if (grid == 0) {
        if (n_in != 30 || out_size != M * DM || ws_size < WS_END) { fprintf(stderr, "kernel_launch: unexpected shapes n_in %d out %d ws %zu\n", n_in, out_size, ws_size); grid = -1; return; }
        int dev = 0, cus = 0, per_cu = 0;
        (void)hipGetDevice(&dev);
        (void)hipDeviceGetAttribute(&cus, hipDeviceAttributeMultiprocessorCount, dev);
        (void)hipFuncSetAttribute((const void*)mega, hipFuncAttributeMaxDynamicSharedMemorySize, LDS_BYTES);
        (void)hipOccupancyMaxActiveBlocksPerMultiprocessor(&per_cu, (const void*)mega, NT, LDS_BYTES);
        if (per_cu < 1) per_cu = 1;
        grid = cus * per_cu;
    }
    if (grid < 0) return;
    Params p{};
    for (int i = 0; i < 30; ++i) p.in[i] = (const float*)d_in[i];
    p.out = (float*)d_out; p.ws = (unsigned char*)d_ws;
    (void)hipMemsetAsync(d_ws, 0, 16384, stream);
    void* args[] = {&p};
    hipError_t e = hipLaunchCooperativeKernel((void*)mega, dim3(grid), dim3(NT), args, LDS_BYTES, stream);
    if (e != hipSuccess) fprintf(stderr, "cooperative launch failed: %s (grid %d)\n", hipGetErrorString(e), grid);
}
```

```cpp
#include <hip/hip_runtime.h>
#include <hip/hip_cooperative_groups.h>
#include <cstdio>
#include <cstdint>
namespace cg = cooperative_groups;

typedef unsigned short bf16_t;
typedef float f32x4 __attribute__((ext_vector_type(4)));
typedef unsigned u32x4 __attribute__((ext_vector_type(4)));
typedef unsigned u32x2 __attribute__((ext_vector_type(2)));

constexpr int BATCH = 8, SEQ = 2048, DM = 1024, M = BATCH * SEQ, MEML = 256, MM = BATCH * MEML;
constexpr float EPS = 1e-6f;
constexpr int NT = 512;
constexpr int LDS_BYTES = 147456;

constexpr size_t MiB = 1u << 20;
constexpr size_t WS_RS = 1 * MiB;
constexpr size_t WS_LNS = 2 * MiB;
constexpr size_t WS_SGUW = 3 * MiB;
constexpr size_t WS_S5W = 4 * MiB;
constexpr size_t WS_XB = 8 * MiB;
constexpr size_t WS_B0 = 40 * MiB, WS_B1 = 72 * MiB, WS_B2 = 104 * MiB, WS_B3 = 136 * MiB;
constexpr size_t WS_KVX = 168 * MiB;
constexpr size_t WS_VTX = 184 * MiB;
constexpr int WIN_LD = 1088;
constexpr size_t WS_WIN = 200 * MiB;
constexpr size_t WS_WUT = 248 * MiB;
constexpr size_t WS_WOAB = 216 * MiB;
constexpr size_t WS_WOCD = 224 * MiB;
constexpr size_t WS_WXQ = 230 * MiB;
constexpr size_t WS_WXO = 238 * MiB;
constexpr size_t WS_GLU = 246 * MiB;
constexpr size_t WS_END = 253 * MiB;
constexpr size_t WS_WKVT = WS_B0;
constexpr size_t WS_MEMNB = WS_B1;
constexpr size_t WS_PWT = WS_B2;
constexpr size_t WS_WVB = WS_B2 + 2 * MiB;

struct Params { const float* in[30]; float* out; unsigned char* ws; };

#define GAS __attribute__((address_space(1)))
template <class T> __device__ __forceinline__ T gld(const void* p) { return *(const GAS T*)p; }
template <class T> __device__ __forceinline__ void gst(void* p, T v) { *(GAS T*)p = v; }
#ifndef POOL_SLIDE
#define POOL_SLIDE 1
#endif
#ifndef POOL_NP
#define POOL_NP 4
#endif
#ifndef S5_XCD_MAP
#define S5_XCD_MAP 1
#endif
#ifndef S5_MFMA_PASS0
#define S5_MFMA_PASS0 1
#endif
#ifndef ABL
#define ABL 0
#endif
#ifndef FUSE_FINAL
#define FUSE_FINAL 1
#endif
#ifndef WT_STORES
#define WT_STORES 1
#endif
__device__ __forceinline__ void wst8(void* base, size_t off, u32x2 v) {
#if WT_STORES
    const __amdgpu_buffer_rsrc_t r = __builtin_amdgcn_make_buffer_rsrc(base, (short)0, 0x7fffffff, 0x00020000);
    __builtin_amdgcn_raw_buffer_store_b64(v, r, (unsigned)off, 0, 16);
#else
    *(GAS u32x2*)((unsigned char*)base + off) = v;
#endif
}
__device__ __forceinline__ void wst4(void* base, size_t off, float v) {
    const __amdgpu_buffer_rsrc_t r = __builtin_amdgcn_make_buffer_rsrc(base, (short)0, 0x7fffffff, 0x00020000);
    __builtin_amdgcn_raw_buffer_store_b32(__float_as_uint(v), r, (unsigned)off, 0, 16);
}
__device__ __forceinline__ void wst16(void* base, size_t off, u32x4 v) {
#if WT_STORES
    const __amdgpu_buffer_rsrc_t r = __builtin_amdgcn_make_buffer_rsrc(base, (short)0, 0x7fffffff, 0x00020000);
    __builtin_amdgcn_raw_buffer_store_b128(v, r, (unsigned)off, 0, 16);
#else
    *(GAS u32x4*)((unsigned char*)base + off) = v;
#endif
}
__device__ __forceinline__ void st16(void* base, size_t off, u32x4 v, const bool wt) { if (wt) wst16(base, off, v); else *(GAS u32x4*)((unsigned char*)base + off) = v; }
__device__ __forceinline__ int tid_l() { int t = threadIdx.x; asm volatile("" : "+v"(t)); return t; }
__device__ __forceinline__ int bid_l() { int b = blockIdx.x; asm volatile("" : "+s"(b)); return b; }
__device__ __forceinline__ float quad_rows_sum(float v) {
    { const auto r = __builtin_amdgcn_permlane16_swap(__float_as_uint(v), __float_as_uint(v), false, false); v = __uint_as_float(r[0]) + __uint_as_float(r[1]); }
    { const auto r = __builtin_amdgcn_permlane32_swap(__float_as_uint(v), __float_as_uint(v), false, false); v = __uint_as_float(r[0]) + __uint_as_float(r[1]); }
    return v;
}
__device__ __forceinline__ float quad_rows_max(float v) {
    { const auto r = __builtin_amdgcn_permlane16_swap(__float_as_uint(v), __float_as_uint(v), false, false); v = fmaxf(__uint_as_float(r[0]), __uint_as_float(r[1])); }
    { const auto r = __builtin_amdgcn_permlane32_swap(__float_as_uint(v), __float_as_uint(v), false, false); v = fmaxf(__uint_as_float(r[0]), __uint_as_float(r[1])); }
    return v;
}
__device__ __forceinline__ float bf2f(bf16_t v) { return __uint_as_float(((unsigned)v) << 16); }
__device__ __forceinline__ bf16_t f2bf(float f) { unsigned u = __float_as_uint(f); u += 0x7fffu + ((u >> 16) & 1u); return (bf16_t)(u >> 16); }
__device__ __forceinline__ float wave_sum(float v) {
#pragma unroll
    for (int o = 1; o < 64; o <<= 1) v += __shfl_xor(v, o);
    return v;
}
__device__ __forceinline__ float wave_max(float v) {
#pragma unroll
    for (int o = 1; o < 64; o <<= 1) v = fmaxf(v, __shfl_xor(v, o));
    return v;
}
__device__ __forceinline__ float half_sum32(float v) {
#pragma unroll
    for (int o = 1; o < 32; o <<= 1) v += __shfl_xor(v, o);
    return v;
}
__device__ __forceinline__ float silu_f(float x) { return x / (1.0f + expf(-x)); }
__device__ __forceinline__ float sigmoid_f(float x) { return 1.0f / (1.0f + expf(-x)); }
__device__ __forceinline__ float gelu_tanh_f(float x) { return 0.5f * x * (1.0f + tanhf(0.7978845608028654f * (x + 0.044715f * x * x * x))); }
__device__ __forceinline__ float rstd_of(const float* RS, int row) { return rsqrtf(((gld<float>(RS + row) + gld<float>(RS + M + row)) + (gld<float>(RS + 2 * M + row) + gld<float>(RS + 3 * M + row))) * (1.0f / DM) + EPS); }
__device__ __forceinline__ float fsilu(float x) { return x * __builtin_amdgcn_rcpf(1.0f + __builtin_amdgcn_exp2f(-1.4426950408889634f * x)); }
__device__ __forceinline__ float fsigmoid(float x) { return __builtin_amdgcn_rcpf(1.0f + __builtin_amdgcn_exp2f(-1.4426950408889634f * x)); }
typedef float cvt_f32x2 __attribute__((ext_vector_type(2)));
typedef __bf16 cvt_bf16x2 __attribute__((ext_vector_type(2)));
__device__ __forceinline__ unsigned cvt_pk_bf16(float lo, float hi) { const cvt_f32x2 v = {lo, hi}; return __builtin_bit_cast(unsigned, __builtin_convertvector(v, cvt_bf16x2)); }
__device__ __forceinline__ float bflo(unsigned w) { return __uint_as_float(w << 16); }
__device__ __forceinline__ float bfhi(unsigned w) { return __uint_as_float(w & 0xffff0000u); }

__device__ __forceinline__ void conv_job(unsigned char* lds, const float* src, int ldn, int n0, int Nrows, int K, bf16_t* dst, const float* rs, float scale, int& tc, int ldd = 0, const bool wt = true) {
    if (ldd == 0) ldd = K;
    const int tid = tid_l(), lane = tid & 63, wid = tid >> 6;
    float* T = (float*)lds + wid * (64 * 65);
    const int nnt = Nrows / 64, ntile = (K / 64) * nnt, gw = blockIdx.x * (NT / 64) + wid, ngw = gridDim.x * (NT / 64);
    const int r4 = lane >> 4, c16 = lane & 15;
    for (int t = ((gw - tc) % ngw + ngw) % ngw; t < ntile; t += ngw) {
        const int kt = t / nnt, nt = t % nnt, k0 = kt * 64, nn0 = nt * 64;
        f32x4 v[16];
#pragma unroll
        for (int i = 0; i < 16; ++i) v[i] = gld<f32x4>(src + (size_t)(k0 + r4 + 4 * i) * ldn + n0 + nn0 + 4 * c16);
#pragma unroll
        for (int i = 0; i < 16; ++i) { const int kk = r4 + 4 * i; const float sc = rs ? scale * gld<float>(rs + k0 + kk) : scale; float* tp = T + kk * 65 + 4 * c16;
            tp[0] = v[i].x * sc; tp[1] = v[i].y * sc; tp[2] = v[i].z * sc; tp[3] = v[i].w * sc; }
        __builtin_amdgcn_wave_barrier();
#pragma unroll
        for (int j = 0; j < 8; ++j) { const int nn = (lane >> 3) + 8 * j, kc = (lane & 7) * 8; const float* tp = T + kc * 65 + nn; u32x4 o;
            o.x = cvt_pk_bf16(tp[0], tp[65]); o.y = cvt_pk_bf16(tp[2 * 65], tp[3 * 65]); o.z = cvt_pk_bf16(tp[4 * 65], tp[5 * 65]); o.w = cvt_pk_bf16(tp[6 * 65], tp[7 * 65]);
            st16(dst, ((size_t)(nn0 + nn) * ldd + k0 + kc) * 2, o, wt); }
        __builtin_amdgcn_wave_barrier();
    }
    tc += ntile;
}

__device__ __forceinline__ void conv_inproj(unsigned char* lds, const Params& p, int l, int& tc, const bool wt = true) {
    unsigned char* wsl = p.ws; asm volatile("" : "+s"(wsl));
    bf16_t* W = (bf16_t*)(wsl + WS_WIN);
    const int i = l >> 1;
    if ((l & 1) == 0) {
        const float* src = p.in[3] + (size_t)i * 1024 * 6144; const float* g = p.in[2] + i * 1024;
        conv_job(lds, src, 6144, 0, 1024, 1024, W, g, 0.125f * 1.4426950408889634f, tc, WIN_LD, wt);
        conv_job(lds, src, 6144, 1024, 3072, 1024, W + (size_t)1024 * WIN_LD, g, 1.0f, tc, WIN_LD, wt);
        conv_job(lds, src, 6144, 5120, 1024, 1024, W + (size_t)4096 * WIN_LD, g, 1.0f, tc, WIN_LD, wt);
    } else {
        const float* src = p.in[8] + (size_t)i * 1024 * 4096; const float* g = p.in[7] + i * 1024;
        for (int j = 0; j < 8; ++j) {
            conv_job(lds, src, 4096, 128 * j, 128, 1024, W + (size_t)(256 * j) * WIN_LD, g, 1.0f, tc, WIN_LD, wt);
            conv_job(lds, src, 4096, 2048 + 128 * j, 128, 1024, W + (size_t)(256 * j + 128) * WIN_LD, g, 1.0f, tc, WIN_LD, wt); }
        conv_job(lds, src, 4096, 1024, 1024, 1024, W + (size_t)2048 * WIN_LD, g, 1.0f, tc, WIN_LD, wt);
        conv_job(lds, src, 4096, 3072, 1024, 1024, W + (size_t)3072 * WIN_LD, g, 1.0f, tc, WIN_LD, wt);
    }
}

template <class Epi>
__device__ __forceinline__ void ngemm(unsigned char* lds, const bf16_t* A1, const bf16_t* A2, int K1, int lda, const bf16_t* Bt, int Mrows, int N, int K, const Epi& E) {
    float* As = (float*)lds;
    float* Bs = As + 32 * 68;
    const int tid = tid_l(), tx = tid & 31, ty = tid >> 5;
    const int ntm = Mrows / 64, ntn = N / 256;
    for (int tile = blockIdx.x; tile < ntm * ntn; tile += gridDim.x) {
        const int tm = tile % ntm, tn = tile / ntm;
        float acc[4][8];
#pragma unroll
        for (int r = 0; r < 4; ++r)
#pragma unroll
            for (int j = 0; j < 8; ++j) acc[r][j] = 0.f;
        for (int k0 = 0; k0 < K; k0 += 32) {
            { const int r = tid >> 3, kc = (tid & 7) * 4;
              const bf16_t* ap = (k0 < K1) ? (A1 + (size_t)(tm * 64 + r) * lda + k0 + kc) : (A2 + (size_t)(tm * 64 + r) * lda + (k0 - K1) + kc);
              const u32x2 w = *(const u32x2*)ap;
              As[(kc + 0) * 68 + r] = __uint_as_float(w.x << 16); As[(kc + 1) * 68 + r] = __uint_as_float(w.x & 0xffff0000u);
              As[(kc + 2) * 68 + r] = __uint_as_float(w.y << 16); As[(kc + 3) * 68 + r] = __uint_as_float(w.y & 0xffff0000u); }
            { const int n = tid >> 1, kc = (tid & 1) * 16;
              const bf16_t* bp = Bt + (size_t)(tn * 256 + n) * K + k0 + kc;
#pragma unroll
              for (int h = 0; h < 2; ++h) { const u32x4 w = *(const u32x4*)(bp + 8 * h); const int kk = kc + 8 * h;
                  Bs[(kk + 0) * 260 + n] = __uint_as_float(w.x << 16); Bs[(kk + 1) * 260 + n] = __uint_as_float(w.x & 0xffff0000u);
                  Bs[(kk + 2) * 260 + n] = __uint_as_float(w.y << 16); Bs[(kk + 3) * 260 + n] = __uint_as_float(w.y & 0xffff0000u);
                  Bs[(kk + 4) * 260 + n] = __uint_as_float(w.z << 16); Bs[(kk + 5) * 260 + n] = __uint_as_float(w.z & 0xffff0000u);
                  Bs[(kk + 6) * 260 + n] = __uint_as_float(w.w << 16); Bs[(kk + 7) * 260 + n] = __uint_as_float(w.w & 0xffff0000u); } }
            __syncthreads();
#pragma unroll 8
            for (int k = 0; k < 32; ++k) {
                const f32x4 a = *(const f32x4*)(As + k * 68 + ty * 4);
                float b[8];
#pragma unroll
                for (int j = 0; j < 8; ++j) b[j] = Bs[k * 260 + tx + 32 * j];
#pragma unroll
                for (int j = 0; j < 8; ++j) { acc[0][j] += a.x * b[j]; acc[1][j] += a.y * b[j]; acc[2][j] += a.z * b[j]; acc[3][j] += a.w * b[j]; }
            }
            __syncthreads();
        }
#pragma unroll
        for (int r = 0; r < 4; ++r) E.row(tm * 64 + ty * 4 + r, tn * 256 + tx, acc[r]);
    }
}

namespace pg8 {
#define PG8_LAS __attribute__((address_space(3)))
typedef short bf16x8 __attribute__((ext_vector_type(8)));
constexpr int BM = 256, BK = 64, HALF = 128, HTB = HALF * BK * 2, STAGE_BYTES = 8 * HTB, NXCD = 8, WGM = 8;
__host__ __device__ __forceinline__ int lds_byte(int r, int c) { const int st = (r >> 4) * 2 + (c >> 5), rr = r & 15, cc = c & 31, ob = rr * 64 + cc * 2; return st * 1024 + (ob ^ (((ob >> 9) & 1) << 5)); }
__host__ __device__ __forceinline__ void stage_rc(int b, int& R, int& C) { const int st = b / 1024, sb = b % 1024, swz = sb ^ (((sb >> 9) & 1) << 5); R = (st >> 1) * 16 + swz / 64; C = (st & 1) * 32 + (swz % 64) / 2; }
__host__ __device__ __forceinline__ int perm32(int rho) { const int n = rho >> 4, i = rho & 15; return 8 * (i >> 2) + 4 * n + (i & 3); }
struct Unit { int pm, pn; };
struct Gemm { const bf16_t* A1; const bf16_t* A2; int nt1; int lda; const bf16_t* Bt; int M, N, K; int a_grp, a_skip, b_grp, b_skip; int vG, vc; int ldb; const bf16_t* Bt2; int nsplit; };
struct StaticOrder {
    int nM, nN, nwg, G, c;
    __device__ void init(int M_, int N_, int G_, int c_) { nM = M_ / BM; nN = N_ / BM; nwg = nM * nN; G = G_; c = c_; }
    __device__ bool next(int i, Unit& u) const {
        const long L = (long)i * G + c; if (L >= nwg) return false;
        int wgid = (int)L; { const int q = nwg / NXCD, r = nwg % NXCD, xcd = wgid % NXCD, off = wgid / NXCD; wgid = (xcd < r ? xcd * (q + 1) : r * (q + 1) + (xcd - r) * q) + off; }
        const int nig = WGM * nN, gid = wgid / nig, fm = gid * WGM, gsz = (nM - fm) < WGM ? (nM - fm) : WGM;
        u.pm = fm + ((wgid % nig) % gsz); u.pn = (wgid % nig) / gsz; return true;
    }
};
__device__ __forceinline__ int static_unit(int M_, int N_, int G, int c, int i) {
    const int nM = M_ / BM, nN = N_ / BM, nwg = nM * nN; const long L = (long)i * G + c; if (L >= nwg) return -1;
    int wgid = (int)L; { const int q = nwg / NXCD, r = nwg % NXCD, xcd = wgid % NXCD, off = wgid / NXCD; wgid = (xcd < r ? xcd * (q + 1) : r * (q + 1) + (xcd - r) * q) + off; }
    const int nig = WGM * nN, gid = wgid / nig, fm = gid * WGM, gsz = (nM - fm) < WGM ? (nM - fm) : WGM;
    return (fm + ((wgid % nig) % gsz)) * 65536 + (wgid % nig) / gsz;
}
template <class Epi, bool TAIL = true>
__device__ __forceinline__ void gemm_phase(PG8_LAS unsigned char* lds, const Gemm g, const Epi& E) {
    const int tid = tid_l(), wid = __builtin_amdgcn_readfirstlane(tid >> 6), lane = tid & 63, wr = wid >> 2, wc = wid & 3, fr = lane & 15, fq = lane >> 4;
    if (g.vG > 0 && g.vc < 0) return;
    StaticOrder S; S.init(g.M, g.N, g.vG > 0 ? g.vG : (int)gridDim.x, g.vG > 0 ? g.vc : bid_l());
    const int K = g.K, nt = K / BK, nt1 = g.nt1;
    unsigned voffA[2], voffB[2];
#pragma unroll
    for (int i = 0; i < 2; ++i) { int R, C; stage_rc(tid * 16 + i * 8192, R, C); const int Rb = (R & ~31) + perm32(R & 31);
        voffA[i] = (unsigned)(R * g.lda + C) * 2u; voffB[i] = (unsigned)(Rb * g.ldb + C) * 2u; }
    const size_t kstep = (size_t)(BK * 2);
    const size_t hstepA = (size_t)HALF * g.lda * 2, tstepA = 2 * hstepA;
    const size_t hstepB = (size_t)HALF * g.ldb * 2, tstepB = 2 * hstepB;
    const unsigned ldsw = (unsigned)wid * 1024u;
    const int aoff = lds_byte(wr * 64 + fr, fq * 8), boff = lds_byte(wc * 32 + fr, fq * 8);
#define PG8_SA(b, h) (((b) * 2 + (h)) * HTB)
#define PG8_SB(b, h) ((4 + (b) * 2 + (h)) * HTB)
#define PG8_STAGE(bufoff, gbase, voff) do { _Pragma("unroll") for (int _i = 0; _i < 2; ++_i) \
        __builtin_amdgcn_global_load_lds((const unsigned*)((const char*)(gbase) + (voff)[_i]), (PG8_LAS unsigned*)(lds + (bufoff) + ldsw + _i * 8192), 16, 0, 0); } while (0)
#define PG8_LDA(dst, b, h) do { _Pragma("unroll") for (int m = 0; m < 4; ++m) _Pragma("unroll") for (int k = 0; k < 2; ++k) dst[m][k] = *(const PG8_LAS bf16x8*)(lds + PG8_SA(b, h) + aoff + m * 2048 + k * 1024); } while (0)
#define PG8_LDB(dst, b, h) do { _Pragma("unroll") for (int n = 0; n < 2; ++n) _Pragma("unroll") for (int k = 0; k < 2; ++k) dst[n][k] = *(const PG8_LAS bf16x8*)(lds + PG8_SB(b, h) + boff + n * 2048 + k * 1024); } while (0)
#define PG8_MMA(ai, bj, At, Bt) do { __builtin_amdgcn_s_setprio(1); _Pragma("unroll") for (int m = 0; m < 4; ++m) _Pragma("unroll") for (int n = 0; n < 2; ++n) _Pragma("unroll") for (int k = 0; k < 2; ++k) \
        acc[ai][bj][m][n] = __builtin_amdgcn_mfma_f32_16x16x32_bf16(Bt[n][k], At[m][k], acc[ai][bj][m][n], 0, 0, 0); __builtin_amdgcn_s_setprio(0); } while (0)
#define PG8_WAIT_V(n) asm volatile("s_waitcnt vmcnt(" #n ")" ::: "memory")
#define PG8_WAIT_L(n) asm volatile("s_waitcnt lgkmcnt(" #n ")" ::: "memory")
#define PG8_BAR __builtin_amdgcn_s_barrier()
#define PG8_SCHED __builtin_amdgcn_sched_barrier(0)
    Unit cur, nxt; int ui = 0;
    if (!S.next(0, cur)) return;
    PG8_LAS float* rtab = (PG8_LAS float*)(lds + 139264);
    if constexpr (Epi::HAS_ROWSCALE) {
        Unit tu;
        for (int i = 0; i < 4 && S.next(i, tu); ++i) if (tid < 256) rtab[i * 256 + tid] = E.row_scale(tu.pm * 256 + tid);
        asm volatile("s_waitcnt vmcnt(0) lgkmcnt(0)" ::: "memory"); __builtin_amdgcn_s_barrier();
    }
    f32x4 acc[2][2][4][2];
#pragma unroll
    for (int a = 0; a < 2; ++a)
#pragma unroll
        for (int b = 0; b < 2; ++b)
#pragma unroll
            for (int m = 0; m < 4; ++m)
#pragma unroll
                for (int n = 0; n < 2; ++n) acc[a][b][m][n] = (f32x4){0.f, 0.f, 0.f, 0.f};
    bf16x8 At[4][2], B0[2][2], B1[2][2];
#define PG8_TA(pm_) ((size_t)((pm_) + ((pm_) / g.a_grp) * g.a_skip) * tstepA)
#define PG8_TB(pn_) ((size_t)((pn_) + ((pn_) / g.b_grp) * g.b_skip) * tstepB)
#define PG8_BP(pn_) ((pn_) < g.nsplit ? (const char*)g.Bt + PG8_TB(pn_) : (const char*)g.Bt2 + PG8_TB((pn_) - g.nsplit))
    const char* cA1 = (const char*)g.A1 + PG8_TA(cur.pm); const char* cA2 = (const char*)g.A2 + PG8_TA(cur.pm) - (size_t)nt1 * kstep; const char* cB = PG8_BP(cur.pn);
    PG8_STAGE(PG8_SB(0, 0), cB, voffB); PG8_STAGE(PG8_SB(0, 1), cB + hstepB, voffB); PG8_STAGE(PG8_SA(0, 0), cA1, voffA); PG8_STAGE(PG8_SA(0, 1), cA1 + hstepA, voffA);
    if (wr == 1) PG8_BAR;
    PG8_WAIT_V(2); PG8_BAR;
    PG8_STAGE(PG8_SB(1, 0), cB + kstep, voffB); PG8_STAGE(PG8_SA(1, 0), cA1 + kstep, voffA); PG8_STAGE(PG8_SB(1, 1), cB + hstepB + kstep, voffB);
    PG8_WAIT_V(6); PG8_BAR;
    for (;;) {
        const bool has_next = S.next(ui + 1, nxt);
        const char* nA1 = has_next ? (const char*)g.A1 + PG8_TA(nxt.pm) : cA1; const char* nA2 = has_next ? (const char*)g.A2 + PG8_TA(nxt.pm) - (size_t)nt1 * kstep : cA2;
        const char* nB = has_next ? PG8_BP(nxt.pn) : cB;
        for (int t = 0; t < nt; t += 2) {
            const bool last = (t == nt - 2);
            const char* a1 = ((t + 1 < nt1) ? cA1 : cA2) + (size_t)(t + 1) * kstep;
            const char* a2 = last ? nA1 : ((t + 2 < nt1) ? cA1 : cA2) + (size_t)(t + 2) * kstep; const char* b2 = last ? nB : cB + (size_t)(t + 2) * kstep;
            const char* a3 = a2 + kstep; const char* b3 = b2 + kstep;
            const bool tail = TAIL && last && !has_next;
            PG8_LDB(B0, 0, 0); PG8_LDB(B1, 0, 1); PG8_SCHED; PG8_LDA(At, 0, 0); PG8_STAGE(PG8_SA(1, 1), a1 + hstepA, voffA);
            PG8_WAIT_V(8); PG8_WAIT_L(0); PG8_BAR; PG8_MMA(0, 0, At, B0); PG8_MMA(0, 1, At, B1); PG8_BAR; PG8_SCHED;
            PG8_LDA(At, 0, 1);
            if (!tail) { PG8_STAGE(PG8_SB(0, 0), b2, voffB); PG8_STAGE(PG8_SB(0, 1), b2 + hstepB, voffB); PG8_STAGE(PG8_SA(0, 0), a2, voffA); PG8_WAIT_V(8); } else { PG8_WAIT_V(2); }
            PG8_WAIT_L(0); PG8_BAR; PG8_MMA(1, 0, At, B0); PG8_MMA(1, 1, At, B1); PG8_BAR; PG8_SCHED;
            PG8_LDB(B0, 1, 0); PG8_LDB(B1, 1, 1); PG8_SCHED; PG8_LDA(At, 1, 0);
            if (!tail) { PG8_STAGE(PG8_SA(0, 1), a2 + hstepA, voffA); PG8_WAIT_V(8); } else { PG8_WAIT_V(0); }
            PG8_WAIT_L(0); PG8_BAR; PG8_MMA(0, 0, At, B0); PG8_MMA(0, 1, At, B1); PG8_BAR; PG8_SCHED;
            PG8_LDA(At, 1, 1);
            if (!tail) { PG8_STAGE(PG8_SB(1, 0), b3, voffB); PG8_STAGE(PG8_SB(1, 1), b3 + hstepB, voffB); PG8_STAGE(PG8_SA(1, 0), a3, voffA); PG8_WAIT_V(8); }
            PG8_WAIT_L(0); PG8_BAR; PG8_MMA(1, 0, At, B0); PG8_MMA(1, 1, At, B1); PG8_BAR; PG8_SCHED;
        }
        if (wr == 0) PG8_BAR;
#ifndef EPI_REP
#define EPI_REP 1
#endif
        if constexpr (Epi::MUTATES) { E.mut(acc, cur, wr, wc, fr, fq); }
        else if constexpr (Epi::HAS_ROWSCALE) { E.scaled(acc, cur, wr, wc, fr, fq, ui < 4 ? rtab + ui * 256 : (PG8_LAS float*)nullptr, !has_next); }
        else if constexpr (Epi::HAS_FUSED) { if (has_next) E(acc, cur, wr, wc, fr, fq); } else { E(acc, cur, wr, wc, fr, fq); if constexpr (Epi::IDEMPOTENT && EPI_REP > 1) { int er_ = 1; asm volatile("" : "+s"(er_)); if (er_) E(acc, cur, wr, wc, fr, fq); } }
        if (!has_next) break;
#pragma unroll
        for (int a = 0; a < 2; ++a)
#pragma unroll
            for (int b = 0; b < 2; ++b)
#pragma unroll
                for (int m = 0; m < 4; ++m)
#pragma unroll
                    for (int n = 0; n < 2; ++n) acc[a][b][m][n] = (f32x4){0.f, 0.f, 0.f, 0.f};
        cur = nxt; cA1 = nA1; cA2 = nA2; cB = nB; ++ui;
        if (wr == 1) PG8_BAR;
    }
    PG8_WAIT_V(0);
    PG8_BAR;
    if constexpr (Epi::HAS_FUSED) E.fused(acc, cur, wr, wc, fr, fq, lds);
#undef PG8_TA
#undef PG8_TB
#undef PG8_BP
#undef PG8_SA
#undef PG8_SB
#undef PG8_STAGE
#undef PG8_LDA
#undef PG8_LDB
#undef PG8_MMA
#undef PG8_WAIT_V
#undef PG8_WAIT_L
#undef PG8_BAR
#undef PG8_SCHED
}
}
typedef f32x4 AccT[2][2][4][2];

__device__ __forceinline__ u32x4 pack8(const f32x4 a, const f32x4 b) { u32x4 w; w.x = cvt_pk_bf16(a.x, a.y); w.y = cvt_pk_bf16(a.z, a.w); w.z = cvt_pk_bf16(b.x, b.y); w.w = cvt_pk_bf16(b.z, b.w); return w; }
struct EpiProj {
    static constexpr bool MUTATES = false;
    static constexpr bool HAS_ROWSCALE = true;
    static constexpr bool IDEMPOTENT = true;
    static constexpr bool HAS_FUSED = false;
    bf16_t* dst0; size_t seg_stride; const float* RS; unsigned silu_bits; float* LNS; int lns_seg; int use_rstd; int pitch; unsigned char* scr; unsigned hm_bits = 0u; bf16_t* seg0 = nullptr;
    __device__ __forceinline__ void row(int row, int colbase, float (&v)[8]) const {
        const float rs = use_rstd ? rstd_of(RS, row) : 1.0f;
        float s0 = 0.f, q0 = 0.f;
#pragma unroll
        for (int j = 0; j < 8; ++j) {
            const int col = colbase + 32 * j, seg = col >> 10, c = col & 1023;
            float x = v[j] * rs;
            s0 += x; q0 += x * x;
            if ((silu_bits >> (2 * seg + (c >> 9))) & 1u) x = silu_f(x);
            dst0[(size_t)seg * seg_stride + (((hm_bits >> seg) & 1u) ? ((size_t)(((row >> 11) * 16 + (c >> 6)) * 2048 + (row & 2047)) * 64 + (c & 63)) : ((size_t)row * pitch + c))] = f2bf(x);
        }
        if (LNS) {
            const int seg = colbase >> 10;
            if (seg == lns_seg) {
                s0 = half_sum32(s0); q0 = half_sum32(q0);
                if ((threadIdx.x & 31) == 0) { const int slot = (colbase & 1023) >> 8; LNS[(size_t)slot * M + row] = s0; LNS[(size_t)(4 + slot) * M + row] = q0; }
            }
        }
    }
    __device__ __forceinline__ float row_scale(int row) const { return use_rstd ? rstd_of(RS, row) : 1.0f; }
    __device__ __forceinline__ void operator()(const AccT& acc, const pg8::Unit& u, int wr, int wc, int fr, int fq) const { scaled(acc, u, wr, wc, fr, fq, (PG8_LAS float*)nullptr, true); }
    __device__ __forceinline__ void scaled(const AccT& acc, const pg8::Unit& u, int wr, int wc, int fr, int fq, PG8_LAS float* rtab, const bool wt) const {
        const int colt = u.pn * 256, seg = colt >> 10, cb = (colt & 1023) + wc * 32 + 8 * fq, row0 = u.pm * 256 + wr * 64 + fr;
        bf16_t* base = (seg == 0 && seg0) ? seg0 : dst0 + (size_t)seg * seg_stride;
        const bool st = (LNS != nullptr) && (seg == lns_seg);
        const bool act = (silu_bits >> (2 * seg + ((colt & 1023) >> 9))) & 1u;
        const bool hm = (hm_bits >> seg) & 1u;
        PG8_LAS float* P = (PG8_LAS float*)scr;
#pragma unroll
        for (int ai = 0; ai < 2; ++ai)
#pragma unroll
            for (int m = 0; m < 4; ++m) {
                const int row = row0 + ai * 128 + m * 16; const float rs = rtab ? rtab[ai * 128 + wr * 64 + m * 16 + fr] : row_scale(row);
                float s = 0.f, q = 0.f;
#pragma unroll
                for (int bj = 0; bj < 2; ++bj) {
                    f32x4 v0 = acc[ai][bj][m][0] * rs, v1 = acc[ai][bj][m][1] * rs;
                    if (st) { s += (v0.x + v0.y) + (v0.z + v0.w) + (v1.x + v1.y) + (v1.z + v1.w);
                              q += (v0.x * v0.x + v0.y * v0.y) + (v0.z * v0.z + v0.w * v0.w) + (v1.x * v1.x + v1.y * v1.y) + (v1.z * v1.z + v1.w * v1.w); }
                    if (act) { v0.x = fsilu(v0.x); v0.y = fsilu(v0.y); v0.z = fsilu(v0.z); v0.w = fsilu(v0.w); v1.x = fsilu(v1.x); v1.y = fsilu(v1.y); v1.z = fsilu(v1.z); v1.w = fsilu(v1.w); }
                    { const int c_ = cb + 128 * bj; const size_t off_ = hm ? ((size_t)(((row >> 11) * 16 + (c_ >> 6)) * 2048 + (row & 2047)) * 64 + (c_ & 63)) : ((size_t)row * pitch + c_);
                      if (wt) wst16(base, off_ * 2, pack8(v0, v1)); else gst<u32x4>((unsigned char*)base + off_ * 2, pack8(v0, v1)); }
                }
                if (st) { s = quad_rows_sum(s); q = quad_rows_sum(q);
                          if (fq == 0) { const int rl = ai * 128 + wr * 64 + m * 16 + fr; P[(rl * 4 + wc) * 2] = s; P[(rl * 4 + wc) * 2 + 1] = q; } }
            }
        if (st) {
            asm volatile("s_waitcnt lgkmcnt(0)" ::: "memory"); __builtin_amdgcn_s_barrier(); asm volatile("" ::: "memory");
            const int t = (wr * 4 + wc) * 64 + fr + 16 * fq;
            if (t < 256) { const float s = (P[(t * 4 + 0) * 2] + P[(t * 4 + 1) * 2]) + (P[(t * 4 + 2) * 2] + P[(t * 4 + 3) * 2]);
                           const float q = (P[(t * 4 + 0) * 2 + 1] + P[(t * 4 + 1) * 2 + 1]) + (P[(t * 4 + 2) * 2 + 1] + P[(t * 4 + 3) * 2 + 1]);
                           const int slot = (colt & 1023) >> 8; gst<float>(LNS + (size_t)slot * M + u.pm * 256 + t, s); gst<float>(LNS + (size_t)(4 + slot) * M + u.pm * 256 + t, q); }
        }
    }
};
struct EpiKV {
    static constexpr bool MUTATES = false;
    static constexpr bool HAS_ROWSCALE = false;
    static constexpr bool IDEMPOTENT = true;
    static constexpr bool HAS_FUSED = false;
    bf16_t* dst;
    __device__ __forceinline__ void row(int row, int colbase, float (&v)[8]) const {
#pragma unroll
        for (int j = 0; j < 8; ++j) { const int col = colbase + 32 * j; dst[(size_t)(col >> 11) * MM * 2048 + (size_t)row * 2048 + (col & 2047)] = f2bf(v[j]); }
    }
    __device__ __forceinline__ void operator()(const AccT& acc, const pg8::Unit& u, int wr, int wc, int fr, int fq) const {
        const int l = u.pn >> 3, cb = (u.pn & 7) * 256 + wc * 32 + 8 * fq, row0 = u.pm * 256 + wr * 64 + fr;
        bf16_t* base = dst + (size_t)l * MM * 2048;
#pragma unroll
        for (int ai = 0; ai < 2; ++ai)
#pragma unroll
            for (int m = 0; m < 4; ++m) { const int row = row0 + ai * 128 + m * 16;
#pragma unroll
                for (int bj = 0; bj < 2; ++bj) *(u32x4*)(base + (size_t)row * 2048 + cb + 128 * bj) = pack8(acc[ai][bj][m][0], acc[ai][bj][m][1]); }
    }
};
struct EpiGateA {
    static constexpr bool MUTATES = false;
    static constexpr bool HAS_ROWSCALE = false;
    static constexpr bool IDEMPOTENT = false;
    static constexpr bool HAS_FUSED = false;
    bf16_t* A0; const float* RS; int dry; bool wt = true;
    __device__ __forceinline__ void row(int row, int colbase, float (&v)[8]) const {
        const float rs = rstd_of(RS, row);
#pragma unroll
        for (int j = 0; j < 8; ++j) { bf16_t* q = A0 + (size_t)row * 1024 + colbase + 32 * j; *q = f2bf(bf2f(*q) * silu_f(v[j] * rs)); }
    }
    __device__ __forceinline__ void operator()(const AccT& acc, const pg8::Unit& u, int wr, int wc, int fr, int fq) const {
        const int cb = u.pn * 256 + wc * 32 + 8 * fq, row0 = u.pm * 256 + wr * 64 + fr;
#pragma unroll
        for (int ai = 0; ai < 2; ++ai) {
            float rsv[4]; u32x4 av[4][2];
#pragma unroll
            for (int m = 0; m < 4; ++m) { const int row = row0 + ai * 128 + m * 16; rsv[m] = rstd_of(RS, row);
#pragma unroll
                for (int bj = 0; bj < 2; ++bj) av[m][bj] = gld<u32x4>(A0 + (size_t)row * 1024 + cb + 128 * bj); }
#pragma unroll
            for (int m = 0; m < 4; ++m) {
                const int row = row0 + ai * 128 + m * 16; const float rs = rsv[m];
#pragma unroll
                for (int bj = 0; bj < 2; ++bj) {
                    f32x4 g0 = acc[ai][bj][m][0] * rs, g1 = acc[ai][bj][m][1] * rs;
                    g0.x = fsilu(g0.x); g0.y = fsilu(g0.y); g0.z = fsilu(g0.z); g0.w = fsilu(g0.w); g1.x = fsilu(g1.x); g1.y = fsilu(g1.y); g1.z = fsilu(g1.z); g1.w = fsilu(g1.w);
                    const size_t off = (size_t)row * 1024 + cb + 128 * bj;
                    const u32x4 a = av[m][bj];
                    const f32x4 o0 = (f32x4){bflo(a.x) * g0.x, bfhi(a.x) * g0.y, bflo(a.y) * g0.z, bfhi(a.y) * g0.w}, o1 = (f32x4){bflo(a.z) * g1.x, bfhi(a.z) * g1.y, bflo(a.w) * g1.z, bfhi(a.w) * g1.w};
                    if (!dry) st16(A0, off * 2, pack8(o0, o1), wt);
                }
            }
        }
    }
};
__device__ __forceinline__ float poolop(const bf16_t* U, int row, int c) {
    const int w = 2 << (c >> 8), t = row & (SEQ - 1), n = (t + 1 < w) ? (t + 1) : w;
    float s = 0.f;
    for (int i = 0; i < n; ++i) s += bf2f(U[(size_t)(row - i) * 1024 + c]);
    return s / (float)n - bf2f(U[(size_t)row * 1024 + c]);
}
struct EpiGateB {
    static constexpr bool MUTATES = false;
    static constexpr bool HAS_ROWSCALE = false;
    static constexpr bool IDEMPOTENT = false;
    static constexpr bool HAS_FUSED = true;
    bf16_t* A1; const bf16_t* U; const float* RS; int dry;
    __device__ __forceinline__ void row(int row, int colbase, float (&v)[8]) const {
        const float rs = rstd_of(RS, row);
#pragma unroll
        for (int j = 0; j < 8; ++j) { const int c = colbase + 32 * j; A1[(size_t)row * 1024 + c] = f2bf(poolop(U, row, c) * silu_f(v[j] * rs)); }
    }
    __device__ __forceinline__ void operator()(const AccT& acc, const pg8::Unit& u, int wr, int wc, int fr, int fq) const {
        const int cb = u.pn * 256 + wc * 32 + 8 * fq, row0 = u.pm * 256 + wr * 64 + fr, w = 2 << u.pn;
#pragma unroll
        for (int ai = 0; ai < 2; ++ai)
#pragma unroll
            for (int m = 0; m < 4; ++m) {
                const int row = row0 + ai * 128 + m * 16; const float rs = rstd_of(RS, row);
#pragma unroll
                for (int bj = 0; bj < 2; ++bj) {
                    f32x4 g0 = acc[ai][bj][m][0] * rs, g1 = acc[ai][bj][m][1] * rs;
                    g0.x = fsilu(g0.x); g0.y = fsilu(g0.y); g0.z = fsilu(g0.z); g0.w = fsilu(g0.w); g1.x = fsilu(g1.x); g1.y = fsilu(g1.y); g1.z = fsilu(g1.z); g1.w = fsilu(g1.w);
                    const size_t off = (size_t)row * 1024 + cb + 128 * bj;
                    const int t = row & (SEQ - 1), n = (t + 1 < w) ? (t + 1) : w;
                    const u32x4 c = gld<u32x4>(U + off);
                    f32x4 s0 = (f32x4){bflo(c.x), bfhi(c.x), bflo(c.y), bfhi(c.y)}, s1 = (f32x4){bflo(c.z), bfhi(c.z), bflo(c.w), bfhi(c.w)};
                    const f32x4 c0 = s0, c1 = s1;
                    for (int i = 1; i < w; ++i) if (i <= t) { const u32x4 a = gld<u32x4>(U + off - (size_t)i * 1024);
                        s0 += (f32x4){bflo(a.x), bfhi(a.x), bflo(a.y), bfhi(a.y)}; s1 += (f32x4){bflo(a.z), bfhi(a.z), bflo(a.w), bfhi(a.w)}; }
                    const float inv = 1.0f / (float)n;
                    if (!dry) wst16(A1, off * 2, pack8((s0 * inv - c0) * g0, (s1 * inv - c1) * g1));
                }
            }
    }
    __device__ __forceinline__ void fused(const AccT& acc, const pg8::Unit& u, int wr, int wc, int fr, int fq, PG8_LAS unsigned char* lds) const {
        const int R0 = u.pm * 256, C0 = u.pn * 256, w = 2 << u.pn, tid = (wr * 4 + wc) * 64 + fr + 16 * fq;
        const int tb = R0 & (SEQ - 1);
        float rsv[2][4];
#pragma unroll
        for (int ai = 0; ai < 2; ++ai)
#pragma unroll
            for (int m = 0; m < 4; ++m) rsv[ai][m] = rstd_of(RS, R0 + ai * 128 + wr * 64 + m * 16 + fr);
        for (int id = tid; id < 271 * 32; id += NT) { const int rl = id >> 5, ch = id & 31;
            if (rl >= 15 || tb != 0) *(PG8_LAS u32x4*)(lds + rl * 528 + ch * 16) = gld<u32x4>(U + (size_t)(R0 - 15 + rl) * 1024 + C0 + ch * 8);
            else *(PG8_LAS u32x4*)(lds + rl * 528 + ch * 16) = (u32x4){0u, 0u, 0u, 0u}; }
        asm volatile("s_waitcnt vmcnt(0) lgkmcnt(0)" ::: "memory"); __builtin_amdgcn_s_barrier(); asm volatile("" ::: "memory");
        if (POOL_SLIDE && w >= 8) {
#pragma unroll 1
            for (int ps = 0; ps < POOL_NP; ++ps) {
              constexpr int CP = 32 / POOL_NP, RS_ = CP / 2;
              const int ch = ps * CP + (tid % CP), r0 = RS_ * (tid / CP);
              PG8_LAS unsigned char* col = lds + ch * 16 + (r0 + 15) * 528;
              f32x4 s0 = (f32x4){0.f, 0.f, 0.f, 0.f}, s1 = s0;
              for (int i = 1; i < w; ++i) { const u32x4 a = *(const PG8_LAS u32x4*)(col - i * 528);
                  s0 += (f32x4){bflo(a.x), bfhi(a.x), bflo(a.y), bfhi(a.y)}; s1 += (f32x4){bflo(a.z), bfhi(a.z), bflo(a.w), bfhi(a.w)}; }
              u32x4 Pp[RS_];
#pragma unroll
              for (int i = 0; i < RS_; ++i) {
                  const u32x4 cn = *(const PG8_LAS u32x4*)(col + i * 528);
                  const f32x4 c0 = (f32x4){bflo(cn.x), bfhi(cn.x), bflo(cn.y), bfhi(cn.y)}, c1 = (f32x4){bflo(cn.z), bfhi(cn.z), bflo(cn.w), bfhi(cn.w)};
                  s0 += c0; s1 += c1;
                  const int t = (R0 + r0 + i) & (SEQ - 1); const float inv = 1.0f / (float)((t + 1 < w) ? (t + 1) : w);
                  Pp[i] = pack8(s0 * inv - c0, s1 * inv - c1);
                  if (i + 1 < RS_) { const u32x4 od = *(const PG8_LAS u32x4*)(col + (i + 1 - w) * 528);
                      s0 -= (f32x4){bflo(od.x), bfhi(od.x), bflo(od.y), bfhi(od.y)}; s1 -= (f32x4){bflo(od.z), bfhi(od.z), bflo(od.w), bfhi(od.w)}; }
              }
              asm volatile("s_waitcnt lgkmcnt(0)" ::: "memory"); __builtin_amdgcn_s_barrier(); asm volatile("" ::: "memory");
#pragma unroll
              for (int i = 0; i < RS_; ++i) *(PG8_LAS u32x4*)(col + i * 528) = Pp[i];
            }
            asm volatile("s_waitcnt lgkmcnt(0)" ::: "memory"); __builtin_amdgcn_s_barrier(); asm volatile("" ::: "memory");
#pragma unroll
            for (int ai = 0; ai < 2; ++ai)
#pragma unroll
                for (int m = 0; m < 4; ++m) { const int rloc = ai * 128 + wr * 64 + m * 16 + fr, row = R0 + rloc; float rs = rsv[ai][m]; asm volatile("" : "+v"(rs));
#pragma unroll
                    for (int bj = 0; bj < 2; ++bj) {
                        f32x4 g0 = acc[ai][bj][m][0] * rs, g1 = acc[ai][bj][m][1] * rs;
                        g0.x = fsilu(g0.x); g0.y = fsilu(g0.y); g0.z = fsilu(g0.z); g0.w = fsilu(g0.w); g1.x = fsilu(g1.x); g1.y = fsilu(g1.y); g1.z = fsilu(g1.z); g1.w = fsilu(g1.w);
                        const u32x4 pv = *(const PG8_LAS u32x4*)(lds + (15 + rloc) * 528 + (128 * bj + wc * 32 + 8 * fq) * 2);
                        const f32x4 o0 = (f32x4){bflo(pv.x) * g0.x, bfhi(pv.x) * g0.y, bflo(pv.y) * g0.z, bfhi(pv.y) * g0.w};
                        const f32x4 o1 = (f32x4){bflo(pv.z) * g1.x, bfhi(pv.z) * g1.y, bflo(pv.w) * g1.z, bfhi(pv.w) * g1.w};
                        if (!dry) wst16(A1, ((size_t)row * 1024 + C0 + 128 * bj + wc * 32 + 8 * fq) * 2, pack8(o0, o1));
                    } }
            return;
        }
#pragma unroll
        for (int ai = 0; ai < 2; ++ai)
#pragma unroll
            for (int m = 0; m < 4; ++m) {
                const int rloc = ai * 128 + wr * 64 + m * 16 + fr, row = R0 + rloc; const float rs = rsv[ai][m];
                const int t = row & (SEQ - 1), n = (t + 1 < w) ? (t + 1) : w;
                const float inv = 1.0f / (float)n;
#pragma unroll
                for (int bj = 0; bj < 2; ++bj) {
                    f32x4 g0 = acc[ai][bj][m][0] * rs, g1 = acc[ai][bj][m][1] * rs;
                    g0.x = fsilu(g0.x); g0.y = fsilu(g0.y); g0.z = fsilu(g0.z); g0.w = fsilu(g0.w); g1.x = fsilu(g1.x); g1.y = fsilu(g1.y); g1.z = fsilu(g1.z); g1.w = fsilu(g1.w);
                    const PG8_LAS unsigned char* lp = lds + (15 + rloc) * 528 + (128 * bj + wc * 32 + 8 * fq) * 2;
                    const u32x4 c = *(const PG8_LAS u32x4*)lp;
                    f32x4 s0 = (f32x4){bflo(c.x), bfhi(c.x), bflo(c.y), bfhi(c.y)}, s1 = (f32x4){bflo(c.z), bfhi(c.z), bflo(c.w), bfhi(c.w)};
                    const f32x4 c0 = s0, c1 = s1;
                    for (int i = 1; i < n; ++i) { const u32x4 a = *(const PG8_LAS u32x4*)(lp - i * 528);
                        s0 += (f32x4){bflo(a.x), bfhi(a.x), bflo(a.y), bfhi(a.y)}; s1 += (f32x4){bflo(a.z), bfhi(a.z), bflo(a.w), bfhi(a.w)}; }
                    if (!dry) wst16(A1, ((size_t)row * 1024 + C0 + 128 * bj + wc * 32 + 8 * fq) * 2, pack8((s0 * inv - c0) * g0, (s1 * inv - c1) * g1));
                }
            }
    }
};
struct EpiGates {
    static constexpr bool MUTATES = false;
    static constexpr bool HAS_ROWSCALE = false;
    static constexpr bool IDEMPOTENT = false;
    static constexpr bool HAS_FUSED = true;
    EpiGateA ga; EpiGateB gb;
    __device__ __forceinline__ void row(int row, int colbase, float (&v)[8]) const { if (colbase < 1024) ga.row(row, colbase, v); else gb.row(row, colbase - 1024, v); }
    __device__ __forceinline__ void operator()(const AccT& acc, const pg8::Unit& u, int wr, int wc, int fr, int fq) const {
        if (u.pn < 4) { EpiGateA g2 = ga; g2.wt = false; g2(acc, u, wr, wc, fr, fq); }
        else { pg8::Unit v; v.pm = u.pm; v.pn = u.pn - 4; gb(acc, v, wr, wc, fr, fq); }
    }
    __device__ __forceinline__ void fused(const AccT& acc, const pg8::Unit& u, int wr, int wc, int fr, int fq, PG8_LAS unsigned char* lds) const {
        if (u.pn < 4) ga(acc, u, wr, wc, fr, fq);
        else { pg8::Unit v; v.pm = u.pm; v.pn = u.pn - 4; gb.fused(acc, v, wr, wc, fr, fq, lds); }
    }
};
struct XcdBarrier;
__device__ __forceinline__ void xcd_barrier(const XcdBarrier& b, const bool release = true);
struct EpiResid {
    static constexpr bool MUTATES = false;
    static constexpr bool HAS_ROWSCALE = false;
    static constexpr bool IDEMPOTENT = false;
    static constexpr bool HAS_FUSED = false;
    bf16_t* XB; float* RSn; unsigned char* scr; int dry; bool wt = true;
    __device__ __forceinline__ void row(int row, int colbase, float (&v)[8]) const {
        float q0 = 0.f;
#pragma unroll
        for (int j = 0; j < 8; ++j) { const int col = colbase + 32 * j; bf16_t* xp = XB + (size_t)row * 1024 + col; const float x = bf2f(*xp) + v[j]; *xp = f2bf(x); q0 += x * x; }
        q0 = half_sum32(q0);
        if ((threadIdx.x & 31) == 0) RSn[(size_t)(colbase >> 8) * M + row] = q0;
    }
    __device__ __forceinline__ void operator()(const AccT& acc, const pg8::Unit& u, int wr, int wc, int fr, int fq) const {
        const int cb = u.pn * 256 + wc * 32 + 8 * fq, row0 = u.pm * 256 + wr * 64 + fr;
        PG8_LAS float* P = (PG8_LAS float*)scr;
        u32x4 ov[2][4][2];
#pragma unroll
        for (int ai = 0; ai < 2; ++ai)
#pragma unroll
            for (int m = 0; m < 4; ++m)
#pragma unroll
                for (int bj = 0; bj < 2; ++bj) ov[ai][m][bj] = gld<u32x4>(XB + (size_t)(row0 + ai * 128 + m * 16) * 1024 + cb + 128 * bj);
#pragma unroll
        for (int ai = 0; ai < 2; ++ai)
#pragma unroll
            for (int m = 0; m < 4; ++m) {
                const int row = row0 + ai * 128 + m * 16; float q = 0.f;
#pragma unroll
                for (int bj = 0; bj < 2; ++bj) {
                    const u32x4 o = ov[ai][m][bj];
                    const f32x4 x0 = (f32x4){bflo(o.x), bfhi(o.x), bflo(o.y), bfhi(o.y)} + acc[ai][bj][m][0], x1 = (f32x4){bflo(o.z), bfhi(o.z), bflo(o.w), bfhi(o.w)} + acc[ai][bj][m][1];
                    if (!dry) st16(XB, ((size_t)row * 1024 + cb + 128 * bj) * 2, pack8(x0, x1), wt);
                    q += (x0.x * x0.x + x0.y * x0.y) + (x0.z * x0.z + x0.w * x0.w) + (x1.x * x1.x + x1.y * x1.y) + (x1.z * x1.z + x1.w * x1.w);
                }
                q = quad_rows_sum(q);
                if (fq == 0) P[(ai * 128 + wr * 64 + m * 16 + fr) * 4 + wc] = q;
            }
        asm volatile("s_waitcnt lgkmcnt(0)" ::: "memory"); __builtin_amdgcn_s_barrier(); asm volatile("" ::: "memory");
        const int t = (wr * 4 + wc) * 64 + fr + 16 * fq;
        if (t < 256 && !dry) wst4(RSn, ((size_t)u.pn * M + u.pm * 256 + t) * 4, (P[t * 4 + 0] + P[t * 4 + 1]) + (P[t * 4 + 2] + P[t * 4 + 3]));
    }
};
struct EpiResidFinal {
    static constexpr bool MUTATES = true;
    static constexpr bool HAS_ROWSCALE = false;
    static constexpr bool IDEMPOTENT = false;
    static constexpr bool HAS_FUSED = false;
    const bf16_t* XB; float* RSn; const float* RSall; const float* gain; float* out; unsigned char* scr; const XcdBarrier* xb;
    __device__ __forceinline__ void row(int row, int colbase, float (&v)[8]) const { (void)row; (void)colbase; (void)v; }
    __device__ __forceinline__ void operator()(const AccT& acc, const pg8::Unit& u, int wr, int wc, int fr, int fq) const { (void)acc; (void)u; (void)wr; (void)wc; (void)fr; (void)fq; }
    __device__ __forceinline__ void mut(AccT& acc, const pg8::Unit& u, int wr, int wc, int fr, int fq) const {
        (void)u;
        const int cb = wc * 32 + 8 * fq, row0 = wr * 64 + fr, t = (wr * 4 + wc) * 64 + fr + 16 * fq;
        PG8_LAS float* P = (PG8_LAS float*)scr; PG8_LAS float* R = P + 1024;
#pragma unroll
        for (int ai = 0; ai < 2; ++ai) {
            u32x4 ov[4][2];
#pragma unroll
            for (int m = 0; m < 4; ++m)
#pragma unroll
                for (int bj = 0; bj < 2; ++bj) ov[m][bj] = gld<u32x4>(XB + (size_t)(row0 + ai * 128 + m * 16) * 1024 + cb + 128 * bj);
#pragma unroll
            for (int m = 0; m < 4; ++m) { float q = 0.f;
#pragma unroll
                for (int bj = 0; bj < 2; ++bj) { const u32x4 o = ov[m][bj];
                    const f32x4 x0 = (f32x4){bflo(o.x), bfhi(o.x), bflo(o.y), bfhi(o.y)} + acc[ai][bj][m][0], x1 = (f32x4){bflo(o.z), bfhi(o.z), bflo(o.w), bfhi(o.w)} + acc[ai][bj][m][1];
                    acc[ai][bj][m][0] = x0; acc[ai][bj][m][1] = x1;
                    q += (x0.x * x0.x + x0.y * x0.y) + (x0.z * x0.z + x0.w * x0.w) + (x1.x * x1.x + x1.y * x1.y) + (x1.z * x1.z + x1.w * x1.w); }
                q = quad_rows_sum(q);
                if (fq == 0) P[(ai * 128 + wr * 64 + m * 16 + fr) * 4 + wc] = q; }
        }
        asm volatile("s_waitcnt lgkmcnt(0)" ::: "memory"); __builtin_amdgcn_s_barrier(); asm volatile("" ::: "memory");
        if (t < 256) wst4(RSn, (size_t)t * 4, (P[t * 4 + 0] + P[t * 4 + 1]) + (P[t * 4 + 2] + P[t * 4 + 3]));
        xcd_barrier(*xb, false);
        if (t < 256) R[t] = rsqrtf(((gld<float>(RSall + t) + gld<float>(RSall + (size_t)M + t)) + (gld<float>(RSall + (size_t)2 * M + t) + gld<float>(RSall + (size_t)3 * M + t))) * (1.0f / DM) + EPS);
        f32x4 gv[2][2];
#pragma unroll
        for (int bj = 0; bj < 2; ++bj) { gv[bj][0] = gld<f32x4>(gain + cb + 128 * bj); gv[bj][1] = gld<f32x4>(gain + cb + 128 * bj + 4); }
        asm volatile("s_waitcnt vmcnt(0) lgkmcnt(0)" ::: "memory"); __builtin_amdgcn_s_barrier(); asm volatile("" ::: "memory");
#pragma unroll
        for (int ai = 0; ai < 2; ++ai)
#pragma unroll
            for (int m = 0; m < 4; ++m) { const int rl = ai * 128 + wr * 64 + m * 16 + fr; const float rs = R[rl];
#pragma unroll
                for (int bj = 0; bj < 2; ++bj) { float* op = out + (size_t)rl * 1024 + cb + 128 * bj;
                    gst<f32x4>(op, acc[ai][bj][m][0] * rs * gv[bj][0]); gst<f32x4>(op + 4, acc[ai][bj][m][1] * rs * gv[bj][1]); } }
    }
};
struct EpiGlu {
    static constexpr bool MUTATES = false;
    static constexpr bool HAS_ROWSCALE = false;
    static constexpr bool IDEMPOTENT = false;
    static constexpr bool HAS_FUSED = false;
    bf16_t* D; int dry;
    __device__ __forceinline__ void row(int row, int colbase, float (&v)[8]) const {
#pragma unroll
        for (int j = 0; j < 4; ++j) { const int c = (colbase >> 8) * 128 + (colbase & 255) + 32 * j; bf16_t* d = D + (size_t)row * 1024 + c;
            *d = f2bf(v[j] * sigmoid_f(v[j + 4]) * bf2f(*d)); }
    }
    __device__ __forceinline__ void operator()(const AccT& acc, const pg8::Unit& u, int wr, int wc, int fr, int fq) const {
        const int cb = u.pn * 128 + wc * 32 + 8 * fq, row0 = u.pm * 256 + wr * 64 + fr;
        u32x4 gv[2][4];
#pragma unroll
        for (int ai = 0; ai < 2; ++ai)
#pragma unroll
            for (int m = 0; m < 4; ++m) gv[ai][m] = gld<u32x4>(D + (size_t)(row0 + ai * 128 + m * 16) * 1024 + cb);
#pragma unroll
        for (int ai = 0; ai < 2; ++ai)
#pragma unroll
            for (int m = 0; m < 4; ++m) {
                const int row = row0 + ai * 128 + m * 16;
                const u32x4 g = gv[ai][m]; const f32x4 a0 = acc[ai][0][m][0], a1 = acc[ai][0][m][1], b0 = acc[ai][1][m][0], b1 = acc[ai][1][m][1];
                const f32x4 o0 = (f32x4){a0.x * fsigmoid(b0.x) * bflo(g.x), a0.y * fsigmoid(b0.y) * bfhi(g.x), a0.z * fsigmoid(b0.z) * bflo(g.y), a0.w * fsigmoid(b0.w) * bfhi(g.y)};
                const f32x4 o1 = (f32x4){a1.x * fsigmoid(b1.x) * bflo(g.z), a1.y * fsigmoid(b1.y) * bfhi(g.z), a1.z * fsigmoid(b1.z) * bflo(g.w), a1.w * fsigmoid(b1.w) * bfhi(g.w)};
                if (!dry) wst16(D, ((size_t)row * 1024 + cb) * 2, pack8(o0, o1));
            }
    }
};
struct EpiFold {
    static constexpr bool MUTATES = false;
    static constexpr bool HAS_ROWSCALE = false;
    static constexpr bool IDEMPOTENT = true;
    static constexpr bool HAS_FUSED = false;
    bf16_t* dst; const float* scale;
    __device__ __forceinline__ void row(int row, int colbase, float (&v)[8]) const {
#pragma unroll
        for (int j = 0; j < 8; ++j) dst[(size_t)row * WIN_LD + colbase + 32 * j] = f2bf(v[j] * scale[row]);
    }
    __device__ __forceinline__ void operator()(const AccT& acc, const pg8::Unit& u, int wr, int wc, int fr, int fq) const {
        const int cb = u.pn * 256 + wc * 32 + 8 * fq, row0 = u.pm * 256 + wr * 64 + fr;
#pragma unroll
        for (int ai = 0; ai < 2; ++ai)
#pragma unroll
            for (int m = 0; m < 4; ++m) { const int row = row0 + ai * 128 + m * 16; const float sc = gld<float>(scale + row);
#pragma unroll
                for (int bj = 0; bj < 2; ++bj) gst<u32x4>(dst + (size_t)row * WIN_LD + cb + 128 * bj, pack8(acc[ai][bj][m][0] * sc, acc[ai][bj][m][1] * sc)); }
    }
};
struct EpiSoftmaxP {
    static constexpr bool MUTATES = true;
    static constexpr bool HAS_ROWSCALE = false;
    static constexpr bool IDEMPOTENT = false;
    static constexpr bool HAS_FUSED = false;
    bf16_t* Pdst; const float* RSu; unsigned char* scr;
    __device__ __forceinline__ void row(int row, int colbase, float (&v)[8]) const { (void)row; (void)colbase; (void)v; }
    __device__ __forceinline__ void operator()(const AccT& acc, const pg8::Unit& u, int wr, int wc, int fr, int fq) const { (void)acc; (void)u; (void)wr; (void)wc; (void)fr; (void)fq; }
    __device__ __forceinline__ void mut(AccT& acc, const pg8::Unit& u, int wr, int wc, int fr, int fq) const {
        PG8_LAS float* P1 = (PG8_LAS float*)scr; PG8_LAS float* P2 = P1 + 1024; PG8_LAS float* R = P2 + 1024;
        { const int t = (wr * 4 + wc) * 64 + fr + 16 * fq;
          if (t < 256) R[t] = rsqrtf(((gld<float>(RSu + t) + gld<float>(RSu + (size_t)M + t)) + (gld<float>(RSu + (size_t)2 * M + t) + gld<float>(RSu + (size_t)3 * M + t))) * (1.0f / 1024.f) + EPS); }
#pragma unroll
        for (int ai = 0; ai < 2; ++ai)
#pragma unroll
            for (int m = 0; m < 4; ++m) { float mx = -3.0e38f;
#pragma unroll
                for (int bj = 0; bj < 2; ++bj)
#pragma unroll
                    for (int n = 0; n < 2; ++n) { const f32x4 x = acc[ai][bj][m][n]; mx = fmaxf(mx, fmaxf(fmaxf(x.x, x.y), fmaxf(x.z, x.w))); }
                mx = quad_rows_max(mx);
                if (fq == 0) P1[(ai * 128 + wr * 64 + m * 16 + fr) * 4 + wc] = mx; }
        asm volatile("s_waitcnt lgkmcnt(0)" ::: "memory"); __builtin_amdgcn_s_barrier(); asm volatile("" ::: "memory");
#pragma unroll
        for (int ai = 0; ai < 2; ++ai)
#pragma unroll
            for (int m = 0; m < 4; ++m) { const int rl = ai * 128 + wr * 64 + m * 16 + fr; const float rs = R[rl];
                const float mx = fmaxf(fmaxf(P1[rl * 4 + 0], P1[rl * 4 + 1]), fmaxf(P1[rl * 4 + 2], P1[rl * 4 + 3])); float sm = 0.f;
#pragma unroll
                for (int bj = 0; bj < 2; ++bj)
#pragma unroll
                    for (int n = 0; n < 2; ++n) { f32x4 x = acc[ai][bj][m][n];
                        x.x = __builtin_amdgcn_exp2f((x.x - mx) * rs); x.y = __builtin_amdgcn_exp2f((x.y - mx) * rs); x.z = __builtin_amdgcn_exp2f((x.z - mx) * rs); x.w = __builtin_amdgcn_exp2f((x.w - mx) * rs);
                        sm += (x.x + x.y) + (x.z + x.w); acc[ai][bj][m][n] = x; }
                sm = quad_rows_sum(sm);
                if (fq == 0) P2[rl * 4 + wc] = sm; }
        asm volatile("s_waitcnt lgkmcnt(0)" ::: "memory"); __builtin_amdgcn_s_barrier(); asm volatile("" ::: "memory");
        const int cb = u.pn * 256 + wc * 32 + 8 * fq;
#pragma unroll
        for (int ai = 0; ai < 2; ++ai)
#pragma unroll
            for (int m = 0; m < 4; ++m) { const int rl = ai * 128 + wr * 64 + m * 16 + fr;
                const float inv = 1.0f / ((P2[rl * 4 + 0] + P2[rl * 4 + 1]) + (P2[rl * 4 + 2] + P2[rl * 4 + 3]));
#pragma unroll
                for (int bj = 0; bj < 2; ++bj) wst16(Pdst, ((size_t)(u.pm * 256 + rl) * 1024 + cb + 128 * bj) * 2, pack8(acc[ai][bj][m][0] * inv, acc[ai][bj][m][1] * inv)); }
    }
};
struct EpiTile {
    static constexpr bool MUTATES = false;
    static constexpr bool HAS_ROWSCALE = false;
    static constexpr bool IDEMPOTENT = true;
    static constexpr bool HAS_FUSED = false;
    bf16_t* dst;
    __device__ __forceinline__ void row(int row, int colbase, float (&v)[8]) const {
#pragma unroll
        for (int j = 0; j < 8; ++j) dst[(size_t)row * 1024 + colbase + 32 * j] = f2bf(v[j]);
    }
    __device__ __forceinline__ void operator()(const AccT& acc, const pg8::Unit& u, int wr, int wc, int fr, int fq) const {
        const int cb = u.pn * 256 + wc * 32 + 8 * fq, row0 = u.pm * 256 + wr * 64 + fr;
#pragma unroll
        for (int ai = 0; ai < 2; ++ai)
#pragma unroll
            for (int m = 0; m < 4; ++m) { const int row = row0 + ai * 128 + m * 16;
#pragma unroll
                for (int bj = 0; bj < 2; ++bj) wst16(dst, ((size_t)row * 1024 + cb + 128 * bj) * 2, pack8(acc[ai][bj][m][0], acc[ai][bj][m][1])); }
    }
};
struct EpiProjOdd {
    static constexpr bool MUTATES = false;
    static constexpr bool HAS_ROWSCALE = true;
    static constexpr bool IDEMPOTENT = true;
    static constexpr bool HAS_FUSED = false;
    bf16_t* UG; bf16_t* VC; bf16_t* XG; const float* RS; float* LNS; unsigned char* scr;
    __device__ __forceinline__ float row_scale(int row) const { return rstd_of(RS, row); }
    __device__ __forceinline__ void row(int row, int colbase, float (&v)[8]) const {
        const float rs = rstd_of(RS, row); const int pn = colbase >> 8, tx = colbase & 255;
        if (pn < 8) {
#pragma unroll
            for (int j = 0; j < 4; ++j) UG[(size_t)row * 1024 + 128 * pn + tx + 32 * j] = f2bf(v[j] * rs * silu_f(v[j + 4] * rs));
        } else {
            const int t = pn - 8, seg = t >> 2; float s0 = 0.f, q0 = 0.f;
#pragma unroll
            for (int j = 0; j < 8; ++j) { const int c = (t & 3) * 256 + tx + 32 * j; float x = v[j] * rs; s0 += x; q0 += x * x;
                if (seg == 1 && c >= 512) x = silu_f(x);
                (seg ? XG : VC)[(size_t)row * 1024 + c] = f2bf(x); }
            if (seg == 0) { s0 = half_sum32(s0); q0 = half_sum32(q0); if ((threadIdx.x & 31) == 0) { LNS[(size_t)(t & 3) * M + row] = s0; LNS[(size_t)(4 + (t & 3)) * M + row] = q0; } }
        }
    }
    __device__ __forceinline__ void operator()(const AccT& acc, const pg8::Unit& u, int wr, int wc, int fr, int fq) const { scaled(acc, u, wr, wc, fr, fq, (PG8_LAS float*)nullptr, true); }
    __device__ __forceinline__ void scaled(const AccT& acc, const pg8::Unit& u, int wr, int wc, int fr, int fq, PG8_LAS float* rtab, const bool wt) const {
        const int row0 = u.pm * 256 + wr * 64 + fr;
        if (u.pn < 8) {
            const int cb = u.pn * 128 + wc * 32 + 8 * fq;
#pragma unroll
            for (int ai = 0; ai < 2; ++ai)
#pragma unroll
                for (int m = 0; m < 4; ++m) { const int row = row0 + ai * 128 + m * 16; const float rs = rtab ? rtab[ai * 128 + wr * 64 + m * 16 + fr] : rstd_of(RS, row);
                    const f32x4 a0 = acc[ai][0][m][0] * rs, a1 = acc[ai][0][m][1] * rs, g0 = acc[ai][1][m][0] * rs, g1 = acc[ai][1][m][1] * rs;
                    const f32x4 o0 = (f32x4){a0.x * fsilu(g0.x), a0.y * fsilu(g0.y), a0.z * fsilu(g0.z), a0.w * fsilu(g0.w)}, o1 = (f32x4){a1.x * fsilu(g1.x), a1.y * fsilu(g1.y), a1.z * fsilu(g1.z), a1.w * fsilu(g1.w)};
                    st16(UG, ((size_t)row * 1024 + cb) * 2, pack8(o0, o1), wt); }
            return;
        }
        const int t = u.pn - 8, seg = t >> 2, cb = (t & 3) * 256 + wc * 32 + 8 * fq;
        bf16_t* base = seg ? XG : VC;
        const bool st = (seg == 0), act = (seg == 1) && ((t & 3) >= 2);
        PG8_LAS float* P = (PG8_LAS float*)scr;
#pragma unroll
        for (int ai = 0; ai < 2; ++ai)
#pragma unroll
            for (int m = 0; m < 4; ++m) {
                const int row = row0 + ai * 128 + m * 16; const float rs = rtab ? rtab[ai * 128 + wr * 64 + m * 16 + fr] : rstd_of(RS, row);
                float sm = 0.f, q = 0.f;
#pragma unroll
                for (int bj = 0; bj < 2; ++bj) {
                    f32x4 v0 = acc[ai][bj][m][0] * rs, v1 = acc[ai][bj][m][1] * rs;
                    if (st) { sm += (v0.x + v0.y) + (v0.z + v0.w) + (v1.x + v1.y) + (v1.z + v1.w);
                              q += (v0.x * v0.x + v0.y * v0.y) + (v0.z * v0.z + v0.w * v0.w) + (v1.x * v1.x + v1.y * v1.y) + (v1.z * v1.z + v1.w * v1.w); }
                    if (act) { v0.x = fsilu(v0.x); v0.y = fsilu(v0.y); v0.z = fsilu(v0.z); v0.w = fsilu(v0.w); v1.x = fsilu(v1.x); v1.y = fsilu(v1.y); v1.z = fsilu(v1.z); v1.w = fsilu(v1.w); }
                    st16(base, ((size_t)row * 1024 + cb + 128 * bj) * 2, pack8(v0, v1), wt);
                }
                if (st) { sm = quad_rows_sum(sm); q = quad_rows_sum(q);
                          if (fq == 0) { const int rl = ai * 128 + wr * 64 + m * 16 + fr; P[(rl * 4 + wc) * 2] = sm; P[(rl * 4 + wc) * 2 + 1] = q; } }
            }
        if (st) {
            asm volatile("s_waitcnt lgkmcnt(0)" ::: "memory"); __builtin_amdgcn_s_barrier(); asm volatile("" ::: "memory");
            const int tt = (wr * 4 + wc) * 64 + fr + 16 * fq;
            if (tt < 256) { const float sm = (P[(tt * 4 + 0) * 2] + P[(tt * 4 + 1) * 2]) + (P[(tt * 4 + 2) * 2] + P[(tt * 4 + 3) * 2]);
                            const float q = (P[(tt * 4 + 0) * 2 + 1] + P[(tt * 4 + 1) * 2 + 1]) + (P[(tt * 4 + 2) * 2 + 1] + P[(tt * 4 + 3) * 2 + 1]);
                            gst<float>(LNS + (size_t)(t & 3) * M + u.pm * 256 + tt, sm); gst<float>(LNS + (size_t)(4 + (t & 3)) * M + u.pm * 256 + tt, q); }
        }
    }
};
template <int FAST, class Epi, bool TAIL = true>
__device__ __forceinline__ void run_gemm(unsigned char* lds, const bf16_t* A1, const bf16_t* A2, int K1, const bf16_t* Bt, int Mrows, int N, int K, const Epi& E, int a_grp = 1 << 20, int a_skip = 0, int b_grp = 1 << 20, int b_skip = 0, int vG = 0, int vc = 0, int lda = 1024, int ldb = 0, const bf16_t* Bt2 = nullptr, int nsplit = 1 << 20) {
    if constexpr (FAST) { pg8::Gemm g{A1, A2, K1 / 64, lda, Bt, Mrows, N, K, a_grp, a_skip, b_grp, b_skip, vG, vc, ldb ? ldb : K, Bt2, nsplit}; pg8::gemm_phase<Epi, TAIL>((PG8_LAS unsigned char*)lds, g, E); }
    else ngemm(lds, A1, A2, K1, lda, Bt, Mrows, N, K, E);
}
__device__ __forceinline__ void zero_f32(float* p, int n) { for (int i = blockIdx.x * NT + tid_l(); i < n; i += gridDim.x * NT) p[i] = 0.f; }

__device__ __forceinline__ void init_rows(const Params& p) {
    unsigned char* wsl = p.ws; asm volatile("" : "+s"(wsl));
    const int tidl = tid_l(), lane = tidl & 63, gw = blockIdx.x * (NT / 64) + (tidl >> 6), ngw = gridDim.x * (NT / 64);
    float* RS = (float*)(wsl + WS_RS); bf16_t* XB = (bf16_t*)(wsl + WS_XB); bf16_t* MB = (bf16_t*)(wsl + WS_MEMNB);
    for (int row = gw; row < M; row += ngw) {
        const f32x4* xr = (const f32x4*)(p.in[0] + (size_t)row * DM) + lane; u32x2* xb = (u32x2*)(XB + (size_t)row * DM) + lane;
        float s = 0.f;
#pragma unroll
        for (int j = 0; j < 4; ++j) { const f32x4 v = gld<f32x4>(xr + 64 * j); s += v.x * v.x + v.y * v.y + v.z * v.z + v.w * v.w;
            u32x2 w; w.x = cvt_pk_bf16(v.x, v.y); w.y = cvt_pk_bf16(v.z, v.w); gst<u32x2>(XB + (size_t)row * DM + 4 * (lane + 64 * j), w); }
        s = wave_sum(s);
        if (lane < 4) RS[(size_t)lane * M + row] = (lane == 0) ? s : 0.f;
    }
    for (int row = gw; row < MM; row += ngw) {
        const f32x4* xr = (const f32x4*)(p.in[1] + (size_t)row * DM) + lane; const f32x4* gr = (const f32x4*)(p.in[28]) + lane; u32x2* xb = (u32x2*)(MB + (size_t)row * DM) + lane;
        f32x4 v[4]; float s = 0.f;
#pragma unroll
        for (int j = 0; j < 4; ++j) { v[j] = xr[64 * j]; s += v[j].x * v[j].x + v[j].y * v[j].y + v[j].z * v[j].z + v[j].w * v[j].w; }
        s = wave_sum(s); const float r = rsqrtf(s * (1.0f / DM) + EPS);
#pragma unroll
        for (int j = 0; j < 4; ++j) { const f32x4 g = gr[64 * j]; u32x2 w; w.x = (unsigned)f2bf(v[j].x * r * g.x) | ((unsigned)f2bf(v[j].y * r * g.y) << 16);
            w.y = (unsigned)f2bf(v[j].z * r * g.z) | ((unsigned)f2bf(v[j].w * r * g.w) << 16); xb[64 * j] = w; }
    }
}
__device__ __forceinline__ void cvt_wvb(const Params& p) {
    unsigned char* wsl = p.ws; asm volatile("" : "+s"(wsl));
    bf16_t* WVB = (bf16_t*)(wsl + WS_WVB);
    for (int e8 = blockIdx.x * NT + tid_l(); e8 < 2 * 4 * 1024 * 32; e8 += gridDim.x * NT) {
        const int c8 = e8 & 31, k = (e8 >> 5) & 1023, g = (e8 >> 15) & 3, i = e8 >> 17;
        const float* src = p.in[3] + (size_t)i * 1024 * 6144 + (size_t)k * 6144 + 4096 + g * 256 + 8 * c8; const float gn = p.in[2][i * 1024 + k];
        const f32x4 a = gld<f32x4>(src) * gn, c = gld<f32x4>(src + 4) * gn;
        wst16(WVB, (size_t)e8 * 16, pack8(a, c));
    }
}

__device__ __forceinline__ void cvt_wxqn(const Params& p) {
    unsigned char* wsl = p.ws; asm volatile("" : "+s"(wsl));
    bf16_t* W = (bf16_t*)(wsl + WS_WXQ);
    for (int e8 = blockIdx.x * NT + tid_l(); e8 < 4 * 1024 * 128; e8 += gridDim.x * NT) {
        const int i = (e8 >> 7) & 1023, l = e8 >> 17;
        const float* src = p.in[25] + (size_t)e8 * 8; const float gn = p.in[24][l * 1024 + i] * (0.0625f * 1.4426950408889634f);
        const f32x4 a = gld<f32x4>(src) * gn, c = gld<f32x4>(src + 4) * gn;
        wst16(W, (size_t)e8 * 16, pack8(a, c));
    }
}

__device__ __forceinline__ int dil_pos(int t, int s) { return (s < 129) ? (t - s) : (s < 258) ? (t - 4 * (s - 129)) : (t - 16 * (s - 258)); }
__device__ __forceinline__ void dil_attn_naive(const Params& p) {
    unsigned char* wsl = p.ws; asm volatile("" : "+s"(wsl));
    bf16_t* Q = (bf16_t*)(wsl + WS_B0); const bf16_t* Kb = (const bf16_t*)(wsl + WS_B1); const bf16_t* Vb = (const bf16_t*)(wsl + WS_B2);
    const int tidl = tid_l(), lane = tidl & 63, gw = blockIdx.x * (NT / 64) + (tidl >> 6), ngw = gridDim.x * (NT / 64);
    for (int item = gw; item < M * 16; item += ngw) {
        const int row = item >> 4, h = item & 15, t = row & (SEQ - 1), rowb = row - t;
        float q[64];
        { const u32x4* qp = (const u32x4*)(Q + (size_t)row * 1024 + h * 64);
#pragma unroll
          for (int i = 0; i < 8; ++i) { const u32x4 w = qp[i];
              q[8 * i + 0] = __uint_as_float(w.x << 16); q[8 * i + 1] = __uint_as_float(w.x & 0xffff0000u); q[8 * i + 2] = __uint_as_float(w.y << 16); q[8 * i + 3] = __uint_as_float(w.y & 0xffff0000u);
              q[8 * i + 4] = __uint_as_float(w.z << 16); q[8 * i + 5] = __uint_as_float(w.z & 0xffff0000u); q[8 * i + 6] = __uint_as_float(w.w << 16); q[8 * i + 7] = __uint_as_float(w.w & 0xffff0000u); } }
        float sc[7]; float mx = -3.0e38f;
#pragma unroll
        for (int i = 0; i < 7; ++i) {
            const int s = lane + 64 * i, pos = dil_pos(t, s); const bool valid = (s < 386) && (pos >= 0);
            float d = -3.0e38f;
            if (valid) { const u32x4* kp = (const u32x4*)(Kb + (size_t)(rowb + pos) * 1024 + h * 64); d = 0.f;
#pragma unroll
                for (int c = 0; c < 8; ++c) { const u32x4 w = kp[c];
                    d += q[8 * c + 0] * __uint_as_float(w.x << 16) + q[8 * c + 1] * __uint_as_float(w.x & 0xffff0000u) + q[8 * c + 2] * __uint_as_float(w.y << 16) + q[8 * c + 3] * __uint_as_float(w.y & 0xffff0000u)
                       + q[8 * c + 4] * __uint_as_float(w.z << 16) + q[8 * c + 5] * __uint_as_float(w.z & 0xffff0000u) + q[8 * c + 6] * __uint_as_float(w.w << 16) + q[8 * c + 7] * __uint_as_float(w.w & 0xffff0000u); } }
            sc[i] = d; mx = fmaxf(mx, d);
        }
        mx = wave_max(mx);
        float l = 0.f;
#pragma unroll
        for (int i = 0; i < 7; ++i) { const int s = lane + 64 * i, pos = dil_pos(t, s); const bool valid = (s < 386) && (pos >= 0); sc[i] = valid ? expf(sc[i] - mx) : 0.f; l += sc[i]; }
        l = wave_sum(l);
        float o = 0.f;
#pragma unroll
        for (int i = 0; i < 7; ++i) {
            for (int j = 0; j < 64; ++j) { const int s = 64 * i + j; if (s >= 386) break; const int pos = dil_pos(t, s); const float pj = __shfl(sc[i], j);
                if (pos >= 0) o += pj * bf2f(Vb[(size_t)(rowb + pos) * 1024 + h * 64 + lane]); }
        }
        Q[(size_t)row * 1024 + h * 64 + lane] = f2bf(o / l);
    }
}

typedef float f32x16 __attribute__((ext_vector_type(16)));
typedef short s16x8 __attribute__((ext_vector_type(8)));
typedef short s16x4 __attribute__((ext_vector_type(4)));
__device__ __forceinline__ void dil_tile(f32x16 (&oacc)[2], float& m, float& l, const s16x8 (&qf)[4], const u32x4 (&kk)[4], const u32x4 (&vv)[4], unsigned char* Vw, unsigned tr_base,
                                         int lane, int q, int h, int qpos, int kpb, bool need_mask) {
#pragma unroll
    for (int i2 = 0; i2 < 4; ++i2) *(u32x4*)(Vw + ((lane >> 3) + 8 * i2) * 144 + (lane & 7) * 16) = kk[i2];
    s16x8 kf[4];
#pragma unroll
    for (int ks = 0; ks < 4; ++ks) kf[ks] = *(const s16x8*)(Vw + q * 144 + (16 * ks + 8 * h) * 2);
    asm volatile("s_waitcnt lgkmcnt(0)" ::: "memory");
#pragma unroll
    for (int i2 = 0; i2 < 4; ++i2) *(u32x4*)(Vw + ((lane >> 3) + 8 * i2) * 192 + (lane & 7) * 16) = vv[i2];
    f32x16 sacc;
#pragma unroll
    for (int e = 0; e < 16; ++e) sacc[e] = 0.f;
#pragma unroll
    for (int ks = 0; ks < 4; ++ks) sacc = __builtin_amdgcn_mfma_f32_32x32x16_bf16(kf[ks], qf[ks], sacc, 0, 0, 0);
    if (need_mask) {
        const int hi = qpos - kpb - 4 * h, l1 = hi - 128, l2 = -(kpb + 4 * h), lo = l1 > l2 ? l1 : l2;
        const unsigned mhi = hi < 0 ? 0u : (hi >= 31 ? 0xffffffffu : ((2u << hi) - 1u));
        const unsigned mlo = lo <= 0 ? 0xffffffffu : (lo >= 32 ? 0u : (0xffffffffu << lo));
        const unsigned mk = mhi & mlo;
#pragma unroll
        for (int e = 0; e < 16; ++e) { const int c = (e & 3) + 8 * (e >> 2); const unsigned mm = (unsigned)(((int)(mk << (31 - c))) >> 31);
            sacc[e] = __uint_as_float((__float_as_uint(sacc[e]) & mm) | (0xff800000u & ~mm)); }
    }
    typedef float f32x2_ __attribute__((ext_vector_type(2)));
    f32x2_ t2[8];
    { const f32x2_ nm = (f32x2_){-m, -m};
#pragma unroll
      for (int e = 0; e < 8; ++e) t2[e] = (f32x2_){sacc[2 * e], sacc[2 * e + 1]} + nm; }
    float mt;
    { const float r0 = fmaxf(fmaxf(t2[0].x, t2[0].y), t2[1].x), r1 = fmaxf(fmaxf(t2[1].y, t2[2].x), t2[2].y), r2 = fmaxf(fmaxf(t2[3].x, t2[3].y), t2[4].x),
                  r3 = fmaxf(fmaxf(t2[4].y, t2[5].x), t2[5].y), r4 = fmaxf(fmaxf(t2[6].x, t2[6].y), t2[7].x);
      mt = fmaxf(fmaxf(fmaxf(r0, r1), r2), fmaxf(fmaxf(r3, r4), t2[7].y)); }
    { const auto rr = __builtin_amdgcn_permlane32_swap(__float_as_uint(mt), __float_as_uint(mt), false, false); mt = __builtin_amdgcn_fmed3f(__uint_as_float(rr[0]), __uint_as_float(rr[1]), INFINITY); }
    if (!__all(mt <= 8.0f)) {
        float ms;
        { float m4[4];
#pragma unroll
          for (int e = 0; e < 4; ++e) m4[e] = fmaxf(fmaxf(sacc[4 * e], sacc[4 * e + 1]), fmaxf(sacc[4 * e + 2], sacc[4 * e + 3]));
          ms = fmaxf(fmaxf(m4[0], m4[1]), fmaxf(m4[2], m4[3])); }
        { const auto rr = __builtin_amdgcn_permlane32_swap(__float_as_uint(ms), __float_as_uint(ms), false, false); ms = fmaxf(__uint_as_float(rr[0]), __uint_as_float(rr[1])); }
        const float mnew = fmaxf(m, ms), alpha = __builtin_amdgcn_exp2f(m - mnew); m = mnew; l *= alpha;
#pragma unroll
        for (int dt = 0; dt < 2; ++dt)
#pragma unroll
            for (int e = 0; e < 16; ++e) oacc[dt][e] *= alpha;
        const f32x2_ nm = (f32x2_){-m, -m};
#pragma unroll
        for (int e = 0; e < 8; ++e) t2[e] = (f32x2_){sacc[2 * e], sacc[2 * e + 1]} + nm;
    }
#pragma unroll
    for (int e = 0; e < 8; ++e) { sacc[2 * e] = __builtin_amdgcn_exp2f(t2[e].x); sacc[2 * e + 1] = __builtin_amdgcn_exp2f(t2[e].y); }
    float ps;
    { float s4[4];
#pragma unroll
      for (int e = 0; e < 4; ++e) s4[e] = (sacc[4 * e] + sacc[4 * e + 1]) + (sacc[4 * e + 2] + sacc[4 * e + 3]);
      ps = (s4[0] + s4[1]) + (s4[2] + s4[3]); }
    { const auto rr = __builtin_amdgcn_permlane32_swap(__float_as_uint(ps), __float_as_uint(ps), false, false); ps = __uint_as_float(rr[0]) + __uint_as_float(rr[1]); }
    l += ps;
    s16x8 pf[2];
#pragma unroll
    for (int s2 = 0; s2 < 2; ++s2) { u32x4 w; w.x = cvt_pk_bf16(sacc[8 * s2 + 0], sacc[8 * s2 + 1]); w.y = cvt_pk_bf16(sacc[8 * s2 + 2], sacc[8 * s2 + 3]);
        w.z = cvt_pk_bf16(sacc[8 * s2 + 4], sacc[8 * s2 + 5]); w.w = cvt_pk_bf16(sacc[8 * s2 + 6], sacc[8 * s2 + 7]); pf[s2] = __builtin_bit_cast(s16x8, w); }
    s16x4 t00, t01, t02, t03, t10, t11, t12, t13;
    asm volatile("ds_read_b64_tr_b16 %0, %8 offset:0\n\tds_read_b64_tr_b16 %1, %8 offset:1536\n\tds_read_b64_tr_b16 %2, %8 offset:3072\n\tds_read_b64_tr_b16 %3, %8 offset:4608\n\t"
                 "ds_read_b64_tr_b16 %4, %8 offset:64\n\tds_read_b64_tr_b16 %5, %8 offset:1600\n\tds_read_b64_tr_b16 %6, %8 offset:3136\n\tds_read_b64_tr_b16 %7, %8 offset:4672\n\ts_waitcnt lgkmcnt(0)"
                 : "=&v"(t00), "=&v"(t01), "=&v"(t02), "=&v"(t03), "=&v"(t10), "=&v"(t11), "=&v"(t12), "=&v"(t13) : "v"(tr_base) : "memory");
    oacc[0] = __builtin_amdgcn_mfma_f32_32x32x16_bf16(__builtin_shufflevector(t00, t01, 0, 1, 2, 3, 4, 5, 6, 7), pf[0], oacc[0], 0, 0, 0);
    oacc[1] = __builtin_amdgcn_mfma_f32_32x32x16_bf16(__builtin_shufflevector(t10, t11, 0, 1, 2, 3, 4, 5, 6, 7), pf[0], oacc[1], 0, 0, 0);
    oacc[0] = __builtin_amdgcn_mfma_f32_32x32x16_bf16(__builtin_shufflevector(t02, t03, 0, 1, 2, 3, 4, 5, 6, 7), pf[1], oacc[0], 0, 0, 0);
    oacc[1] = __builtin_amdgcn_mfma_f32_32x32x16_bf16(__builtin_shufflevector(t12, t13, 0, 1, 2, 3, 4, 5, 6, 7), pf[1], oacc[1], 0, 0, 0);
}
__device__ __forceinline__ void dil_attn_mfma(unsigned char* lds, const Params& p, const int dry) {
    unsigned char* wsl = p.ws; asm volatile("" : "+s"(wsl));
    const bf16_t* Qb = (const bf16_t*)p.out; const bf16_t* Kb = (const bf16_t*)(wsl + WS_B1); const bf16_t* Vb = (const bf16_t*)(wsl + WS_B2);
    bf16_t* Ob = (bf16_t*)(wsl + WS_B0);
    const int tid = tid_l(), lane = tid & 63, wid = tid >> 6, q = lane & 31, h = lane >> 5;
    unsigned char* OST = lds;
    float* MST = (float*)(lds + 65536); float* LST = (float*)(lds + 67584);
    unsigned char* Vw = lds + 69632 + wid * 6144;
    const unsigned tr_base = (unsigned)(size_t)Vw + (unsigned)((4 * h + ((lane & 15) >> 2)) * 192 + (16 * ((lane >> 4) & 1) + 4 * (lane & 3)) * 2);
    for (int uu = bid_l(); uu < 512; uu += gridDim.x) {
        const int u = uu & 255, b = u & 7, hd = (u >> 3) & 15, cb_ = u >> 7, c = (uu < 256) ? cb_ : 3 - cb_, rowb = b * SEQ, T0 = 512 * c;
        __syncthreads();
#pragma unroll 1
        for (int stage = 0; stage < 3; ++stage) {
#pragma unroll 1
            for (int g = 0; g < 2; ++g) {
                int dil, r, pos0, kp0, nkt;
                if (stage == 0) { dil = 1; r = 0; pos0 = T0 + 64 * wid + 32 * g; kp0 = pos0 - 128; nkt = 5; }
                else if (stage == 1) { dil = 4; r = wid >> 1; pos0 = 128 * c + 64 * (wid & 1) + 32 * g; kp0 = pos0 - 128; nkt = 5; }
                else { dil = 16; r = 2 * wid + g; pos0 = 32 * c; kp0 = 0; nkt = c + 1; }
                const int qpos = pos0 + q, qtok = dil * qpos + r, tau = qtok - T0;
                const int fsw = ((tau >> 2) ^ (tau >> 4)) & 15;
                s16x8 qf[4];
                { const bf16_t* qp = Qb + ((size_t)(b * 16 + hd) * 2048 + qtok) * 64 + 8 * h;
#pragma unroll
                  for (int ks = 0; ks < 4; ++ks) qf[ks] = gld<s16x8>(qp + 16 * ks); }
                f32x16 oacc[2]; float m = -1.0e30f, l = 0.f;
                if (stage == 0) {
#pragma unroll
                    for (int dt = 0; dt < 2; ++dt)
#pragma unroll
                        for (int e = 0; e < 16; ++e) oacc[dt][e] = 0.f;
                } else {
                    m = MST[tau]; l = LST[tau];
#pragma unroll
                    for (int dt = 0; dt < 2; ++dt)
#pragma unroll
                        for (int gg = 0; gg < 4; ++gg) { const u32x2 w = *(const u32x2*)(OST + tau * 128 + (((8 * dt + 2 * gg + h) ^ fsw) * 8));
                            oacc[dt][4 * gg + 0] = bflo(w.x); oacc[dt][4 * gg + 1] = bfhi(w.x); oacc[dt][4 * gg + 2] = bflo(w.y); oacc[dt][4 * gg + 3] = bfhi(w.y); }
                }
#define DIL_LOAD(KT, KK, VV) do { const int kpb_ = kp0 + 32 * (KT); \
                    _Pragma("unroll") for (int i2 = 0; i2 < 4; ++i2) { int kpos_ = kpb_ + (lane >> 3) + 8 * i2; if (kpos_ < 0) kpos_ = 0; \
                        const unsigned ro_ = (unsigned)(dil * kpos_ + r) * 64u; KK[i2] = gld<u32x4>(kbase + ro_); VV[i2] = gld<u32x4>(vbase + ro_); } } while (0)
                const bf16_t* kbase = Kb + (size_t)(b * 16 + hd) * 2048 * 64 + 8 * (lane & 7); const bf16_t* vbase = Vb + (size_t)(b * 16 + hd) * 2048 * 64 + 8 * (lane & 7);
                u32x4 kA[4], vA[4], kB[4], vB[4];
                DIL_LOAD(0, kA, vA);
#pragma unroll 1
                for (int kt = 0; kt < nkt; kt += 2) {
                    if (kt + 1 < nkt) DIL_LOAD(kt + 1, kB, vB);
                    dil_tile(oacc, m, l, qf, kA, vA, Vw, tr_base, lane, q, h, qpos, kp0 + 32 * kt, kt == 0 || kt == nkt - 1 || kp0 + 32 * kt < 0);
                    if (kt + 1 < nkt) {
                        if (kt + 2 < nkt) DIL_LOAD(kt + 2, kA, vA);
                        dil_tile(oacc, m, l, qf, kB, vB, Vw, tr_base, lane, q, h, qpos, kp0 + 32 * (kt + 1), kt + 1 == nkt - 1 || kp0 + 32 * (kt + 1) < 0);
                    }
                }
                if (stage < 2) {
                    if (h == 0) { MST[tau] = m; LST[tau] = l; }
#pragma unroll
                    for (int dt = 0; dt < 2; ++dt)
#pragma unroll
                        for (int gg = 0; gg < 4; ++gg) { u32x2 w; w.x = cvt_pk_bf16(oacc[dt][4 * gg + 0], oacc[dt][4 * gg + 1]); w.y = cvt_pk_bf16(oacc[dt][4 * gg + 2], oacc[dt][4 * gg + 3]);
                            *(u32x2*)(OST + tau * 128 + (((8 * dt + 2 * gg + h) ^ fsw) * 8)) = w; }
                } else if (!dry) {
                    const float inv = 1.0f / l;
                    const size_t ob = ((size_t)(rowb + qtok) * 1024 + hd * 64 + 8 * h) * 2;
#pragma unroll
                    for (int dt = 0; dt < 2; ++dt)
#pragma unroll
                        for (int k = 0; k < 4; k += 2) {
                            u32x2 wa, wb;
                            wa.x = cvt_pk_bf16(oacc[dt][4 * k + 0] * inv, oacc[dt][4 * k + 1] * inv); wa.y = cvt_pk_bf16(oacc[dt][4 * k + 2] * inv, oacc[dt][4 * k + 3] * inv);
                            wb.x = cvt_pk_bf16(oacc[dt][4 * k + 4] * inv, oacc[dt][4 * k + 5] * inv); wb.y = cvt_pk_bf16(oacc[dt][4 * k + 6] * inv, oacc[dt][4 * k + 7] * inv);
                            const auto rx = __builtin_amdgcn_permlane32_swap(wa.x, wb.x, false, false); const auto ry = __builtin_amdgcn_permlane32_swap(wa.y, wb.y, false, false);
                            st16(Ob, ob + (size_t)(32 * dt + 8 * k) * 2, (u32x4){rx[0], ry[0], rx[1], ry[1]}, false);
                        }
                }
            }
            __syncthreads();
        }
    }
}

__device__ __forceinline__ void xattn_naive(unsigned char* lds, const Params& p, int l) {
    unsigned char* wsl = p.ws; asm volatile("" : "+s"(wsl));
    const bf16_t* Qb = (const bf16_t*)(wsl + WS_B2); bf16_t* O = (bf16_t*)(wsl + WS_B3); const bf16_t* KV = (const bf16_t*)(wsl + WS_KVX) + (size_t)l * MM * 2048;
    const int tidl = tid_l(), lane = tidl & 63, wid = tidl >> 6, gw = blockIdx.x * (NT / 64) + wid, ngw = gridDim.x * (NT / 64);
    float* qs = (float*)lds + wid * 256;
    for (int item = gw; item < M * 4; item += ngw) {
        const int row = item >> 2, h = item & 3, b = row >> 11;
        { const u32x2 w = *((const u32x2*)(Qb + (size_t)row * 1024 + h * 256) + lane);
          qs[4 * lane + 0] = __uint_as_float(w.x << 16); qs[4 * lane + 1] = __uint_as_float(w.x & 0xffff0000u); qs[4 * lane + 2] = __uint_as_float(w.y << 16); qs[4 * lane + 3] = __uint_as_float(w.y & 0xffff0000u); }
        __builtin_amdgcn_wave_barrier();
        float sc[4]; float mx = -3.0e38f;
#pragma unroll
        for (int i = 0; i < 4; ++i) { const int key = lane + 64 * i; const u32x4* kp = (const u32x4*)(KV + (size_t)(b * MEML + key) * 2048 + h * 256); float d = 0.f;
#pragma unroll 4
            for (int c = 0; c < 32; ++c) { const u32x4 w = kp[c]; const float* qq = qs + 8 * c;
                d += qq[0] * __uint_as_float(w.x << 16) + qq[1] * __uint_as_float(w.x & 0xffff0000u) + qq[2] * __uint_as_float(w.y << 16) + qq[3] * __uint_as_float(w.y & 0xffff0000u)
                   + qq[4] * __uint_as_float(w.z << 16) + qq[5] * __uint_as_float(w.z & 0xffff0000u) + qq[6] * __uint_as_float(w.w << 16) + qq[7] * __uint_as_float(w.w & 0xffff0000u); }
            sc[i] = d; mx = fmaxf(mx, d); }
        mx = wave_max(mx);
        float lsum = 0.f;
#pragma unroll
        for (int i = 0; i < 4; ++i) { sc[i] = expf(sc[i] - mx); lsum += sc[i]; }
        lsum = wave_sum(lsum);
        float o[4] = {0.f, 0.f, 0.f, 0.f};
#pragma unroll
        for (int i = 0; i < 4; ++i)
            for (int j = 0; j < 64; ++j) { const int key = 64 * i + j; const float pj = __shfl(sc[i], j); const bf16_t* vp = KV + (size_t)(b * MEML + key) * 2048 + 1024 + h * 256 + lane;
                o[0] += pj * bf2f(vp[0]); o[1] += pj * bf2f(vp[64]); o[2] += pj * bf2f(vp[128]); o[3] += pj * bf2f(vp[192]); }
        const float inv = 1.0f / lsum;
#pragma unroll
        for (int jj = 0; jj < 4; ++jj) O[(size_t)row * 1024 + h * 256 + lane + 64 * jj] = f2bf(o[jj] * inv);
        __builtin_amdgcn_wave_barrier();
    }
}

__device__ __forceinline__ void xattn_units(unsigned char* lds, const Params& p, int l, int unit0, int unit_step) {
    unsigned char* wsl = p.ws; asm volatile("" : "+s"(wsl));
    const bf16_t* Qb = (const bf16_t*)(wsl + WS_B2); bf16_t* O = (bf16_t*)(wsl + WS_B3);
    const bf16_t* KX = (const bf16_t*)(wsl + WS_KVX) + (size_t)l * MM * 1024; const bf16_t* VT = (const bf16_t*)(wsl + WS_VTX) + (size_t)l * 1024 * MM;
    const int tid = tid_l(), lane = tid & 63, wid = tid >> 6, q = lane & 31, h = lane >> 5;
#ifndef XREP_A
#define XREP_A 1
#endif
#ifndef XREP_B
#define XREP_B 1
#endif
#ifndef XREP_S
#define XREP_S 1
#endif
    for (int unit = unit0; unit < 256; unit += unit_step) {
        const int pm = unit >> 2, hd = unit & 3, b = pm >> 3;
        const int row = pm * 256 + wid * 32 + q;
        const bf16_t* qp = Qb + (size_t)row * 1024 + hd * 256 + 8 * h;
#pragma unroll 4
        for (int i = 0; i < 16; ++i) { const int id = tid + 512 * i, key = id >> 5, ch = id & 31;
            const u32x4 w = gld<u32x4>(KX + (size_t)(b * MEML + key) * 1024 + hd * 256 + ch * 8);
            *(u32x4*)(lds + key * 528 + ch * 16) = w; }
        __syncthreads();
        f32x16 sacc[8];
        {
#pragma unroll
        for (int kt = 0; kt < 8; ++kt)
#pragma unroll
            for (int r = 0; r < 16; ++r) sacc[kt][r] = 0.f;
#pragma unroll 4
        for (int ks = 0; ks < 16; ++ks) {
            const s16x8 qf = gld<s16x8>(qp + 16 * ks);
#pragma unroll
            for (int kt = 0; kt < 8; ++kt) { const s16x8 kf = *(const s16x8*)(lds + (32 * kt + q) * 528 + (16 * ks + 8 * h) * 2);
                sacc[kt] = __builtin_amdgcn_mfma_f32_32x32x16_bf16(kf, qf, sacc[kt], 0, 0, 0); }
        }
        }
        float mx = -3.0e38f;
#pragma unroll
        for (int kt = 0; kt < 8; ++kt)
#pragma unroll
            for (int r = 0; r < 16; ++r) mx = fmaxf(mx, sacc[kt][r]);
        mx = fmaxf(mx, __shfl_xor(mx, 32));
        float ls = 0.f;
        s16x8 pf[8][2];
#pragma unroll
        for (int kt = 0; kt < 8; ++kt) {
#pragma unroll
            for (int r = 0; r < 16; ++r) { const float e = __builtin_amdgcn_exp2f(sacc[kt][r] - mx); sacc[kt][r] = e; ls += e; }
#pragma unroll
            for (int s2 = 0; s2 < 2; ++s2) { u32x4 w;
                w.x = cvt_pk_bf16(sacc[kt][8 * s2 + 0], sacc[kt][8 * s2 + 1]); w.y = cvt_pk_bf16(sacc[kt][8 * s2 + 2], sacc[kt][8 * s2 + 3]);
                w.z = cvt_pk_bf16(sacc[kt][8 * s2 + 4], sacc[kt][8 * s2 + 5]); w.w = cvt_pk_bf16(sacc[kt][8 * s2 + 6], sacc[kt][8 * s2 + 7]);
                pf[kt][s2] = __builtin_bit_cast(s16x8, w); }
        }
        ls += __shfl_xor(ls, 32);
        const float inv = 1.0f / ls;
        __syncthreads();
#pragma unroll 8
        for (int i = 0; i < 16; ++i) { const int id = tid + 512 * i, d = id >> 5, ch = id & 31; const u32x4 w = gld<u32x4>(VT + (size_t)(hd * 256 + d) * MM + b * MEML + ch * 8);
            unsigned char* gp_ = lds + d * 528 + (ch >> 1) * 32 + (ch & 1) * 8;
            *(u32x2*)gp_ = (u32x2){w.x, w.y}; *(u32x2*)(gp_ + 16) = (u32x2){w.z, w.w}; }
        __syncthreads();
#pragma unroll 1
        for (int dt = 0; dt < 8; ++dt) {
            f32x16 oacc;
#pragma unroll
            for (int r = 0; r < 16; ++r) oacc[r] = 0.f;
            const unsigned char* vb = lds + (32 * dt + q) * 528 + 16 * h;
#pragma unroll
            for (int kt = 0; kt < 8; ++kt)
#pragma unroll
                for (int s2 = 0; s2 < 2; ++s2) {
                    const s16x8 vf = *(const s16x8*)(vb + (32 * kt + 16 * s2) * 2);
                    oacc = __builtin_amdgcn_mfma_f32_32x32x16_bf16(vf, pf[kt][s2], oacc, 0, 0, 0);
                }
            __syncthreads();
            unsigned char* ow = lds + (32 * dt) * 528 + wid * 2048 + q * 64 + 8 * h;
#pragma unroll
            for (int g = 0; g < 4; ++g) { u32x2 w; w.x = cvt_pk_bf16(oacc[4 * g + 0] * inv, oacc[4 * g + 1] * inv); w.y = cvt_pk_bf16(oacc[4 * g + 2] * inv, oacc[4 * g + 3] * inv);
                *(u32x2*)(ow + 16 * g) = w; }
        }
        __builtin_amdgcn_wave_barrier();
        {
          const unsigned char* orow = lds + ((lane & 31) >> 2) * (32 * 528) + wid * 2048 + (lane & 3) * 16;
          bf16_t* obase = O + (size_t)(pm * 256 + wid * 32) * 1024 + hd * 256 + 8 * (lane & 31);
#pragma unroll
          for (int i = 0; i < 16; ++i) { const int r = (lane >> 5) + 2 * i; gst<u32x4>(obase + (size_t)r * 1024, *(const u32x4*)(orow + r * 64)); }
        }
        __syncthreads();
    }
}

__device__ __forceinline__ void sgu_naive(unsigned char* lds, const Params& p, int i) {
    unsigned char* wsl = p.ws; asm volatile("" : "+s"(wsl));
    bf16_t* U = (bf16_t*)(wsl + WS_B0); const bf16_t* V = (const bf16_t*)(wsl + WS_B1); const bf16_t* G = (const bf16_t*)(wsl + WS_B2); const float* LNS = (const float*)(wsl + WS_LNS);
    const float* lng = p.in[9] + i * 1024; const float* lnb = p.in[10] + i * 1024; const float* Ws = p.in[11] + (size_t)i * 4 * 128 * 128; const float* bs = p.in[12] + i * 4 * 128;
    float* vn = (float*)lds;
    float* mu = vn + 128 * 256;
    float* rsd = mu + 128;
    const int tid = tid_l();
    for (int item = bid_l(); item < 128 * 4; item += gridDim.x) {
        const int chunk = item >> 2, g = item & 3, row0 = chunk * 128;
        if (tid < 128) { float s = 0.f, q = 0.f;
            for (int k = 0; k < 4; ++k) { s += LNS[(size_t)k * M + row0 + tid]; q += LNS[(size_t)(4 + k) * M + row0 + tid]; }
            const float m = s * (1.0f / 1024.f); const float var = q * (1.0f / 1024.f) - m * m; mu[tid] = m; rsd[tid] = rsqrtf(fmaxf(var, 0.f) + EPS); }
        __syncthreads();
#pragma unroll 2
        for (int e = tid; e < 128 * 256; e += NT) { const int j = e >> 8, c = e & 255, col = g * 256 + c;
            vn[e] = (bf2f(V[(size_t)(row0 + j) * 1024 + col]) - mu[j]) * rsd[j] * lng[col] + lnb[col]; }
        __syncthreads();
#pragma unroll 1
        for (int e = tid; e < 128 * 256; e += NT) { const int ii = e >> 8, c = e & 255, col = g * 256 + c; const float* wr = Ws + (size_t)g * 128 * 128 + (size_t)ii * 128;
            float acc = 0.f;
#pragma unroll 4
            for (int j = 0; j <= ii; ++j) acc += wr[j] * vn[j * 256 + c];
            acc += bs[g * 128 + ii];
            const size_t off = (size_t)(row0 + ii) * 1024 + col;
            U[off] = f2bf(bf2f(U[off]) * acc * bf2f(G[off])); }
        __syncthreads();
    }
}

constexpr size_t WS_WP = WS_B2, WS_VP = WS_B2 + 16 * MiB;
__device__ __forceinline__ void xattn_prep(unsigned char* lds, const Params& p, int l) {
    unsigned char* wsl = p.ws; asm volatile("" : "+s"(wsl));
    const bf16_t* KX = (const bf16_t*)(wsl + WS_KVX) + (size_t)l * MM * 1024; const bf16_t* VX = (const bf16_t*)(wsl + WS_VTX) + (size_t)l * MM * 1024;
    const bf16_t* WQ = (const bf16_t*)(wsl + WS_WXQ) + (size_t)l * 1024 * 1024; const bf16_t* WO = (const bf16_t*)(wsl + WS_WXO) + (size_t)l * 1024 * 1024;
    for (int j = bid_l(); j < 256; j += gridDim.x) {
        const int jj = j & 127, b = jj >> 4, hd = (jj >> 2) & 3, t4 = jj & 3;
        const bf16_t* A; const bf16_t* Bt; bf16_t* dst;
        if (j < 128) { A = KX + (size_t)(b * MEML) * 1024 + hd * 256; Bt = WQ + (size_t)(t4 * 256) * 1024 + hd * 256; dst = (bf16_t*)(wsl + WS_WP) + (size_t)(b * 1024 + hd * 256) * 1024 + t4 * 256; }
        else         { A = WO + (size_t)(t4 * 256) * 1024 + hd * 256; Bt = VX + (size_t)(b * MEML) * 1024 + hd * 256; dst = (bf16_t*)(wsl + WS_VP) + (size_t)(b * 1024 + t4 * 256) * 1024 + hd * 256; }
        EpiTile E{dst};
        run_gemm<1>(lds, A, A, 256, Bt, 256, 256, 256, E, 1 << 20, 0, 1 << 20, 0, 1, 0, 1024, 1024);
    }
}
__device__ __forceinline__ void xattn_s(unsigned char* lds, const Params& p) {
    unsigned char* wsl = p.ws; asm volatile("" : "+s"(wsl));
    for (int i = 0;; ++i) {
        const int pu = pg8::static_unit(M, 1024, (int)gridDim.x, bid_l(), i); if (pu < 0) break;
        const int pm = __builtin_amdgcn_readfirstlane(pu >> 16), hd = __builtin_amdgcn_readfirstlane(pu & 65535), b = pm >> 3;
        const bf16_t* A = (const bf16_t*)(wsl + WS_XB) + (size_t)(pm * 256) * 1024;
        EpiSoftmaxP E{(bf16_t*)(wsl + WS_B0) + (size_t)(pm * 256) * 1024 + hd * 256, (const float*)(wsl + WS_RS) + pm * 256, lds + 131072};
        run_gemm<1>(lds, A, A, 1024, (const bf16_t*)(wsl + WS_WP) + (size_t)(b * 1024 + hd * 256) * 1024, 256, 256, 1024, E, 1 << 20, 0, 1 << 20, 0, 1, 0, 1024, 1024);
    }
}
__device__ __forceinline__ void xattn_o(unsigned char* lds, const Params& p, const int dry) {
    unsigned char* wsl = p.ws; asm volatile("" : "+s"(wsl));
    for (int i = 0;; ++i) {
        const int pu = pg8::static_unit(M, 1024, (int)gridDim.x, bid_l(), i); if (pu < 0) break;
        const int pm = __builtin_amdgcn_readfirstlane(pu >> 16), pn = __builtin_amdgcn_readfirstlane(pu & 65535), b = pm >> 3;
        const bf16_t* A = (const bf16_t*)(wsl + WS_B0) + (size_t)(pm * 256) * 1024;
        EpiResid E{(bf16_t*)(wsl + WS_XB) + (size_t)(pm * 256) * 1024 + pn * 256, (float*)(wsl + WS_RS) + (size_t)pn * M + pm * 256, lds + 131072, dry};
        run_gemm<1>(lds, A, A, 1024, (const bf16_t*)(wsl + WS_VP) + (size_t)(b * 1024 + pn * 256) * 1024, 256, 256, 1024, E, 1 << 20, 0, 1 << 20, 0, 1, 0, 1024, 1024);
    }
}

__device__ __forceinline__ void xattn_o_final(unsigned char* lds, const Params& p, const XcdBarrier& xbar) {
    unsigned char* wsl = p.ws; asm volatile("" : "+s"(wsl));
    const int pu = pg8::static_unit(M, 1024, 256, bid_l(), 0);
    const int pm = __builtin_amdgcn_readfirstlane(pu >> 16), pn = __builtin_amdgcn_readfirstlane(pu & 65535), b = pm >> 3;
    const bf16_t* A = (const bf16_t*)(wsl + WS_B0) + (size_t)(pm * 256) * 1024;
    EpiResidFinal E{(const bf16_t*)(wsl + WS_XB) + (size_t)(pm * 256) * 1024 + pn * 256, (float*)(wsl + WS_RS) + (size_t)pn * M + pm * 256, (const float*)(wsl + WS_RS) + pm * 256,
                    p.in[29] + pn * 256, p.out + (size_t)(pm * 256) * 1024 + pn * 256, lds + 131072, &xbar};
    run_gemm<1>(lds, A, A, 1024, (const bf16_t*)(wsl + WS_VP) + (size_t)(b * 1024 + pn * 256) * 1024, 256, 256, 1024, E, 1 << 20, 0, 1 << 20, 0, 1, 0, 1024, 1024);
}

__device__ __forceinline__ void sgu_mfma(unsigned char* lds, const Params& p, int i, const int dry) {
    unsigned char* wsl = p.ws; asm volatile("" : "+s"(wsl));
    bf16_t* U = (bf16_t*)(wsl + WS_B0); const bf16_t* V = (const bf16_t*)(wsl + WS_B1); const bf16_t* G = (const bf16_t*)(wsl + WS_B2); const float* LNS = (const float*)(wsl + WS_LNS);
    const bf16_t* SW = (const bf16_t*)(wsl + WS_SGUW) + (size_t)i * 4 * 128 * 128;
    const float* lng = p.in[9] + i * 1024; const float* lnb = p.in[10] + i * 1024; const float* bs = p.in[12] + i * 4 * 128;
    const int tid = tid_l(), lane = tid & 63, wid = tid >> 6, q = lane & 31, h = lane >> 5;
    float* mu = (float*)(lds + 73728); float* rsd = mu + 128;
    const unsigned tr_base = (unsigned)(size_t)lds + (unsigned)((8 * h + ((lane & 15) >> 2)) * 576 + (32 * wid + 16 * ((lane >> 4) & 1) + 4 * (lane & 3)) * 2);
    for (int item = bid_l(); item < 128 * 4; item += gridDim.x) {
        const int chunk = item >> 2, g = item & 3, row0 = chunk * 128;
        __syncthreads();
        if (tid < 128) { float sm = 0.f, qq = 0.f;
#pragma unroll
            for (int k = 0; k < 4; ++k) { sm += LNS[(size_t)k * M + row0 + tid]; qq += LNS[(size_t)(4 + k) * M + row0 + tid]; }
            const float mm = sm * (1.0f / 1024.f); const float var = qq * (1.0f / 1024.f) - mm * mm; mu[tid] = mm; rsd[tid] = rsqrtf(fmaxf(var, 0.f) + EPS); }
        __syncthreads();
#pragma unroll 2
        for (int k = 0; k < 8; ++k) { const int id = tid + 512 * k, j = id >> 5, c8 = id & 31, col = g * 256 + 8 * c8;
            const u32x4 w = gld<u32x4>(V + (size_t)(row0 + j) * 1024 + col);
            const f32x4 g0 = gld<f32x4>(lng + col), g1 = gld<f32x4>(lng + col + 4), b0 = gld<f32x4>(lnb + col), b1 = gld<f32x4>(lnb + col + 4);
            const float m_ = mu[j], r_ = rsd[j];
            const f32x4 v0 = (f32x4){(bflo(w.x) - m_) * r_ * g0.x + b0.x, (bfhi(w.x) - m_) * r_ * g0.y + b0.y, (bflo(w.y) - m_) * r_ * g0.z + b0.z, (bfhi(w.y) - m_) * r_ * g0.w + b0.w};
            const f32x4 v1 = (f32x4){(bflo(w.z) - m_) * r_ * g1.x + b1.x, (bfhi(w.z) - m_) * r_ * g1.y + b1.y, (bflo(w.w) - m_) * r_ * g1.z + b1.z, (bfhi(w.w) - m_) * r_ * g1.w + b1.w};
            *(u32x4*)(lds + j * 576 + c8 * 16) = pack8(v0, v1); }
#pragma unroll
        for (int k = 0; k < 4; ++k) { const int id = tid + 512 * k, wrow = id >> 4, c16 = id & 15;
            *(u32x4*)(lds + 74752 + wrow * 272 + c16 * 16) = gld<u32x4>(SW + (size_t)g * 128 * 128 + (size_t)wrow * 128 + 8 * c16); }
        __syncthreads();
        f32x16 acc[4];
#pragma unroll
        for (int it = 0; it < 4; ++it)
#pragma unroll
            for (int e = 0; e < 16; ++e) acc[it][e] = 0.f;
        const unsigned char* wl = lds + 74752 + q * 272 + 16 * h;
#pragma unroll
        for (int ks = 0; ks < 8; ++ks) {
            s16x4 t0, t1; const unsigned a = tr_base + ks * 9216;
            asm volatile("ds_read_b64_tr_b16 %0, %2 offset:0\n\tds_read_b64_tr_b16 %1, %2 offset:2304\n\ts_waitcnt lgkmcnt(0)" : "=&v"(t0), "=&v"(t1) : "v"(a) : "memory");
            const s16x8 vf = __builtin_shufflevector(t0, t1, 0, 1, 2, 3, 4, 5, 6, 7);
#pragma unroll
            for (int it = ks >> 1; it < 4; ++it) { const s16x8 wf = *(const s16x8*)(wl + (32 * it) * 272 + 32 * ks);
                acc[it] = __builtin_amdgcn_mfma_f32_32x32x16_bf16(vf, wf, acc[it], 0, 0, 0); }
        }
        __syncthreads();
#pragma unroll
        for (int it = 0; it < 4; ++it)
#pragma unroll
            for (int gg = 0; gg < 4; ++gg)
                *(f32x4*)(lds + (32 * it + q) * 1040 + (32 * wid + 8 * gg + 4 * h) * 4) = (f32x4){acc[it][4 * gg + 0], acc[it][4 * gg + 1], acc[it][4 * gg + 2], acc[it][4 * gg + 3]};
        __syncthreads();
#pragma unroll 2
        for (int k = 0; k < 8; ++k) { const int id = tid + 512 * k, ii = id >> 5, c8 = id & 31;
            const size_t off = (size_t)(row0 + ii) * 1024 + g * 256 + 8 * c8;
            const u32x4 uu = gld<u32x4>(U + off);
            const f32x4 d0 = *(const f32x4*)(lds + ii * 1040 + c8 * 32), d1 = *(const f32x4*)(lds + ii * 1040 + c8 * 32 + 16);
            const float bias = gld<float>(bs + g * 128 + ii);
            const f32x4 o0 = (f32x4){(d0.x + bias) * bflo(uu.x), (d0.y + bias) * bfhi(uu.x), (d0.z + bias) * bflo(uu.y), (d0.w + bias) * bfhi(uu.y)};
            const f32x4 o1 = (f32x4){(d1.x + bias) * bflo(uu.z), (d1.y + bias) * bfhi(uu.z), (d1.z + bias) * bflo(uu.w), (d1.w + bias) * bfhi(uu.w)};
            if (!dry) wst16(U, off * 2, pack8(o0, o1)); }
    }
}
__device__ __forceinline__ void conv_sguw(const Params& p) {
    unsigned char* wsl = p.ws; asm volatile("" : "+s"(wsl));
    bf16_t* SW = (bf16_t*)(wsl + WS_SGUW);
    for (int e = blockIdx.x * NT + tid_l(); e < 2 * 4 * 128 * 128; e += gridDim.x * NT) { const int ii = (e >> 7) & 127, j = e & 127; SW[e] = f2bf(j <= ii ? p.in[11][e] : 0.f); }
}

__device__ __forceinline__ void s5_naive(const Params& p, int i) {
    unsigned char* wsl = p.ws; asm volatile("" : "+s"(wsl));
    bf16_t* XD = (bf16_t*)(wsl + WS_B3);
    const int tidl = tid_l(), lane = tidl & 63, wid = tidl >> 6;
    if (wid != 0) return;
    for (int item = bid_l(); item < BATCH * 32; item += gridDim.x) {
        const int b = item >> 5, g = item & 31;
        const float dt = expf(p.in[15][i * 32 + g]);
        const float ar = p.in[13][(i * 32 + g) * 64 + lane], ai = p.in[14][(i * 32 + g) * 64 + lane];
        const float mag = expf(dt * ar), abr = mag * cosf(dt * ai), abi = mag * sinf(dt * ai);
        const float nr = abr - 1.0f, ni = abi, inv = 1.0f / (ar * ar + ai * ai);
        const float cr = (nr * ar + ni * ai) * inv, ci = (ni * ar - nr * ai) * inv;
        float bbr[16], bbi[16], cre[16], cim[16];
#pragma unroll
        for (int h = 0; h < 16; ++h) {
            const float br = p.in[16][((size_t)(i * 32 + g) * 64 + lane) * 16 + h], bi = p.in[17][((size_t)(i * 32 + g) * 64 + lane) * 16 + h];
            bbr[h] = cr * br - ci * bi; bbi[h] = cr * bi + ci * br;
            cre[h] = p.in[18][((size_t)(i * 32 + g) * 16 + h) * 64 + lane]; cim[h] = p.in[19][((size_t)(i * 32 + g) * 16 + h) * 64 + lane];
        }
        const float dsk = (lane < 16) ? p.in[20][i * 512 + g * 16 + lane] : 0.f;
        float hr = 0.f, hi = 0.f;
#pragma unroll 1
        for (int t = 0; t < SEQ; ++t) {
            bf16_t* up = XD + (size_t)(b * SEQ + t) * 1024 + g * 16;
            const u32x4 w0 = *(const u32x4*)up, w1 = *(const u32x4*)(up + 8);
            float u[16];
            u[0] = __uint_as_float(w0.x << 16); u[1] = __uint_as_float(w0.x & 0xffff0000u); u[2] = __uint_as_float(w0.y << 16); u[3] = __uint_as_float(w0.y & 0xffff0000u);
            u[4] = __uint_as_float(w0.z << 16); u[5] = __uint_as_float(w0.z & 0xffff0000u); u[6] = __uint_as_float(w0.w << 16); u[7] = __uint_as_float(w0.w & 0xffff0000u);
            u[8] = __uint_as_float(w1.x << 16); u[9] = __uint_as_float(w1.x & 0xffff0000u); u[10] = __uint_as_float(w1.y << 16); u[11] = __uint_as_float(w1.y & 0xffff0000u);
            u[12] = __uint_as_float(w1.z << 16); u[13] = __uint_as_float(w1.z & 0xffff0000u); u[14] = __uint_as_float(w1.w << 16); u[15] = __uint_as_float(w1.w & 0xffff0000u);
            float bur = 0.f, bui = 0.f;
#pragma unroll
            for (int h = 0; h < 16; ++h) { bur += u[h] * bbr[h]; bui += u[h] * bbi[h]; }
            const float nhr = abr * hr - abi * hi + bur, nhi = abr * hi + abi * hr + bui; hr = nhr; hi = nhi;
            float mine = 0.f, umine = 0.f;
#pragma unroll
            for (int h = 0; h < 16; ++h) { const float r = wave_sum(hr * cre[h] - hi * cim[h]); if (lane == h) { mine = r; umine = u[h]; } }
            if (lane < 16) up[lane] = f2bf(gelu_tanh_f(mine + dsk * umine));
        }
    }
}

typedef float f32x4v __attribute__((ext_vector_type(4)));
typedef float f32x2v_ __attribute__((ext_vector_type(2)));
__device__ __forceinline__ float row16_sum_last(float v) {
    v += __int_as_float(__builtin_amdgcn_update_dpp(0, __float_as_int(v), 0x111, 0xf, 0xf, true));
    v += __int_as_float(__builtin_amdgcn_update_dpp(0, __float_as_int(v), 0x112, 0xf, 0xf, true));
    v += __int_as_float(__builtin_amdgcn_update_dpp(0, __float_as_int(v), 0x114, 0xf, 0xf, true));
    v += __int_as_float(__builtin_amdgcn_update_dpp(0, __float_as_int(v), 0x118, 0xf, 0xf, true));
    return v;
}
template <int PASS>
__device__ __forceinline__ void s5_pass(float& hr, float& hi, const float (&pwr)[4], const float (&pwi)[4], const float p16r, const float p16i, const pg8::bf16x8 (&bfrag)[8], const pg8::bf16x8 (&cfrag)[4], const f32x4v dsk,
                                        bf16_t* XD, unsigned char* BUw, unsigned char* Hw, int b, int g, int wid, int lane, int tl, int kq, const int dry) {
            bf16_t* ubase = XD + (size_t)(b * SEQ + wid * 256 + tl) * 1024 + g * 16;
            pg8::bf16x8 ufn[2]; u32x2 uen[2];
#pragma unroll
            for (int k2 = 0; k2 < 2; ++k2) { ufn[k2] = (pg8::bf16x8){0, 0, 0, 0, 0, 0, 0, 0}; uen[k2] = (u32x2){0u, 0u};
                if (kq < 2) ufn[k2] = gld<pg8::bf16x8>(ubase + (size_t)(16 * k2) * 1024 + 8 * kq);
                if constexpr (PASS == 1) uen[k2] = gld<u32x2>(ubase + (size_t)(16 * k2) * 1024 + 4 * kq); }
#pragma unroll 1
            for (int tt = 0; tt < 16; ++tt) {
                bf16_t* urow = ubase + (size_t)(16 * tt) * 1024;
                const pg8::bf16x8 ufrag = ufn[0]; const u32x2 ue = uen[0];
                ufn[0] = ufn[1]; uen[0] = uen[1];
                if (tt + 2 < 16) { if (kq < 2) ufn[1] = gld<pg8::bf16x8>(urow + (size_t)32 * 1024 + 8 * kq); if constexpr (PASS == 1) uen[1] = gld<u32x2>(urow + (size_t)32 * 1024 + 4 * kq); }
#pragma unroll
                for (int rt = 0; rt < 8; ++rt) {
                    const f32x4 d = __builtin_amdgcn_mfma_f32_16x16x32_bf16(bfrag[rt], ufrag, (f32x4){0.f, 0.f, 0.f, 0.f}, 0, 0, 0);
                    *(u32x2*)(BUw + tl * 272 + (8 * rt + 2 * kq) * 4) = (u32x2){cvt_pk_bf16(d.x, d.y), cvt_pk_bf16(d.z, d.w)};
                }
                __builtin_amdgcn_wave_barrier();
                float bur[16], bui[16];
#pragma unroll
                for (int t = 0; t < 16; ++t) { const unsigned bw = *(const unsigned*)(BUw + t * 272 + lane * 4); bur[t] = bflo(bw); bui[t] = bfhi(bw); }
                if constexpr (PASS == 0) {
                    float cr[4], ci[4];
#pragma unroll
                    for (int j = 0; j < 4; ++j) { float r = bur[4 * j], im = bui[4 * j];
#pragma unroll
                        for (int i2 = 1; i2 < 4; ++i2) { const float nr = fmaf(pwr[0], r, fmaf(-pwi[0], im, bur[4 * j + i2])), ni = fmaf(pwr[0], im, fmaf(pwi[0], r, bui[4 * j + i2])); r = nr; im = ni; }
                        cr[j] = r; ci[j] = im; }
                    float sr = cr[0], si = ci[0];
#pragma unroll
                    for (int j = 1; j < 4; ++j) { const float nr = fmaf(pwr[3], sr, fmaf(-pwi[3], si, cr[j])), ni = fmaf(pwr[3], si, fmaf(pwi[3], sr, ci[j])); sr = nr; si = ni; }
                    { const float nr = fmaf(p16r, hr, fmaf(-p16i, hi, sr)), ni = fmaf(p16r, hi, fmaf(p16i, hr, si)); hr = nr; hi = ni; }
                } else {
#pragma unroll
                for (int j = 0; j < 4; ++j)
#pragma unroll
                    for (int i2 = 1; i2 < 4; ++i2) { const int t = 4 * j + i2;
                        const float lr = fmaf(pwr[0], bur[t - 1], fmaf(-pwi[0], bui[t - 1], bur[t])), li = fmaf(pwr[0], bui[t - 1], fmaf(pwi[0], bur[t - 1], bui[t])); bur[t] = lr; bui[t] = li; }
#pragma unroll
                for (int j = 0; j < 4; ++j) {
                    const float cr = hr, ci = hi;
#pragma unroll
                    for (int i2 = 0; i2 < 4; ++i2) { const int t = 4 * j + i2;
                        const float xr = fmaf(pwr[i2], cr, fmaf(-pwi[i2], ci, bur[t])), xi = fmaf(pwr[i2], ci, fmaf(pwi[i2], cr, bui[t]));
                        if constexpr (PASS == 1) *(unsigned*)(Hw + t * 272 + lane * 4) = cvt_pk_bf16(xr, xi);
                        if (i2 == 3) { hr = xr; hi = xi; } }
                }
                }
                if constexpr (PASS == 1) {
                    __builtin_amdgcn_wave_barrier();
                    f32x4 y = (f32x4){0.f, 0.f, 0.f, 0.f};
#pragma unroll
                    for (int kk = 0; kk < 4; ++kk) { const pg8::bf16x8 hf = *(const pg8::bf16x8*)(Hw + tl * 272 + (32 * kk + 8 * kq) * 2);
                        y = __builtin_amdgcn_mfma_f32_16x16x32_bf16(cfrag[kk], hf, y, 0, 0, 0); }
                    float yy[4] = {y.x + dsk.x * bflo(ue.x), y.y + dsk.y * bfhi(ue.x), y.z + dsk.z * bflo(ue.y), y.w + dsk.w * bfhi(ue.y)};
#pragma unroll
                    for (int r = 0; r < 4; ++r) { const float x = yy[r]; yy[r] = x * fsigmoid(1.5957691216057308f * (x + 0.044715f * x * x * x)); }
                    u32x2 w; w.x = cvt_pk_bf16(yy[0], yy[1]); w.y = cvt_pk_bf16(yy[2], yy[3]);
                    if (!dry) gst<u32x2>(urow + 4 * kq, w);
                }
                __builtin_amdgcn_wave_barrier();
            }
}
__device__ __forceinline__ void s5_tables(unsigned char* lds, const Params& p, int combo) {
    unsigned char* wsl = p.ws; asm volatile("" : "+s"(wsl));
    const int tid = tid_l(), i = combo >> 5, g = combo & 31;
    bf16_t* TB = (bf16_t*)lds; float* LP = (float*)(lds + 8192);
    __syncthreads();
    if (tid < 64) {
        const int pp = tid;
        const float dt = expf(p.in[15][i * 32 + g]);
        const float ar = p.in[13][(i * 32 + g) * 64 + pp], ai = p.in[14][(i * 32 + g) * 64 + pp];
        const float mag = expf(dt * ar), abr = mag * cosf(dt * ai), abi = mag * sinf(dt * ai);
        const float nr = abr - 1.0f, ni = abi, inv = 1.0f / (ar * ar + ai * ai);
        const float cr = (nr * ar + ni * ai) * inv, ci = (ni * ar - nr * ai) * inv;
#pragma unroll
        for (int h = 0; h < 16; ++h) {
            const float br = p.in[16][((size_t)(i * 32 + g) * 64 + pp) * 16 + h], bi = p.in[17][((size_t)(i * 32 + g) * 64 + pp) * 16 + h];
            TB[(2 * pp) * 16 + h] = f2bf(cr * br - ci * bi); TB[(2 * pp + 1) * 16 + h] = f2bf(cr * bi + ci * br); }
        float xr = 1.f, xi = 0.f;
        for (int m = 0; m < 16; ++m) { LP[(tid * 16 + m) * 2] = xr; LP[(tid * 16 + m) * 2 + 1] = xi; const float t2 = xr * abr - xi * abi; xi = xr * abi + xi * abr; xr = t2; }
    }
    __syncthreads();
    { const int r = tid >> 2, pp = r >> 1, c = r & 1, s0 = 4 * (tid & 3);
      bf16_t* dst = (bf16_t*)(wsl + WS_S5W) + (size_t)combo * 128 * 256 + (size_t)r * 256;
      float bre[16], bim[16];
#pragma unroll
      for (int h8 = 0; h8 < 2; ++h8) { const u32x4 tr = *(const u32x4*)(TB + (2 * pp) * 16 + 8 * h8), ti = *(const u32x4*)(TB + (2 * pp + 1) * 16 + 8 * h8);
          bre[8 * h8 + 0] = bflo(tr.x); bre[8 * h8 + 1] = bfhi(tr.x); bre[8 * h8 + 2] = bflo(tr.y); bre[8 * h8 + 3] = bfhi(tr.y); bre[8 * h8 + 4] = bflo(tr.z); bre[8 * h8 + 5] = bfhi(tr.z); bre[8 * h8 + 6] = bflo(tr.w); bre[8 * h8 + 7] = bfhi(tr.w);
          bim[8 * h8 + 0] = bflo(ti.x); bim[8 * h8 + 1] = bfhi(ti.x); bim[8 * h8 + 2] = bflo(ti.y); bim[8 * h8 + 3] = bfhi(ti.y); bim[8 * h8 + 4] = bflo(ti.z); bim[8 * h8 + 5] = bfhi(ti.z); bim[8 * h8 + 6] = bflo(ti.w); bim[8 * h8 + 7] = bfhi(ti.w); }
#pragma unroll
      for (int ss = 0; ss < 4; ++ss) { const int sx = s0 + ss; const float lr = LP[(pp * 16 + 15 - sx) * 2], li = LP[(pp * 16 + 15 - sx) * 2 + 1];
          const float ka = lr, kb = c ? li : -li;
#pragma unroll
          for (int h8 = 0; h8 < 2; ++h8) { float v[8];
#pragma unroll
              for (int j = 0; j < 8; ++j) v[j] = c ? (ka * bim[8 * h8 + j] + kb * bre[8 * h8 + j]) : (ka * bre[8 * h8 + j] + kb * bim[8 * h8 + j]);
              u32x4 o; o.x = cvt_pk_bf16(v[0], v[1]); o.y = cvt_pk_bf16(v[2], v[3]); o.z = cvt_pk_bf16(v[4], v[5]); o.w = cvt_pk_bf16(v[6], v[7]);
              wst16(dst, (size_t)(16 * sx + 8 * h8) * 2, o); } } }
    __syncthreads();
}
__device__ __forceinline__ void s5_mfma(unsigned char* lds, const Params& p, int i, const int dry) {
    unsigned char* wsl = p.ws; asm volatile("" : "+s"(wsl));
    bf16_t* XD = (bf16_t*)(wsl + WS_B3);
    const int tid = tid_l(), lane = tid & 63, wid = tid >> 6, tl = lane & 15, kq = lane >> 4;
    bf16_t* TB = (bf16_t*)lds;
    bf16_t* TC = (bf16_t*)(lds + 4096);
    float* AB = (float*)(lds + 8192);
    float* A256 = (float*)(lds + 8704);
    float* HE = (float*)(lds + 9216);
    unsigned char* BUw = lds + 16384 + wid * 12800;
    unsigned char* Hw = BUw + 8448;
    for (int item = bid_l(); item < BATCH * 32; item += gridDim.x) {
        const int it2 = (S5_XCD_MAP && gridDim.x == 256) ? ((item & 7) * 32 + (item >> 3)) : item;
        const int b = it2 >> 5, g = it2 & 31;
        __syncthreads();
        if (tid < 64) {
            const int pp = tid;
            const float dt = expf(p.in[15][i * 32 + g]);
            const float ar = p.in[13][(i * 32 + g) * 64 + pp], ai = p.in[14][(i * 32 + g) * 64 + pp];
            const float mag = expf(dt * ar), abr = mag * cosf(dt * ai), abi = mag * sinf(dt * ai);
            const float nr = abr - 1.0f, ni = abi, inv = 1.0f / (ar * ar + ai * ai);
            const float cr = (nr * ar + ni * ai) * inv, ci = (ni * ar - nr * ai) * inv;
#pragma unroll
            for (int h = 0; h < 16; ++h) {
                const float br = p.in[16][((size_t)(i * 32 + g) * 64 + pp) * 16 + h], bi = p.in[17][((size_t)(i * 32 + g) * 64 + pp) * 16 + h];
                TB[(2 * pp) * 16 + h] = f2bf(cr * br - ci * bi); TB[(2 * pp + 1) * 16 + h] = f2bf(cr * bi + ci * br);
                TC[h * 128 + 2 * pp] = f2bf(p.in[18][((size_t)(i * 32 + g) * 16 + h) * 64 + pp]); TC[h * 128 + 2 * pp + 1] = f2bf(-p.in[19][((size_t)(i * 32 + g) * 16 + h) * 64 + pp]);
            }
            AB[pp] = abr; AB[64 + pp] = abi;
            float xr = abr, xi = abi;
#pragma unroll
            for (int k = 0; k < 8; ++k) { const float t2 = xr * xr - xi * xi; xi = 2.0f * xr * xi; xr = t2; }
            A256[pp] = xr; A256[64 + pp] = xi;
        }
        __syncthreads();
        const float abr = AB[lane], abi = AB[64 + lane];
        float pwr[4], pwi[4]; pwr[0] = abr; pwi[0] = abi;
#pragma unroll
        for (int k = 1; k < 4; ++k) { pwr[k] = pwr[k - 1] * abr - pwi[k - 1] * abi; pwi[k] = pwr[k - 1] * abi + pwi[k - 1] * abr; }
        float p16r, p16i;
        { const float t8r = pwr[3] * pwr[3] - pwi[3] * pwi[3], t8i = 2.0f * pwr[3] * pwi[3]; p16r = t8r * t8r - t8i * t8i; p16i = 2.0f * t8r * t8i; }
        pg8::bf16x8 bfrag[8], cfrag[4];
#pragma unroll
        for (int rt = 0; rt < 8; ++rt) { if (kq < 2) bfrag[rt] = *(const pg8::bf16x8*)(TB + (16 * rt + tl) * 16 + 8 * kq); else bfrag[rt] = (pg8::bf16x8){0, 0, 0, 0, 0, 0, 0, 0}; }
#pragma unroll
        for (int kk = 0; kk < 4; ++kk) cfrag[kk] = *(const pg8::bf16x8*)(TC + tl * 128 + 32 * kk + 8 * kq);
        const f32x4v dsk = *(const f32x4v*)(p.in[20] + i * 512 + g * 16 + 4 * kq);
        float hr = 0.f, hi = 0.f;
#if S5_MFMA_PASS0
        {
            unsigned char* WS = lds + 16384;
            float* WT = (float*)(lds + 16384 + 69632);
            const bool sk2 = false;
            { const bf16_t* wsg = (const bf16_t*)(wsl + WS_S5W) + (size_t)(i * 32 + g) * 128 * 256;
#pragma unroll
              for (int k = 0; k < 8; ++k) { const int id = tid + 512 * k, row = id >> 5, ch = id & 31; *(u32x4*)(WS + row * 528 + ch * 16) = gld<u32x4>(wsg + (size_t)row * 256 + ch * 8); } }
            if (tid < 64) {
                float xr = AB[tid], xi = AB[64 + tid];
#pragma unroll
                for (int k = 0; k < 4; ++k) { const float t2 = xr * xr - xi * xi; xi = 2.0f * xr * xi; xr = t2; }
                const float a16r = xr, a16i = xi; float yr = 1.f, yi = 0.f;
                for (int j = 15; j >= 0; --j) { WT[(tid * 16 + j) * 2] = yr; WT[(tid * 16 + j) * 2 + 1] = yi; const float t2 = yr * a16r - yi * a16i; yi = yr * a16i + yi * a16r; yr = t2; }
            }
            __syncthreads();
            if (!sk2) {
            const bf16_t* ub = XD + (size_t)(b * SEQ + wid * 256 + 16 * tl + (kq >> 1)) * 1024 + g * 16 + 8 * (kq & 1);
            pg8::bf16x8 uf[8];
#pragma unroll
            for (int kk = 0; kk < 8; ++kk) uf[kk] = gld<pg8::bf16x8>(ub + (size_t)(2 * kk) * 1024);
#pragma unroll
            for (int rb = 0; rb < 8; ++rb) {
                f32x4 acc = (f32x4){0.f, 0.f, 0.f, 0.f};
#pragma unroll
                for (int kk = 0; kk < 8; ++kk) acc = __builtin_amdgcn_mfma_f32_16x16x32_bf16(*(const pg8::bf16x8*)(WS + (rb * 16 + tl) * 528 + (kk * 32 + 8 * kq) * 2), uf[kk], acc, 0, 0, 0);
                const int p0 = 8 * rb + 2 * kq;
                const float w0r = WT[(p0 * 16 + tl) * 2], w0i = WT[(p0 * 16 + tl) * 2 + 1], w1r = WT[((p0 + 1) * 16 + tl) * 2], w1i = WT[((p0 + 1) * 16 + tl) * 2 + 1];
                const float e0r = row16_sum_last(w0r * acc.x - w0i * acc.y), e0i = row16_sum_last(w0r * acc.y + w0i * acc.x);
                const float e1r = row16_sum_last(w1r * acc.z - w1i * acc.w), e1i = row16_sum_last(w1r * acc.w + w1i * acc.z);
                if (tl == 15) { HE[(wid * 2 + 0) * 64 + p0] = e0r; HE[(wid * 2 + 1) * 64 + p0] = e0i; HE[(wid * 2 + 0) * 64 + p0 + 1] = e1r; HE[(wid * 2 + 1) * 64 + p0 + 1] = e1i; }
            }
            }
            __syncthreads();
            const float a2r = A256[lane], a2i = A256[64 + lane];
            for (int w2 = 0; w2 < wid; ++w2) { const float er = HE[(w2 * 2 + 0) * 64 + lane], ei = HE[(w2 * 2 + 1) * 64 + lane];
                const float nr2 = a2r * hr - a2i * hi + er, ni2 = a2r * hi + a2i * hr + ei; hr = nr2; hi = ni2; }
            s5_pass<1>(hr, hi, pwr, pwi, p16r, p16i, bfrag, cfrag, dsk, XD, BUw, Hw, b, g, wid, lane, tl, kq, dry);
        }
#else
#pragma unroll 1
        for (int pass = 0; pass < 2; ++pass) {
            if (pass == 1) {
                HE[(wid * 2 + 0) * 64 + lane] = hr; HE[(wid * 2 + 1) * 64 + lane] = hi;
                __syncthreads();
                const float a2r = A256[lane], a2i = A256[64 + lane];
                hr = 0.f; hi = 0.f;
                for (int w2 = 0; w2 < wid; ++w2) { const float er = HE[(w2 * 2 + 0) * 64 + lane], ei = HE[(w2 * 2 + 1) * 64 + lane];
                    const float nr2 = a2r * hr - a2i * hi + er, ni2 = a2r * hi + a2i * hr + ei; hr = nr2; hi = ni2; }
            }
            if (pass == 0) s5_pass<0>(hr, hi, pwr, pwi, p16r, p16i, bfrag, cfrag, dsk, XD, BUw, Hw, b, g, wid, lane, tl, kq, dry);
            else s5_pass<1>(hr, hi, pwr, pwi, p16r, p16i, bfrag, cfrag, dsk, XD, BUw, Hw, b, g, wid, lane, tl, kq, dry);
        }
#endif
    }
}

__device__ __forceinline__ void final_norm(const Params& p) {
    unsigned char* wsl = p.ws; asm volatile("" : "+s"(wsl));
    const bf16_t* XB = (const bf16_t*)(wsl + WS_XB);
    const int tidl = tid_l(), lane = tidl & 63, gw = blockIdx.x * (NT / 64) + (tidl >> 6), ngw = gridDim.x * (NT / 64);
    for (int row = gw; row < M; row += ngw) {
        const u32x4 a = gld<u32x4>(XB + (size_t)row * DM + 8 * lane), c = gld<u32x4>(XB + (size_t)row * DM + 512 + 8 * lane);
        float v[16] = {bflo(a.x), bfhi(a.x), bflo(a.y), bfhi(a.y), bflo(a.z), bfhi(a.z), bflo(a.w), bfhi(a.w), bflo(c.x), bfhi(c.x), bflo(c.y), bfhi(c.y), bflo(c.z), bfhi(c.z), bflo(c.w), bfhi(c.w)};
        float s = 0.f;
#pragma unroll
        for (int j = 0; j < 16; ++j) s += v[j] * v[j];
        s = wave_sum(s); const float r = rsqrtf(s * (1.0f / DM) + EPS);
        const float* gp = p.in[29] + 8 * lane; float* op = p.out + (size_t)row * DM + 8 * lane;
#pragma unroll
        for (int hh = 0; hh < 2; ++hh) { const f32x4 g0 = gld<f32x4>(gp + 512 * hh), g1 = gld<f32x4>(gp + 512 * hh + 4);
            gst<f32x4>(op + 512 * hh, (f32x4){v[8 * hh + 0] * r * g0.x, v[8 * hh + 1] * r * g0.y, v[8 * hh + 2] * r * g0.z, v[8 * hh + 3] * r * g0.w});
            gst<f32x4>(op + 512 * hh + 4, (f32x4){v[8 * hh + 4] * r * g1.x, v[8 * hh + 5] * r * g1.y, v[8 * hh + 6] * r * g1.z, v[8 * hh + 7] * r * g1.w}); }
    }
}

#define WSL(name) unsigned char* name = p.ws; asm volatile("" : "+s"(name))
#define PBF(ws_, off) ((bf16_t*)((ws_) + (off)))
#define PF32(ws_, off) ((float*)((ws_) + (off)))
#ifndef F_KV
#define F_KV 1
#endif
#ifndef F_G1
#define F_G1 1
#endif
#ifndef F_G1U
#define F_G1U 1
#endif
#ifndef F_GG
#define F_GG 1
#endif
#ifndef F_G2
#define F_G2 1
#endif
#ifndef F_G1O
#define F_G1O 1
#endif
#ifndef F_GLU
#define F_GLU 1
#endif
#ifndef F_G2O
#define F_G2O 1
#endif
#ifndef F_G3
#define F_G3 1
#endif
#ifndef F_G4
#define F_G4 1
#endif
#define XB_TMO      128
#define XB_XCNT(j)  (256  + 64 * (j))
#define XB_XSUB(j)  (1280 + 64 * (j))
#define XB_XGEN(j)  (2304 + 64 * (j))
#define XB_TOP      3328
#define XB_TOPGEN   3392
#define XCD_BAR_WORDS 3456
#define XB_SPIN_CAP (1u << 22)
__device__ __forceinline__ unsigned xb_ld(unsigned* p)              { return __hip_atomic_load(p, __ATOMIC_RELAXED, __HIP_MEMORY_SCOPE_AGENT); }
__device__ __forceinline__ unsigned xb_add(unsigned* p, unsigned v) { return __hip_atomic_fetch_add(p, v, __ATOMIC_RELAXED, __HIP_MEMORY_SCOPE_AGENT); }
__device__ __forceinline__ unsigned xb_xcc_id() { return (unsigned)__builtin_amdgcn_s_getreg((3 << 11) | 20) & 0xFu; }
#define XB_SPIN(cond, bar) do { unsigned _sp = 0; while (cond) { __builtin_amdgcn_s_sleep(1); \
    if ((++_sp & 255u) == 0u) { if (xb_ld(&(bar)[XB_TMO])) break; if (_sp > XB_SPIN_CAP) { atomicAdd(&(bar)[XB_TMO], 1u); break; } } } } while (0)
struct XcdBarrier { unsigned* bar; unsigned x; volatile PG8_LAS unsigned* st; };
__device__ __forceinline__ XcdBarrier xcd_barrier_post(unsigned* bar, volatile PG8_LAS unsigned* st) {
    XcdBarrier b; b.bar = bar; b.x = xb_xcc_id(); b.st = st;
    if (threadIdx.x == 0) (void)xb_add(&bar[XB_XCNT(b.x)], 1u);
    return b;
}
__device__ __forceinline__ void xcd_barrier_complete(unsigned* bar, unsigned x, unsigned& nloc, unsigned& nx) {
    const unsigned G = gridDim.x * gridDim.y * gridDim.z;
    unsigned sum, cnt, mine, sp = 0u;
    for (;;) {
        sum = 0u; cnt = 0u; mine = 0u;
#pragma unroll
        for (unsigned j = 0; j < 16; ++j) { const unsigned c = xb_ld(&bar[XB_XCNT(j)]); sum += c; cnt += (c > 0u) ? 1u : 0u; mine = (j == x) ? c : mine; }
        if (sum == G) break;
        __builtin_amdgcn_s_sleep(1);
        if ((++sp & 255u) == 0u) { if (xb_ld(&bar[XB_TMO])) break; if (sp > XB_SPIN_CAP) { atomicAdd(&bar[XB_TMO], 1u); break; } }
    }
    nloc = mine > 0u ? mine : 1u; nx = cnt > 0u ? cnt : 1u;
}
__device__ __forceinline__ void xcd_barrier(const XcdBarrier& b, const bool release) {
    asm volatile("s_waitcnt vmcnt(0)" ::: "memory");
    __syncthreads();
    if (threadIdx.x == 0) {
        unsigned* bar = b.bar;
        __builtin_amdgcn_s_waitcnt(0);
        unsigned nloc = b.st[0], nx = b.st[1];
        if (nloc == 0u) { xcd_barrier_complete(bar, b.x, nloc, nx); b.st[0] = nloc; b.st[1] = nx; }
        const unsigned old = xb_add(&bar[XB_XSUB(b.x)], 1u);
        const unsigned gen = old / nloc;
        if (old + 1u == (gen + 1u) * nloc) {
            if (release) { __builtin_amdgcn_fence(__ATOMIC_RELEASE, "agent"); asm volatile("s_waitcnt vmcnt(0)" ::: "memory"); }
            const unsigned og = xb_add(&bar[XB_TOP], 1u);
            const unsigned tg = og / nx;
            if (og + 1u != (tg + 1u) * nx) XB_SPIN(xb_ld(&bar[XB_TOP]) < (tg + 1u) * nx, bar);
            __builtin_amdgcn_fence(__ATOMIC_ACQUIRE, "agent");
            xb_add(&bar[XB_XGEN(b.x)], 1u);
            asm volatile("s_waitcnt vmcnt(0)" ::: "memory");
        } else {
            XB_SPIN(xb_ld(&bar[XB_XGEN(b.x)]) == gen, bar);
            __builtin_amdgcn_fence(__ATOMIC_ACQUIRE, "agent");
            asm volatile("s_waitcnt vmcnt(0)" ::: "memory");
        }
    }
    __syncthreads();
}

#ifndef REPEAT_MASK
#define REPEAT_MASK 0
#endif
#ifndef SYNC_REP
#define SYNC_REP 1
#endif
#ifndef REPEAT_N
#define REPEAT_N 2
#endif
#define REPN(ty) (((REPEAT_MASK >> (ty)) & 1) ? REPEAT_N : 1)
#define RUN(ty, ...) do { for (int rep_ = 0; rep_ < REPN(ty); ++rep_) { int dry = rep_; asm volatile("" : "+s"(dry)); __VA_ARGS__ } } while (0)
#define GSYNC() do { for (int sr_ = 0; sr_ < SYNC_REP; ++sr_) xcd_barrier(xbar); } while (0)
#ifndef WT_SYNC
#define WT_SYNC 1
#endif
#define GSYNC_WT() do { for (int sr_ = 0; sr_ < SYNC_REP; ++sr_) xcd_barrier(xbar, !WT_SYNC); } while (0)
__global__ void __launch_bounds__(NT) mega(Params p) {
    extern __shared__ __attribute__((aligned(16))) unsigned char lds[];
    if (threadIdx.x < 2) ((volatile PG8_LAS unsigned*)((PG8_LAS unsigned char*)lds + 143360))[threadIdx.x] = 0u;
    __syncthreads();
    const XcdBarrier xbar = xcd_barrier_post((unsigned*)p.ws, (volatile PG8_LAS unsigned*)((PG8_LAS unsigned char*)lds + 143360));
    constexpr size_t SEG = (size_t)(WS_B1 - WS_B0) / 2;

    RUN(0, {
        WSL(ws);
#ifndef PREP
#define PREP 0
#endif
        init_rows(p); if (PREP & 1) init_rows(p);
        cvt_wvb(p);
        cvt_wxqn(p);
        conv_sguw(p);
        for (int pr_ = 0; pr_ < ((PREP & 4) ? 2 : 1); ++pr_) {
        int tc = 0;
        for (int l = 0; l < 4; ++l) conv_job(lds, p.in[26] + (size_t)l * 1024 * 2048, 2048, 0, 2048, 1024, PBF(ws, WS_WKVT) + (size_t)l * 2048 * 1024, nullptr, 1.0f, tc);
        conv_inproj(lds, p, 0, tc);
        for (int ig = 0; ig < 8; ++ig) conv_job(lds, p.in[4] + (size_t)ig * 256 * 256, 256, 0, 256, 256, PBF(ws, WS_PWT) + (size_t)ig * 256 * 256, nullptr, 1.0f, tc);
        for (int i = 0; i < 2; ++i) conv_job(lds, p.in[6] + (size_t)i * 2048 * 1024, 1024, 0, 1024, 2048, PBF(ws, WS_WOAB) + (size_t)i * 1024 * 2048, nullptr, 1.0f, tc);
        for (int i = 0; i < 2; ++i) conv_job(lds, p.in[23] + (size_t)i * 1536 * 1024, 1024, 0, 1024, 1536, PBF(ws, WS_WOCD) + (size_t)i * 1024 * 1536, nullptr, 1.0f, tc);
        for (int l = 0; l < 4; ++l) conv_job(lds, p.in[27] + (size_t)l * 1024 * 1024, 1024, 0, 1024, 1024, PBF(ws, WS_WXO) + (size_t)l * 1024 * 1024, nullptr, 1.0f, tc);
        for (int i = 0; i < 2; ++i)
            for (int j = 0; j < 4; ++j) {
                conv_job(lds, p.in[21] + (size_t)i * 512 * 512, 512, 128 * j, 128, 512, PBF(ws, WS_GLU) + (size_t)i * 1024 * 512 + (size_t)(256 * j) * 512, nullptr, 1.0f, tc);
                conv_job(lds, p.in[22] + (size_t)i * 512 * 512, 512, 128 * j, 128, 512, PBF(ws, WS_GLU) + (size_t)i * 1024 * 512 + (size_t)(256 * j + 128) * 512, nullptr, 1.0f, tc);
            }
        }
        (void)dry;
    });
    GSYNC();
    RUN(1, {
        WSL(ws);
        for (int ig = 0; ig < 8; ++ig) { const int vcf = (int)blockIdx.x - 4 * ig;
            EpiFold E{PBF(ws, WS_WUT) + (size_t)(ig >> 2) * 1024 * WIN_LD + (size_t)(ig & 3) * 256 * WIN_LD, p.in[5] + (ig >> 2) * 1024 + (ig & 3) * 256};
            run_gemm<1>(lds, PBF(ws, WS_PWT) + (size_t)ig * 256 * 256, PBF(ws, WS_PWT) + (size_t)ig * 256 * 256, 256, PBF(ws, WS_WVB) + (size_t)ig * 1024 * 256, 256, 1024, 256, E, 1 << 20, 0, 1 << 20, 0, 4, (vcf >= 0 && vcf < 4) ? vcf : -1, 256); }
        { const int sh_ = ((int)gridDim.x >= 96) ? 32 : 0; for (int cb_ = (int)blockIdx.x - sh_; cb_ < 64; cb_ += (int)gridDim.x) if (cb_ >= 0) s5_tables(lds, p, cb_); }
        const int hg = (int)gridDim.x >> 1;
        { EpiProj E{PBF(ws, WS_KVX), (size_t)MM * 1024, nullptr, 0u, nullptr, -1, 0, 1024, nullptr}; run_gemm<F_KV>(lds, PBF(ws, WS_MEMNB), PBF(ws, WS_MEMNB), 1024, PBF(ws, WS_WKVT), MM, 4096, 1024, E, 1 << 20, 0, 4, 4, hg, (int)blockIdx.x < hg ? (int)blockIdx.x : -1); }
        { EpiProj E{PBF(ws, WS_VTX), (size_t)MM * 1024, nullptr, 0u, nullptr, -1, 0, 1024, nullptr}; run_gemm<F_KV>(lds, PBF(ws, WS_MEMNB), PBF(ws, WS_MEMNB), 1024, PBF(ws, WS_WKVT) + (size_t)1024 * 1024, MM, 4096, 1024, E, 1 << 20, 0, 4, 4, hg, (int)blockIdx.x >= hg ? (int)blockIdx.x - hg : -1); }
        (void)dry;
    });
    GSYNC();

#pragma unroll 1
    for (int l = 0; l < 4; ++l) {
        const int i = l >> 1;
        if ((l & 1) == 0) {
            RUN(2, {
            { WSL(ws); EpiProj E{PBF(ws, WS_B0), SEG, PF32(ws, WS_RS), 0u, nullptr, -1, 1, 1024, nullptr, 7u, (bf16_t*)p.out};
              run_gemm<F_G1, EpiProj, false>(lds, PBF(ws, WS_XB), PBF(ws, WS_XB), 1024, PBF(ws, WS_WIN), M, 4096, 1024, E, 1 << 20, 0, 1 << 20, 0, 0, 0, 1024, WIN_LD, PBF(ws, WS_WUT) + (size_t)i * 1024 * WIN_LD, 12); }
            (void)dry; });
            GSYNC();
            RUN(3, { dil_attn_mfma(lds, p, dry); });
            GSYNC();
            RUN(4, { WSL(ws); EpiGates E{EpiGateA{PBF(ws, WS_B0), PF32(ws, WS_RS), dry}, EpiGateB{PBF(ws, WS_B1), PBF(ws, WS_B3), PF32(ws, WS_RS), dry}};
                     run_gemm<F_GG>(lds, PBF(ws, WS_XB), PBF(ws, WS_XB), 1024, PBF(ws, WS_WIN) + (size_t)3072 * WIN_LD, M, 2048, 1024, E, 1 << 20, 0, 1 << 20, 0, 0, 0, 1024, WIN_LD); });
            GSYNC();
            RUN(5, { WSL(ws); EpiResid E{PBF(ws, WS_XB), PF32(ws, WS_RS), lds + 131072, dry}; run_gemm<F_G2>(lds, PBF(ws, WS_B0), PBF(ws, WS_B1), 1024, PBF(ws, WS_WOAB) + (size_t)i * 1024 * 2048, M, 1024, 2048, E); });
        } else {
            RUN(6, { WSL(ws); EpiProjOdd E{PBF(ws, WS_B0), PBF(ws, WS_B1), PBF(ws, WS_B3), PF32(ws, WS_RS), PF32(ws, WS_LNS), lds + 131072}; run_gemm<F_G1O, EpiProjOdd, false>(lds, PBF(ws, WS_XB), PBF(ws, WS_XB), 1024, PBF(ws, WS_WIN), M, 4096, 1024, E, 1 << 20, 0, 1 << 20, 0, 0, 0, 1024, WIN_LD); (void)dry; });
            GSYNC();
            RUN(7, { s5_mfma(lds, p, i, dry); __syncthreads(); });
            RUN(13, { sgu_mfma(lds, p, i, dry); __syncthreads(); });
            GSYNC();
            RUN(8, { WSL(ws); EpiGlu E{PBF(ws, WS_B3) + 512, dry}; run_gemm<F_GLU>(lds, PBF(ws, WS_B3), PBF(ws, WS_B3), 512, PBF(ws, WS_GLU) + (size_t)i * 1024 * 512, M, 1024, 512, E); });
            GSYNC();
            RUN(9, { WSL(ws); EpiResid E{PBF(ws, WS_XB), PF32(ws, WS_RS), lds + 131072, dry}; run_gemm<F_G2O>(lds, PBF(ws, WS_B0), PBF(ws, WS_B3) + 512, 1024, PBF(ws, WS_WOCD) + (size_t)i * 1024 * 1536, M, 1024, 1536, E); });
        }
        RUN(10, { xattn_prep(lds, p, l); (void)dry; });
        GSYNC_WT();
        RUN(11, {
            { int tc = 0; if (l < 3) conv_inproj(lds, p, l + 1, tc); }
            __syncthreads();
            xattn_s(lds, p);
            (void)dry; });
        GSYNC_WT();
        if (FUSE_FINAL && l == 3 && gridDim.x == 256) { xattn_o_final(lds, p, xbar); }
        else {
            RUN(12, { xattn_o(lds, p, dry); });
            GSYNC_WT();
        }
    }
    if (!(FUSE_FINAL && gridDim.x == 256)) final_norm(p);
}

extern "C" void kernel_launch(void* const* d_in, const int* in_sizes, int n_in, void* d_out, int out_size, void* d_ws, size_t ws_size, hipStream_t stream) {
    static int grid = 0;
    if (grid == 0) {
        if (n_in != 30 || out_size != M * DM || ws_size < WS_END) { fprintf(stderr, "kernel_launch: unexpected shapes n_in %d out %d ws %zu\n", n_in, out_size, ws_size); grid = -1; return; }
        int dev = 0, cus = 0, per_cu = 0;
        (void)hipGetDevice(&dev);
        (void)hipDeviceGetAttribute(&cus, hipDeviceAttributeMultiprocessorCount, dev);
        (void)hipFuncSetAttribute((const void*)mega, hipFuncAttributeMaxDynamicSharedMemorySize, LDS_BYTES);
        (void)hipOccupancyMaxActiveBlocksPerMultiprocessor(&per_cu, (const void*)mega, NT, LDS_BYTES);
        if (per_cu < 1) per_cu = 1;
        grid = cus * per_cu;
    }
    if (grid < 0) return;
    Params p{};
    for (int i = 0; i < 30; ++i) p.in[i] = (const float*)d_in[i];
    p.out = (float*)d_out; p.ws = (unsigned char*)d_ws;
    (void)hipMemsetAsync(d_ws, 0, 16384, stream);
    void* args[] = {&p};
    hipError_t e = hipLaunchCooperativeKernel((void*)mega, dim3(grid), dim3(NT), args, LDS_BYTES, stream);
    if (e != hipSuccess) fprintf(stderr, "cooperative launch failed: %s (grid %d)\n", hipGetErrorString(e), grid);
}
```
